# Optimizing an MI355X kernel written in HIP

```python
import jax, jax.numpy as jnp
from jax import lax
import numpy as np

D_MODEL = 1024
BATCH = 8
SEQ = 2048
DEPTH = 4

N_MIXERS = 4
DEEPNORM_ALPHA = (2.0 * DEPTH) ** 0.25
DEEPNORM_BETA = (8.0 * DEPTH) ** -0.25
LN_EPS = 1e-5
RMS_EPS = 1e-6
Q_BLOCK = 128

A_CHUNK = 128
A_HALF = 2 * D_MODEL
A_GROUPS = 8
A_GROUP_DIM = A_HALF // A_GROUPS

B_HEADS = 16
B_HEAD_DIM = D_MODEL // B_HEADS
B_IDX_HEADS = 4
B_IDX_DIM = 64
B_TOPK_MAX = 256
B_IN = 3 * B_HEADS * B_HEAD_DIM + B_IDX_HEADS * B_IDX_DIM + B_IDX_DIM + B_IDX_HEADS

C_HEADS = 8
C_EXPAND = 128
C_HEAD_V = D_MODEL // C_HEADS
C_FDIM = C_HEADS * C_EXPAND
C_CHUNK = 64

D_HEADS = 16
D_NOPE = 64
D_ROPE = 32
D_VDIM = 64
D_Q_RANK = 256
D_KV_RANK = 128
ROPE_BASE = 10000.0

FFN_DIM = 3584
N_EXPERTS = 8
TOP_K = 2
MOE_BLOCK = 128

kernel_name = "hybrid_interleaved_gmlp_dsa_hgrn2_mla_moe"

F32 = jnp.float32


def layer_norm(x, g, b):
    xf = x.astype(F32)
    mu = jnp.mean(xf, axis=-1, keepdims=True)
    var = jnp.mean(jnp.square(xf - mu), axis=-1, keepdims=True)
    return ((xf - mu) * lax.rsqrt(var + LN_EPS) * g.astype(F32) + b.astype(F32)).astype(x.dtype)


def rms_norm(x, g):
    xf = x.astype(F32)
    return (xf * lax.rsqrt(jnp.mean(jnp.square(xf), axis=-1, keepdims=True) + RMS_EPS) * g.astype(F32)).astype(x.dtype)


def rope(x, positions):
    half = x.shape[-1] // 2
    inv_freq = ROPE_BASE ** (-jnp.arange(half, dtype=F32) / half)
    ang = positions.astype(F32)[:, :, None] * inv_freq
    cos, sin = jnp.cos(ang)[:, :, None, :], jnp.sin(ang)[:, :, None, :]
    xf = x.astype(F32)
    x1, x2 = xf[..., :half], xf[..., half:]
    return jnp.concatenate([x1 * cos - x2 * sin, x2 * cos + x1 * sin], axis=-1).astype(x.dtype)


def mixer_gmlp(x, w_in, ln_g, ln_b, w_s, b_s, w_out):
    bsz, seq, _ = x.shape
    n_chunks = seq // A_CHUNK
    uv = jax.nn.gelu(x @ w_in)
    u, v = uv[..., :A_HALF], uv[..., A_HALF:]
    v = layer_norm(v, ln_g, ln_b).reshape(bsz, n_chunks, A_CHUNK, A_GROUPS, A_GROUP_DIM)
    causal = jnp.tril(jnp.ones((A_CHUNK, A_CHUNK), dtype=bool))
    w_causal = jnp.where(causal, w_s, 0.0).astype(v.dtype)
    s = jnp.einsum('gts,bnsgd->bntgd', w_causal, v) + b_s.T.astype(v.dtype)[None, None, :, :, None]
    return (u * s.reshape(bsz, seq, A_HALF)) @ w_out


def mixer_dsa(x, w_in, w_out):
    bsz, seq, _ = x.shape
    topk = min(B_TOPK_MAX, seq // 4)
    hd = B_HEADS * B_HEAD_DIM
    proj = x @ w_in
    q = proj[..., :hd].reshape(bsz, seq, B_HEADS, B_HEAD_DIM)
    k = proj[..., hd:2 * hd].reshape(bsz, seq, B_HEADS, B_HEAD_DIM)
    v = proj[..., 2 * hd:3 * hd].reshape(bsz, seq, B_HEADS, B_HEAD_DIM)
    o = 3 * hd
    q_idx = proj[..., o:o + B_IDX_HEADS * B_IDX_DIM].reshape(bsz, seq, B_IDX_HEADS, B_IDX_DIM).astype(F32)
    o += B_IDX_HEADS * B_IDX_DIM
    k_idx = proj[..., o:o + B_IDX_DIM].astype(F32)
    o += B_IDX_DIM
    w_idx = proj[..., o:o + B_IDX_HEADS].astype(F32)
    idx_scale = (B_IDX_DIM * B_IDX_HEADS) ** -0.5
    attn_scale = B_HEAD_DIM ** -0.5
    k_pos = jnp.arange(seq)
    take_rows = jax.vmap(lambda arr, sel: arr[sel])

    def block(i):
        start = i * Q_BLOCK
        q_pos = start + jnp.arange(Q_BLOCK)
        qb = lax.dynamic_slice_in_dim(q, start, Q_BLOCK, axis=1)
        qib = lax.dynamic_slice_in_dim(q_idx, start, Q_BLOCK, axis=1)
        wib = lax.dynamic_slice_in_dim(w_idx, start, Q_BLOCK, axis=1)
        dots = jnp.einsum('bthd,bsd->bths', qib, k_idx)
        score = jnp.einsum('bths,bth->bts', jax.nn.relu(dots), wib) * idx_scale
        admissible = k_pos[None, :] <= q_pos[:, None]
        score = jnp.where(admissible[None], score, -jnp.inf)
        _, sel = lax.top_k(score, topk)
        k_sel = take_rows(k, sel)
        v_sel = take_rows(v, sel)
        logits = jnp.einsum('bthd,btkhd->bthk', qb, k_sel).astype(F32) * attn_scale
        valid = sel <= q_pos[None, :, None]
        logits = jnp.where(valid[:, :, None, :], logits, -jnp.inf)
        p = jax.nn.softmax(logits, axis=-1).astype(v.dtype)
        return jnp.einsum('bthk,btkhd->bthd', p, v_sel)

    out = lax.map(block, jnp.arange(seq // Q_BLOCK))
    out = out.transpose(1, 0, 2, 3, 4).reshape(bsz, seq, hd)
    return out @ w_out


def mixer_hgrn2(x, w_in, lb_logits, norm_g, w_out, layer):
    bsz, seq, _ = x.shape
    nc = seq // C_CHUNK
    proj = x @ w_in
    q = proj[..., :C_FDIM].astype(F32)
    f_pre = proj[..., C_FDIM:2 * C_FDIM].astype(F32)
    i_in = proj[..., 2 * C_FDIM:2 * C_FDIM + D_MODEL].astype(F32)
    gate = proj[..., 2 * C_FDIM + D_MODEL:].astype(F32)
    lb_all = jnp.cumsum(jax.nn.softmax(lb_logits.astype(F32), axis=0), axis=0)
    lb = lb_all[layer] - lb_all[0]
    f = lb + (1.0 - lb) * jax.nn.sigmoid(f_pre)
    log_f = jnp.log(f)
    key = 1.0 - f

    def heads(t, d):
        return t.reshape(bsz, nc, C_CHUNK, C_HEADS, d).transpose(1, 0, 3, 2, 4)

    xs = (heads(q, C_EXPAND), heads(key, C_EXPAND), heads(log_f, C_EXPAND), heads(i_in, C_HEAD_V))
    tri = jnp.tril(jnp.ones((C_CHUNK, C_CHUNK), dtype=bool))[:, :, None]

    def step(state, inp):
        qb, kb, gb, vb = inp
        g_cum = jnp.cumsum(gb, axis=2)
        diff = g_cum[:, :, :, None, :] - g_cum[:, :, None, :, :]
        decay = jnp.where(tri, jnp.exp(jnp.where(tri, diff, 0.0)), 0.0)
        scores = jnp.einsum('bhtk,bhtsk,bhsk->bhts', qb, decay, kb)
        out = jnp.einsum('bhts,bhsv->bhtv', scores, vb) + jnp.einsum('bhtk,bhkv->bhtv', qb * jnp.exp(g_cum), state)
        g_last = g_cum[:, :, -1]
        k_dec = kb * jnp.exp(g_last[:, :, None, :] - g_cum)
        state = jnp.exp(g_last)[..., None] * state + jnp.einsum('bhsk,bhsv->bhkv', k_dec, vb)
        return state, out

    s0 = jnp.zeros((bsz, C_HEADS, C_EXPAND, C_HEAD_V), F32)
    _, o = lax.scan(step, s0, xs)
    o = o.transpose(1, 0, 3, 2, 4).reshape(bsz, seq, C_HEADS, C_HEAD_V)
    o = rms_norm(o, norm_g) * jax.nn.silu(gate.reshape(bsz, seq, C_HEADS, C_HEAD_V))
    return o.reshape(bsz, seq, D_MODEL).astype(x.dtype) @ w_out


def mixer_mla(x, positions, w_in, q_norm_g, w_uq, kv_norm_g, w_ukv, w_out):
    bsz, seq, _ = x.shape
    proj = x @ w_in
    c_q = rms_norm(proj[..., :D_Q_RANK], q_norm_g)
    c_kv = rms_norm(proj[..., D_Q_RANK:D_Q_RANK + D_KV_RANK], kv_norm_g)
    k_rope = rope(proj[..., D_Q_RANK + D_KV_RANK:][:, :, None, :], positions)[:, :, 0]
    q = (c_q @ w_uq).reshape(bsz, seq, D_HEADS, D_NOPE + D_ROPE)
    q_nope, q_rope = q[..., :D_NOPE], rope(q[..., D_NOPE:], positions)
    kv = (c_kv @ w_ukv).reshape(bsz, seq, D_HEADS, D_NOPE + D_VDIM)
    k_nope, v = kv[..., :D_NOPE], kv[..., D_NOPE:]
    scale = (D_NOPE + D_ROPE) ** -0.5
    k_pos = jnp.arange(seq)

    def block(i):
        start = i * Q_BLOCK
        q_pos = start + jnp.arange(Q_BLOCK)
        qn = lax.dynamic_slice_in_dim(q_nope, start, Q_BLOCK, axis=1)
        qr = lax.dynamic_slice_in_dim(q_rope, start, Q_BLOCK, axis=1)
        s = jnp.einsum('bthd,bshd->bhts', qn, k_nope) + jnp.einsum('bthd,bsd->bhts', qr, k_rope)
        s = jnp.where((k_pos[None, :] <= q_pos[:, None])[None, None], s.astype(F32) * scale, -jnp.inf)
        p = jax.nn.softmax(s, axis=-1).astype(v.dtype)
        return jnp.einsum('bhts,bshd->bthd', p, v)

    out = lax.map(block, jnp.arange(seq // Q_BLOCK))
    out = out.transpose(1, 0, 2, 3, 4).reshape(bsz, seq, D_HEADS * D_VDIM)
    return out @ w_out


def swiglu(x, w_gu, w_down):
    gu = x @ w_gu
    return (jax.nn.silu(gu[..., :FFN_DIM]) * gu[..., FFN_DIM:]) @ w_down


def moe_swiglu(x, w_router, w_gu, w_down):
    bsz, seq, d = x.shape
    n_tok = bsz * seq
    n_assign = n_tok * TOP_K
    xf = x.reshape(n_tok, d)
    logits = (xf @ w_router).astype(F32)
    top_logit, top_e = lax.top_k(logits, TOP_K)
    gate = jax.nn.softmax(top_logit, axis=-1)
    flat_e = top_e.reshape(-1)
    flat_tok = jnp.repeat(jnp.arange(n_tok, dtype=jnp.int32), TOP_K)
    order = jnp.argsort(flat_e)
    e_sorted, tok_sorted, gate_sorted = flat_e[order], flat_tok[order], gate.reshape(-1)[order]
    counts = jnp.zeros((N_EXPERTS,), jnp.int32).at[flat_e].add(1)
    starts = jnp.cumsum(counts) - counts
    padded = (counts + MOE_BLOCK - 1) // MOE_BLOCK * MOE_BLOCK
    padded_ends = jnp.cumsum(padded)
    padded_starts = padded_ends - padded
    dest = padded_starts[e_sorted] + jnp.arange(n_assign, dtype=jnp.int32) - starts[e_sorted]
    n_rows = (-(-n_assign // MOE_BLOCK) + N_EXPERTS) * MOE_BLOCK
    n_blocks = n_rows // MOE_BLOCK
    row_tok = jnp.full((n_rows,), n_tok, jnp.int32).at[dest].set(tok_sorted)
    row_gate = jnp.zeros((n_rows,), F32).at[dest].set(gate_sorted)
    block_e = jnp.minimum(jnp.searchsorted(padded_ends, jnp.arange(n_blocks, dtype=jnp.int32) * MOE_BLOCK, side='right'), N_EXPERTS - 1)
    x_pad = jnp.concatenate([xf, jnp.zeros((1, d), xf.dtype)], axis=0)
    x_rows = x_pad[row_tok].reshape(n_blocks, MOE_BLOCK, d)

    def expert_block(args):
        xb, e = args
        return swiglu(xb, w_gu[e], w_down[e])

    y = lax.map(expert_block, (x_rows, block_e)).reshape(n_rows, d)
    y = y * row_gate[:, None].astype(y.dtype)
    out = jnp.zeros((n_tok + 1, d), y.dtype).at[row_tok].add(y)[:n_tok]
    return out.reshape(bsz, seq, d)


def setup_inputs(seed: int = 0) -> dict:
    key = jax.random.key(seed)
    keys = iter(jax.random.split(key, 48))

    def w(shape, fan_in, scale=1.0):
        return jax.random.normal(next(keys), shape, F32) * (scale * fan_in ** -0.5)

    def gain(shape):
        return 1.0 + 0.05 * jax.random.normal(next(keys), shape, F32)

    def bias(shape):
        return 0.02 * jax.random.normal(next(keys), shape, F32)

    beta = DEEPNORM_BETA
    x = jax.random.normal(next(keys), (BATCH, SEQ, D_MODEL), F32)
    offsets = jax.random.randint(next(keys), (BATCH, 1), 0, 1024, dtype=jnp.int32)
    positions = offsets + jnp.arange(SEQ, dtype=jnp.int32)[None, :]
    return {
        "x": x,
        "positions": positions,
        "a_w_in": w((D_MODEL, 2 * A_HALF), D_MODEL),
        "a_ln_g": gain((A_HALF,)),
        "a_ln_b": bias((A_HALF,)),
        "a_w_s": w((A_GROUPS, A_CHUNK, A_CHUNK), A_CHUNK, 0.5),
        "a_b_s": gain((A_GROUPS, A_CHUNK)),
        "a_w_out": w((A_HALF, D_MODEL), A_HALF, beta),
        "b_w_in": w((D_MODEL, B_IN), D_MODEL),
        "b_w_out": w((B_HEADS * B_HEAD_DIM, D_MODEL), B_HEADS * B_HEAD_DIM, beta),
        "c_w_in": w((D_MODEL, 2 * C_FDIM + 2 * D_MODEL), D_MODEL),
        "c_lb_logits": 0.1 * jax.random.normal(next(keys), (DEPTH, C_FDIM), F32),
        "c_norm_g": gain((C_HEAD_V,)),
        "c_w_out": w((D_MODEL, D_MODEL), D_MODEL, beta),
        "d_w_in": w((D_MODEL, D_Q_RANK + D_KV_RANK + D_ROPE), D_MODEL),
        "d_q_norm_g": gain((D_Q_RANK,)),
        "d_w_uq": w((D_Q_RANK, D_HEADS * (D_NOPE + D_ROPE)), D_Q_RANK),
        "d_kv_norm_g": gain((D_KV_RANK,)),
        "d_w_ukv": w((D_KV_RANK, D_HEADS * (D_NOPE + D_VDIM)), D_KV_RANK),
        "d_w_out": w((D_HEADS * D_VDIM, D_MODEL), D_HEADS * D_VDIM, beta),
        "ffn0_w_gu": w((D_MODEL, 2 * FFN_DIM), D_MODEL),
        "ffn0_w_down": w((FFN_DIM, D_MODEL), FFN_DIM, beta),
        "moe1_w_router": w((D_MODEL, N_EXPERTS), D_MODEL),
        "moe1_w_gu": w((N_EXPERTS, D_MODEL, 2 * FFN_DIM), D_MODEL),
        "moe1_w_down": w((N_EXPERTS, FFN_DIM, D_MODEL), FFN_DIM, beta),
        "ffn2_w_gu": w((D_MODEL, 2 * FFN_DIM), D_MODEL),
        "ffn2_w_down": w((FFN_DIM, D_MODEL), FFN_DIM, beta),
        "moe3_w_router": w((D_MODEL, N_EXPERTS), D_MODEL),
        "moe3_w_gu": w((N_EXPERTS, D_MODEL, 2 * FFN_DIM), D_MODEL),
        "moe3_w_down": w((N_EXPERTS, FFN_DIM, D_MODEL), FFN_DIM, beta),
        "ln_mix_g": gain((DEPTH, D_MODEL)),
        "ln_mix_b": bias((DEPTH, D_MODEL)),
        "ln_ffn_g": gain((DEPTH, D_MODEL)),
        "ln_ffn_b": bias((DEPTH, D_MODEL)),
    }


def reference(x, positions, a_w_in, a_ln_g, a_ln_b, a_w_s, a_b_s, a_w_out,
              b_w_in, b_w_out, c_w_in, c_lb_logits, c_norm_g, c_w_out,
              d_w_in, d_q_norm_g, d_w_uq, d_kv_norm_g, d_w_ukv, d_w_out,
              ffn0_w_gu, ffn0_w_down, moe1_w_router, moe1_w_gu, moe1_w_down,
              ffn2_w_gu, ffn2_w_down, moe3_w_router, moe3_w_gu, moe3_w_down,
              ln_mix_g, ln_mix_b, ln_ffn_g, ln_ffn_b):
    dense_ffn = {0: (ffn0_w_gu, ffn0_w_down), 2: (ffn2_w_gu, ffn2_w_down)}
    moe_ffn = {1: (moe1_w_router, moe1_w_gu, moe1_w_down), 3: (moe3_w_router, moe3_w_gu, moe3_w_down)}
    for i in range(DEPTH):
        kind = i % N_MIXERS
        if kind == 0:
            h = mixer_gmlp(x, a_w_in, a_ln_g, a_ln_b, a_w_s, a_b_s, a_w_out)
        elif kind == 1:
            h = mixer_dsa(x, b_w_in, b_w_out)
        elif kind == 2:
            h = mixer_hgrn2(x, c_w_in, c_lb_logits, c_norm_g, c_w_out, i)
        else:
            h = mixer_mla(x, positions, d_w_in, d_q_norm_g, d_w_uq, d_kv_norm_g, d_w_ukv, d_w_out)
        x = layer_norm(DEEPNORM_ALPHA * x + h, ln_mix_g[i], ln_mix_b[i])
        if i % 2 == 0:
            h = swiglu(x, *dense_ffn[i])
        else:
            h = moe_swiglu(x, *moe_ffn[i])
        x = layer_norm(DEEPNORM_ALPHA * x + h, ln_ffn_g[i], ln_ffn_b[i])
    return x
```

```cpp
#include <hip/hip_runtime.h>
#include <cstdio>
#include <cstdint>

#define LAS __attribute__((address_space(3)))
#define GAS __attribute__((address_space(1)))
typedef unsigned short bf16;
typedef short bf16x8 __attribute__((ext_vector_type(8)));
typedef short s16x4 __attribute__((ext_vector_type(4)));
typedef float f32x2 __attribute__((ext_vector_type(2)));
typedef float f32x4 __attribute__((ext_vector_type(4)));
typedef float f32x16 __attribute__((ext_vector_type(16)));
typedef unsigned u32x2 __attribute__((ext_vector_type(2)));
typedef unsigned u32x4 __attribute__((ext_vector_type(4)));
typedef unsigned long long u64;

constexpr int NB = 8, SEQ = 2048, D = 1024, M = NB * SEQ;
constexpr int FF = 3584, NE = 8;
constexpr int MOE_ROWS = 34816;
constexpr float ALPHA = 1.6817928305074290f;
constexpr float LN_EPS = 1e-5f, RMS_EPS = 1e-6f;
constexpr int NWAVES = 8, NTHREADS = 512;

constexpr size_t MiB = 1u << 20;
constexpr size_t WS_CTL = 0, CTL_ZERO_BYTES = 1 * MiB;
constexpr size_t WS_W0 = 1 * MiB;
constexpr size_t W_A_IN = WS_W0;
constexpr size_t W_A_OUT = W_A_IN + 8 * MiB;
constexpr size_t W_B_IN = W_A_OUT + 4 * MiB;
constexpr size_t W_B_OUT = W_B_IN + 7 * MiB;
constexpr size_t W_C_IN = W_B_OUT + 2 * MiB;
constexpr size_t W_C_OUT = W_C_IN + 8 * MiB;
constexpr size_t W_D_IN = W_C_OUT + 2 * MiB;
constexpr size_t W_D_UQ = W_D_IN + 1 * MiB;
constexpr size_t W_D_UKV = W_D_UQ + 1 * MiB;
constexpr size_t W_D_OUT = W_D_UKV + 1 * MiB;
constexpr size_t W_F0_GU = W_D_OUT + 2 * MiB;
constexpr size_t W_F0_DN = W_F0_GU + 14 * MiB;
constexpr size_t W_F2_GU = W_F0_DN + 7 * MiB;
constexpr size_t W_F2_DN = W_F2_GU + 14 * MiB;
constexpr size_t W_M1_GU = W_F2_DN + 7 * MiB;
constexpr size_t W_M1_DN = W_M1_GU + 112 * MiB;
constexpr size_t W_M3_GU = W_M1_DN + 56 * MiB;
constexpr size_t W_M3_DN = W_M3_GU + 112 * MiB;
constexpr size_t WS_WEND = W_M3_DN + 56 * MiB;
constexpr size_t WS_XB = WS_WEND;
constexpr size_t WS_SMALL = WS_XB + 32 * MiB;
constexpr size_t S_STATS = WS_SMALL;
constexpr size_t S_TOKE = WS_SMALL + 128 * 1024;
constexpr size_t S_TOKG = WS_SMALL + 256 * 1024;
constexpr size_t S_SLOT = WS_SMALL + 384 * 1024;
constexpr size_t S_ROWTOK = WS_SMALL + 512 * 1024;
constexpr size_t S_ROWGATE = WS_SMALL + 768 * 1024;
constexpr size_t S_ANG = WS_SMALL + 1 * MiB;
constexpr size_t S_KR = WS_SMALL + 3 * MiB;
constexpr size_t S_MASK = WS_SMALL + 4 * MiB;
constexpr size_t WS_BIG = WS_SMALL + 8 * MiB;
constexpr size_t WS_R2 = WS_BIG + 238 * MiB;
constexpr size_t WS_END = WS_R2 + 68 * MiB;
static_assert(WS_WEND == 415 * MiB, "weight map");
static_assert(WS_END <= 880 * MiB, "workspace budget");
constexpr size_t B_UV = WS_BIG, B_GATED = WS_BIG + 128 * MiB;
constexpr size_t B_PROJB = WS_BIG, B_OB = WS_BIG + 192 * MiB;
constexpr size_t B_PROJC = WS_BIG, B_OPRE = WS_BIG + 128 * MiB;
constexpr size_t B_PROJD = WS_BIG, B_CQ = WS_BIG + 32 * MiB, B_CKV = WS_BIG + 40 * MiB, B_Q = WS_BIG + 48 * MiB, B_KV = WS_BIG + 96 * MiB;
constexpr size_t B_H = WS_BIG;
constexpr int CW_BAR = 4096;
constexpr int CW_CNT = 16384;

constexpr int RING_BYTES = 131072;
constexpr int LDSCTL_OFF = RING_BYTES;
constexpr int LDS_BYTES = 147456;

typedef __bf16 bf16x2_t __attribute__((ext_vector_type(2)));
__device__ __forceinline__ unsigned cvt_pk_bf16(float lo, float hi) { const f32x2 v = {lo, hi}; const bf16x2_t b = __builtin_convertvector(v, bf16x2_t); return __builtin_bit_cast(unsigned, b); }
__device__ __forceinline__ float bf2f(unsigned short b) { return __uint_as_float((unsigned)b << 16); }
__device__ __forceinline__ float bflo(unsigned w) { return __uint_as_float(w << 16); }
__device__ __forceinline__ float bfhi(unsigned w) { return __uint_as_float(w & 0xffff0000u); }
__device__ __forceinline__ float fast_exp2(float x) { return __builtin_amdgcn_exp2f(x); }
__device__ __forceinline__ float fast_rcp(float x) { return __builtin_amdgcn_rcpf(x); }
__device__ __forceinline__ float sigmoidf_(float x) { return fast_rcp(1.0f + fast_exp2(-1.4426950408889634f * x)); }
__device__ __forceinline__ float siluf_(float x) { return x * sigmoidf_(x); }
__device__ __forceinline__ float gelu_tanh(float x) { const float u = x + 0.044715f * x * x * x; return x * fast_rcp(1.0f + fast_exp2(-2.302208198f * u)); }
__device__ __forceinline__ float wave_sum(float v) {
#pragma unroll
    for (int o = 1; o < 64; o <<= 1) v += __shfl_xor(v, o);
    return v;
}
#define LDS_WAIT() asm volatile("s_waitcnt lgkmcnt(0)" ::: "memory")
#define VM_WAIT() asm volatile("s_waitcnt vmcnt(0)" ::: "memory")
namespace pg8 {
constexpr int BM = 256, BK = 64, HALF = 128, HTB = HALF * BK * 2  , STAGE_BYTES = 8 * HTB, NXCD = 8, WGM = 8;
__host__ __device__ __forceinline__ int lds_byte(int r, int c) { const int st = (r >> 4) * 2 + (c >> 5), rr = r & 15, cc = c & 31, ob = rr * 64 + cc * 2; return st * 1024 + (ob ^ (((ob >> 9) & 1) << 5)); }
__host__ __device__ __forceinline__ void stage_rc(int b, int& R, int& C) { const int st = b / 1024, sb = b % 1024, swz = sb ^ (((sb >> 9) & 1) << 5); R = (st >> 1) * 16 + swz / 64; C = (st & 1) * 32 + (swz % 64) / 2; }
__host__ __device__ __forceinline__ int perm32(int rho) { const int n = rho >> 4, i = rho & 15; return 8 * (i >> 2) + 4 * n + (i & 3); }

struct Unit { int pm, pn, e; };
struct Gemm { const bf16* A; const bf16* Bt; int M, N, K, lda; size_t bes; };

struct StaticOrder {
    int nM, nN, nwg, G, c;
    __device__ void init(int M_, int N_, int G_, int c_) { nM = M_ / BM; nN = N_ / BM; nwg = nM * nN; G = G_; c = c_; }
    __device__ bool next(int i, Unit& u) const {
        const long L = (long)i * G + c; if (L >= nwg) return false;
        int wgid = (int)L; { const int q = nwg / NXCD, r = nwg % NXCD, xcd = wgid % NXCD, off = wgid / NXCD; wgid = (xcd < r ? xcd * (q + 1) : r * (q + 1) + (xcd - r) * q) + off; }
        const int nig = WGM * nN, gid = wgid / nig, fm = gid * WGM, gsz = (nM - fm) < WGM ? (nM - fm) : WGM;
        u.pm = fm + ((wgid % nig) % gsz); u.pn = (wgid % nig) / gsz; u.e = 0; return true;
    }
};
struct MoeOrder {
    StaticOrder so; int pend[NE];
    __device__ bool next(int i, Unit& u) const {
        if (!so.next(i, u)) return false;
        const int r0 = u.pm * BM; int e = 0;
#pragma unroll
        for (int j = 0; j < NE - 1; ++j) e += (r0 >= pend[j]) ? 1 : 0;
        u.e = e; return true;
    }
};

template <int ACT  > struct EpiBf16 {
    static constexpr bool PERM = true;
    bf16* O; int ldc;
    __device__ __forceinline__ void operator()(const f32x4 (&acc)[2][2][4][2], const Unit& u, int wr, int wc, int fr, int fq) const {
        const int row0 = u.pm * BM + wr * 64 + fr, col0 = u.pn * BM + wc * 32 + 8 * fq;
#pragma unroll
        for (int ai = 0; ai < 2; ++ai)
#pragma unroll
            for (int m = 0; m < 4; ++m) { bf16* rowp = O + (size_t)(row0 + ai * HALF + m * 16) * ldc + col0;
#pragma unroll
                for (int bj = 0; bj < 2; ++bj) { f32x4 v0 = acc[ai][bj][m][0], v1 = acc[ai][bj][m][1];
                    if (ACT == 1) { v0 = (f32x4){gelu_tanh(v0[0]), gelu_tanh(v0[1]), gelu_tanh(v0[2]), gelu_tanh(v0[3])}; v1 = (f32x4){gelu_tanh(v1[0]), gelu_tanh(v1[1]), gelu_tanh(v1[2]), gelu_tanh(v1[3])}; }
                    u32x4 w; w.x = cvt_pk_bf16(v0[0], v0[1]); w.y = cvt_pk_bf16(v0[2], v0[3]); w.z = cvt_pk_bf16(v1[0], v1[1]); w.w = cvt_pk_bf16(v1[2], v1[3]);
                    *(u32x4*)(rowp + bj * HALF) = w; } }
    }
};
struct EpiSwiGLU {
    static constexpr bool PERM = true;
    bf16* H; int ldh;
    __device__ __forceinline__ void operator()(const f32x4 (&acc)[2][2][4][2], const Unit& u, int wr, int wc, int fr, int fq) const {
        const int row0 = u.pm * BM + wr * 64 + fr, col0 = u.pn * HALF + wc * 32 + 8 * fq;
#pragma unroll
        for (int ai = 0; ai < 2; ++ai)
#pragma unroll
            for (int m = 0; m < 4; ++m) { bf16* rowp = H + (size_t)(row0 + ai * HALF + m * 16) * ldh + col0;
                const f32x4 g0 = acc[ai][0][m][0], g1 = acc[ai][0][m][1], u0 = acc[ai][1][m][0], u1 = acc[ai][1][m][1];
                u32x4 w; w.x = cvt_pk_bf16(siluf_(g0[0]) * u0[0], siluf_(g0[1]) * u0[1]); w.y = cvt_pk_bf16(siluf_(g0[2]) * u0[2], siluf_(g0[3]) * u0[3]);
                w.z = cvt_pk_bf16(siluf_(g1[0]) * u1[0], siluf_(g1[1]) * u1[1]); w.w = cvt_pk_bf16(siluf_(g1[2]) * u1[2], siluf_(g1[3]) * u1[3]);
                *(u32x4*)rowp = w; }
    }
};
struct EpiResid {
    static constexpr bool PERM = false;
    const float* X; float* Y; float alpha;
    __device__ __forceinline__ void operator()(const f32x4 (&acc)[2][2][4][2], const Unit& u, int wr, int wc, int fr, int fq) const {
        const int row0 = u.pm * BM + wr * 64 + fr, col0 = u.pn * BM + wc * 32 + 4 * fq;
#pragma unroll
        for (int ai = 0; ai < 2; ++ai)
#pragma unroll
            for (int m = 0; m < 4; ++m) { const size_t off = (size_t)(row0 + ai * HALF + m * 16) * D + col0;
#pragma unroll
                for (int bj = 0; bj < 2; ++bj)
#pragma unroll
                    for (int n = 0; n < 2; ++n) { const f32x4 xv = *(const f32x4*)(X + off + bj * HALF + n * 16); *(f32x4*)(Y + off + bj * HALF + n * 16) = xv * alpha + acc[ai][bj][m][n]; } }
    }
};
struct EpiF32 {
    static constexpr bool PERM = false;
    float* C; int ldc;
    __device__ __forceinline__ void operator()(const f32x4 (&acc)[2][2][4][2], const Unit& u, int wr, int wc, int fr, int fq) const {
        const int row0 = u.pm * BM + wr * 64 + fr, col0 = u.pn * BM + wc * 32 + 4 * fq;
#pragma unroll
        for (int ai = 0; ai < 2; ++ai)
#pragma unroll
            for (int m = 0; m < 4; ++m) { float* rowp = C + (size_t)(row0 + ai * HALF + m * 16) * ldc + col0;
#pragma unroll
                for (int bj = 0; bj < 2; ++bj)
#pragma unroll
                    for (int n = 0; n < 2; ++n) *(f32x4*)(rowp + bj * HALF + n * 16) = acc[ai][bj][m][n]; }
    }
};
struct EpiMoeDown {
    static constexpr bool PERM = true;
    bf16* YK; const int* rowtok; const float* rowgate;
    __device__ __forceinline__ void operator()(const f32x4 (&acc)[2][2][4][2], const Unit& u, int wr, int wc, int fr, int fq) const {
        const int row0 = u.pm * BM + wr * 64 + fr, col0 = u.pn * BM + wc * 32 + 8 * fq;
#pragma unroll
        for (int ai = 0; ai < 2; ++ai)
#pragma unroll
            for (int m = 0; m < 4; ++m) { const int r = row0 + ai * HALF + m * 16; const int rt = rowtok[r]; const float gt = rowgate[r];
                if (rt >= 0) { bf16* rowp = YK + (size_t)(rt & 1) * ((size_t)M * D) + (size_t)(rt >> 1) * D + col0;
#pragma unroll
                    for (int bj = 0; bj < 2; ++bj) { const f32x4 v0 = acc[ai][bj][m][0] * gt, v1 = acc[ai][bj][m][1] * gt;
                        u32x4 w; w.x = cvt_pk_bf16(v0[0], v0[1]); w.y = cvt_pk_bf16(v0[2], v0[3]); w.z = cvt_pk_bf16(v1[0], v1[1]); w.w = cvt_pk_bf16(v1[2], v1[3]);
                        *(u32x4*)(rowp + bj * HALF) = w; } } }
    }
};

template <class Epi, class Sched>
__device__ __forceinline__ void gemm_phase(LAS unsigned char* lds, const Gemm g, const Sched& S, const Epi& E) {
    const int tid = threadIdx.x, wid = __builtin_amdgcn_readfirstlane(tid >> 6), lane = tid & 63, wr = wid >> 2, wc = wid & 3, fr = lane & 15, fq = lane >> 4;
    const int K = g.K, nt = K / BK;
    unsigned voffA[2], voffB[2];
#pragma unroll
    for (int i = 0; i < 2; ++i) { int R, C; stage_rc(tid * 16 + i * 8192, R, C); const int Rb = Epi::PERM ? ((R & ~31) + perm32(R & 31)) : R;
        voffA[i] = (unsigned)(R * g.lda + C) * 2u; voffB[i] = (unsigned)(Rb * K + C) * 2u; }
    const size_t kstep = (size_t)(BK * 2);
    const size_t hstepA = (size_t)HALF * g.lda * 2, tstepA = 2 * hstepA;
    const size_t hstepB = (size_t)HALF * K * 2, tstepB = 2 * hstepB;
    const size_t besB = g.bes * 2;
    const unsigned ldsw = (unsigned)wid * 1024u;
    const int aoff = lds_byte(wr * 64 + fr, fq * 8), boff = lds_byte(wc * 32 + fr, fq * 8);
#define PG8_SA(b, h) (((b) * 2 + (h)) * HTB)
#define PG8_SB(b, h) ((4 + (b) * 2 + (h)) * HTB)
#define PG8_STAGE(bufoff, gbase, voff) do { _Pragma("unroll") for (int _i = 0; _i < 2; ++_i) \
        __builtin_amdgcn_global_load_lds((const unsigned*)((const char*)(gbase) + (voff)[_i]), (LAS unsigned*)(lds + (bufoff) + ldsw + _i * 8192), 16, 0, 0); } while (0)
#define PG8_LDA(dst, b, h) do { _Pragma("unroll") for (int m = 0; m < 4; ++m) _Pragma("unroll") for (int k = 0; k < 2; ++k) dst[m][k] = *(const LAS bf16x8*)(lds + PG8_SA(b, h) + aoff + m * 2048 + k * 1024); } while (0)
#define PG8_LDB(dst, b, h) do { _Pragma("unroll") for (int n = 0; n < 2; ++n) _Pragma("unroll") for (int k = 0; k < 2; ++k) dst[n][k] = *(const LAS bf16x8*)(lds + PG8_SB(b, h) + boff + n * 2048 + k * 1024); } while (0)
#define PG8_MMA(ai, bj, At, Bt) do { __builtin_amdgcn_s_setprio(1); _Pragma("unroll") for (int m = 0; m < 4; ++m) _Pragma("unroll") for (int n = 0; n < 2; ++n) _Pragma("unroll") for (int k = 0; k < 2; ++k) \
        acc[ai][bj][m][n] = __builtin_amdgcn_mfma_f32_16x16x32_bf16(Bt[n][k], At[m][k], acc[ai][bj][m][n], 0, 0, 0); __builtin_amdgcn_s_setprio(0); } while (0)
#define PG8_WAIT_V(n) asm volatile("s_waitcnt vmcnt(" #n ")" ::: "memory")
#define PG8_WAIT_L(n) asm volatile("s_waitcnt lgkmcnt(" #n ")" ::: "memory")
#define PG8_BAR __builtin_amdgcn_s_barrier()
#define PG8_SCHED __builtin_amdgcn_sched_barrier(0)
    Unit cur, nxt; int ui = 0;
    if (!S.next(0, cur)) return;
    f32x4 acc[2][2][4][2];
#pragma unroll
    for (int a = 0; a < 2; ++a)
#pragma unroll
        for (int b = 0; b < 2; ++b)
#pragma unroll
            for (int m = 0; m < 4; ++m)
#pragma unroll
                for (int n = 0; n < 2; ++n) acc[a][b][m][n] = (f32x4){0.f, 0.f, 0.f, 0.f};
    bf16x8 At[4][2], B0[2][2], B1[2][2];
    const char* cA = (const char*)g.A + (size_t)cur.pm * tstepA; const char* cB = (const char*)g.Bt + (size_t)cur.e * besB + (size_t)cur.pn * tstepB;
    PG8_STAGE(PG8_SB(0, 0), cB, voffB); PG8_STAGE(PG8_SB(0, 1), cB + hstepB, voffB); PG8_STAGE(PG8_SA(0, 0), cA, voffA); PG8_STAGE(PG8_SA(0, 1), cA + hstepA, voffA);
    if (wr == 1) PG8_BAR;
    PG8_WAIT_V(2); PG8_BAR;
    PG8_STAGE(PG8_SB(1, 0), cB + kstep, voffB); PG8_STAGE(PG8_SA(1, 0), cA + kstep, voffA); PG8_STAGE(PG8_SB(1, 1), cB + hstepB + kstep, voffB);
    PG8_WAIT_V(6); PG8_BAR;
    for (;;) {
        const bool has_next = S.next(ui + 1, nxt);
        const char* nA = has_next ? (const char*)g.A + (size_t)nxt.pm * tstepA : cA; const char* nB = has_next ? (const char*)g.Bt + (size_t)nxt.e * besB + (size_t)nxt.pn * tstepB : cB;
        for (int t = 0; t < nt; t += 2) {
            const bool last = (t == nt - 2);
            const char* a1 = cA + (size_t)(t + 1) * kstep;
            const char* a2 = last ? nA : cA + (size_t)(t + 2) * kstep; const char* b2 = last ? nB : cB + (size_t)(t + 2) * kstep;
            const char* a3 = a2 + kstep; const char* b3 = b2 + kstep;
            PG8_LDB(B0, 0, 0); PG8_LDB(B1, 0, 1); PG8_SCHED; PG8_LDA(At, 0, 0); PG8_STAGE(PG8_SA(1, 1), a1 + hstepA, voffA);
            PG8_WAIT_V(8); PG8_WAIT_L(0); PG8_BAR; PG8_MMA(0, 0, At, B0); PG8_MMA(0, 1, At, B1); PG8_BAR; PG8_SCHED;
            PG8_LDA(At, 0, 1); PG8_STAGE(PG8_SB(0, 0), b2, voffB); PG8_STAGE(PG8_SB(0, 1), b2 + hstepB, voffB); PG8_STAGE(PG8_SA(0, 0), a2, voffA);
            PG8_WAIT_V(8); PG8_WAIT_L(0); PG8_BAR; PG8_MMA(1, 0, At, B0); PG8_MMA(1, 1, At, B1); PG8_BAR; PG8_SCHED;
            PG8_LDB(B0, 1, 0); PG8_LDB(B1, 1, 1); PG8_SCHED; PG8_LDA(At, 1, 0); PG8_STAGE(PG8_SA(0, 1), a2 + hstepA, voffA);
            PG8_WAIT_V(8); PG8_WAIT_L(0); PG8_BAR; PG8_MMA(0, 0, At, B0); PG8_MMA(0, 1, At, B1); PG8_BAR; PG8_SCHED;
            PG8_LDA(At, 1, 1); PG8_STAGE(PG8_SB(1, 0), b3, voffB); PG8_STAGE(PG8_SB(1, 1), b3 + hstepB, voffB); PG8_STAGE(PG8_SA(1, 0), a3, voffA);
            PG8_WAIT_V(8); PG8_WAIT_L(0); PG8_BAR; PG8_MMA(1, 0, At, B0); PG8_MMA(1, 1, At, B1); PG8_BAR; PG8_SCHED;
        }
        if (wr == 0) PG8_BAR;
        E(acc, cur, wr, wc, fr, fq);
        if (!has_next) break;
#pragma unroll
        for (int a = 0; a < 2; ++a)
#pragma unroll
            for (int b = 0; b < 2; ++b)
#pragma unroll
                for (int m = 0; m < 4; ++m)
#pragma unroll
                    for (int n = 0; n < 2; ++n) acc[a][b][m][n] = (f32x4){0.f, 0.f, 0.f, 0.f};
        cur = nxt; cA = nA; cB = nB; ++ui;
        if (wr == 1) PG8_BAR;
    }
    PG8_WAIT_V(0);
    PG8_BAR;
#undef PG8_SA
#undef PG8_SB
#undef PG8_STAGE
#undef PG8_LDA
#undef PG8_LDB
#undef PG8_MMA
#undef PG8_WAIT_V
#undef PG8_WAIT_L
#undef PG8_BAR
#undef PG8_SCHED
}
}
#define XB_TMO      128
#define XB_XCNT(j)  (256  + 64 * (j))
#define XB_XSUB(j)  (1280 + 64 * (j))
#define XB_XGEN(j)  (2304 + 64 * (j))
#define XB_TOP      3328
#define XB_TOPGEN   3392
#define XCD_BAR_WORDS 3456
#define XB_SPIN_CAP (1u << 18)
__device__ __forceinline__ unsigned xb_ld(unsigned* p)              { return __hip_atomic_load(p, __ATOMIC_RELAXED, __HIP_MEMORY_SCOPE_AGENT); }
__device__ __forceinline__ unsigned xb_add(unsigned* p, unsigned v) { return __hip_atomic_fetch_add(p, v, __ATOMIC_RELAXED, __HIP_MEMORY_SCOPE_AGENT); }
__device__ __forceinline__ unsigned xb_xcc_id() { return (unsigned)__builtin_amdgcn_s_getreg((3 << 11) | 20) & 0xFu; }
#define XB_SPIN(cond, bar) do { unsigned _sp = 0; while (cond) { __builtin_amdgcn_s_sleep(1); \
    if ((++_sp & 255u) == 0u) { if (xb_ld(&(bar)[XB_TMO])) break; if (_sp > XB_SPIN_CAP) { atomicAdd(&(bar)[XB_TMO], 1u); break; } } } } while (0)
struct XcdBarrier { unsigned* bar; unsigned x; volatile LAS unsigned* st; };
__device__ __forceinline__ XcdBarrier xcd_barrier_post(unsigned* bar, volatile LAS unsigned* st) {
    XcdBarrier b; b.bar = bar; b.x = xb_xcc_id(); b.st = st;
    if (threadIdx.x == 0) (void)xb_add(&bar[XB_XCNT(b.x)], 1u);
    return b;
}
__device__ __forceinline__ void xcd_barrier_complete(unsigned* bar, unsigned x, unsigned& nloc, unsigned& nx) {
    const unsigned G = gridDim.x * gridDim.y * gridDim.z;
    unsigned sum, cnt, mine, sp = 0u;
    for (;;) {
        sum = 0u; cnt = 0u; mine = 0u;
#pragma unroll
        for (unsigned j = 0; j < 16; ++j) { const unsigned c = xb_ld(&bar[XB_XCNT(j)]); sum += c; cnt += (c > 0u) ? 1u : 0u; mine = (j == x) ? c : mine; }
        if (sum == G) break;
        __builtin_amdgcn_s_sleep(1);
        if ((++sp & 255u) == 0u) { if (xb_ld(&bar[XB_TMO])) break; if (sp > XB_SPIN_CAP) { atomicAdd(&bar[XB_TMO], 1u); break; } }
    }
    nloc = mine > 0u ? mine : 1u; nx = cnt > 0u ? cnt : 1u;
}
__device__ __forceinline__ void xcd_barrier(const XcdBarrier& b) {
    asm volatile("s_waitcnt vmcnt(0)" ::: "memory");
    __syncthreads();
    if (threadIdx.x == 0) {
        unsigned* bar = b.bar;
        __builtin_amdgcn_s_waitcnt(0);
        unsigned nloc = b.st[0], nx = b.st[1];
        if (nloc == 0u) { xcd_barrier_complete(bar, b.x, nloc, nx); b.st[0] = nloc; b.st[1] = nx; }
        const unsigned old = xb_add(&bar[XB_XSUB(b.x)], 1u);
        const unsigned gen = old / nloc;
        if (old + 1u == (gen + 1u) * nloc) {
            __builtin_amdgcn_fence(__ATOMIC_RELEASE, "agent");
            asm volatile("s_waitcnt vmcnt(0)" ::: "memory");
            const unsigned og = xb_add(&bar[XB_TOP], 1u);
            const unsigned tg = og / nx;
            if (og + 1u == (tg + 1u) * nx) xb_add(&bar[XB_TOPGEN], 1u);
            else XB_SPIN(xb_ld(&bar[XB_TOPGEN]) == tg, bar);
            __builtin_amdgcn_fence(__ATOMIC_ACQUIRE, "agent");
            xb_add(&bar[XB_XGEN(b.x)], 1u);
            asm volatile("s_waitcnt vmcnt(0)" ::: "memory");
        } else {
            XB_SPIN(xb_ld(&bar[XB_XGEN(b.x)]) == gen, bar);
            __builtin_amdgcn_fence(__ATOMIC_ACQUIRE, "agent");
            asm volatile("s_waitcnt vmcnt(0)" ::: "memory");
        }
    }
    __syncthreads();
}

struct Frame {
    LAS unsigned char* lds;
    unsigned* ctl;
    unsigned char* ws;
    int tid, lane, wave, G, bid;
};
struct Args { const void* in[34]; float* out; unsigned char* ws; int ph_lo, ph_hi; };

enum { I_X = 0, I_POS, I_A_WIN, I_A_LNG, I_A_LNB, I_A_WS, I_A_BS, I_A_WOUT, I_B_WIN, I_B_WOUT, I_C_WIN, I_C_LB, I_C_NG, I_C_WOUT,
       I_D_WIN, I_D_QNG, I_D_WUQ, I_D_KVNG, I_D_WUKV, I_D_WOUT, I_F0_GU, I_F0_DN, I_M1_R, I_M1_GU, I_M1_DN, I_F2_GU, I_F2_DN, I_M3_R, I_M3_GU, I_M3_DN,
       I_LNM_G, I_LNM_B, I_LNF_G, I_LNF_B };

__device__ __forceinline__ void transpose_item(const float* W, int Kv, int Nv, int ldw, bf16* WT, int Kp, int mode, LAS float* scr, int kb, int nb, int lane) {
    const int k0 = 64 * kb, n0 = 32 * nb;
    const int nn = n0 + (lane & 31);
#pragma unroll 8
    for (int i = 0; i < 32; ++i) { const int kk = 2 * i + (lane >> 5); const int k = k0 + kk;
        scr[kk * 33 + (lane & 31)] = (k < Kv && nn < Nv) ? W[(size_t)k * ldw + nn] : 0.f; }
    LDS_WAIT(); asm volatile("" ::: "memory");
    int drow0;
    if (mode == 0) drow0 = n0; else { const int j = (n0 < FF) ? n0 : n0 - FF; drow0 = 256 * (j >> 7) + (j & 127) + ((n0 < FF) ? 0 : 128); }
    const int c = lane & 7;
#pragma unroll
    for (int j = 0; j < 4; ++j) { const int n = (lane >> 3) + 8 * j; const LAS float* s = scr + (8 * c) * 33 + n;
        u32x4 o; o.x = cvt_pk_bf16(s[0 * 33], s[1 * 33]); o.y = cvt_pk_bf16(s[2 * 33], s[3 * 33]); o.z = cvt_pk_bf16(s[4 * 33], s[5 * 33]); o.w = cvt_pk_bf16(s[6 * 33], s[7 * 33]);
        *(u32x4*)(WT + (size_t)(drow0 + n) * Kp + k0 + 8 * c) = o; }
    LDS_WAIT(); asm volatile("" ::: "memory");
}
__device__ __forceinline__ void convert_matrix(const Frame& F, const float* W, int Kv, int Nv, bf16* WT, int Kp, int Np, int mode, int nmat) {
    LAS float* scr = (LAS float*)(F.lds + F.wave * 16384);
    const int gw = F.bid * NWAVES + F.wave, NGW = F.G * NWAVES;
    const int nkb = Kp / 64, nnb = Np / 32, per = nkb * nnb;
    const long total = (long)per * nmat;
    for (long it = gw; it < total; it += NGW) {
        const int mat = (int)(it / per), r = (int)(it % per);
        const int kb = r / nnb, nb = r % nnb;
        transpose_item(W + (size_t)mat * Kv * Nv, Kv, Nv, Nv, WT + (size_t)mat * Kp * Np, Kp, mode, scr, kb, nb, F.lane);
    }
}

__device__ __forceinline__ void ln_row(f32x4 (&v)[4], const float* g, const float* b, int lane) {
    float s = 0.f;
#pragma unroll
    for (int j = 0; j < 4; ++j) s += (v[j].x + v[j].y) + (v[j].z + v[j].w);
    const float mean = wave_sum(s) * (1.f / D); float s2 = 0.f;
#pragma unroll
    for (int j = 0; j < 4; ++j) { v[j] = v[j] - mean; s2 += (v[j].x * v[j].x + v[j].y * v[j].y) + (v[j].z * v[j].z + v[j].w * v[j].w); }
    const float rstd = __builtin_amdgcn_rsqf(wave_sum(s2) * (1.f / D) + LN_EPS);
#pragma unroll
    for (int j = 0; j < 4; ++j) { const f32x4 gg = *(const f32x4*)(g + 4 * lane + 256 * j), bb = *(const f32x4*)(b + 4 * lane + 256 * j); v[j] = v[j] * rstd * gg + bb; }
}
__device__ __forceinline__ void store_row(const f32x4 (&v)[4], float* of, bf16* ob, int lane) {
#pragma unroll
    for (int j = 0; j < 4; ++j) { *(f32x4*)(of + 4 * lane + 256 * j) = v[j];
        u32x2 w; w.x = cvt_pk_bf16(v[j].x, v[j].y); w.y = cvt_pk_bf16(v[j].z, v[j].w); *(u32x2*)(ob + 4 * lane + 256 * j) = w; }
}
__device__ __forceinline__ void ln_phase(const Frame& F, float* xf, bf16* xb, const float* g, const float* b) {
    const int gw = F.bid * NWAVES + F.wave, NGW = F.G * NWAVES;
    for (int r = gw; r < M; r += NGW) {
        f32x4 v[4];
#pragma unroll
        for (int j = 0; j < 4; ++j) v[j] = *(const f32x4*)(xf + (size_t)r * D + 4 * F.lane + 256 * j);
        ln_row(v, g, b, F.lane);
        store_row(v, xf + (size_t)r * D, xb + (size_t)r * D, F.lane);
    }
}
__device__ __forceinline__ void ln_route_phase(const Frame& F, float* xf, bf16* xb, const float* g, const float* b, const float* wr, unsigned* cnt  ) {
    LAS float* WR = (LAS float*)F.lds;
    LAS int* EB = (LAS int*)(F.lds + 32768);
    LAS int* BASE = (LAS int*)(F.lds + 32768 + 512);
    for (int i = F.tid; i < D * NE / 4; i += NTHREADS) ((LAS f32x4*)WR)[i] = ((const f32x4*)wr)[i];
    __syncthreads();
    int* toke = (int*)(F.ws + S_TOKE); float* tokg = (float*)(F.ws + S_TOKG); int* slot = (int*)(F.ws + S_SLOT);
    for (int blk = F.bid; blk < M / 64; blk += F.G) {
        for (int i = 0; i < 8; ++i) {
            const int rl = F.wave * 8 + i, r = blk * 64 + rl;
            f32x4 v[4];
#pragma unroll
            for (int j = 0; j < 4; ++j) v[j] = *(const f32x4*)(xf + (size_t)r * D + 4 * F.lane + 256 * j);
            ln_row(v, g, b, F.lane);
            store_row(v, xf + (size_t)r * D, xb + (size_t)r * D, F.lane);
            float lg[NE];
#pragma unroll
            for (int e = 0; e < NE; ++e) lg[e] = 0.f;
#pragma unroll
            for (int j = 0; j < 4; ++j)
#pragma unroll
                for (int c = 0; c < 4; ++c) { const LAS f32x4* wp = (const LAS f32x4*)(WR + (size_t)(4 * F.lane + 256 * j + c) * NE); const f32x4 w0 = wp[0], w1 = wp[1]; const float xv = v[j][c];
                    lg[0] += xv * w0.x; lg[1] += xv * w0.y; lg[2] += xv * w0.z; lg[3] += xv * w0.w; lg[4] += xv * w1.x; lg[5] += xv * w1.y; lg[6] += xv * w1.z; lg[7] += xv * w1.w; }
#pragma unroll
            for (int e = 0; e < NE; ++e) lg[e] = wave_sum(lg[e]);
            int e0 = 0; float l0 = lg[0];
#pragma unroll
            for (int e = 1; e < NE; ++e) if (lg[e] > l0) { l0 = lg[e]; e0 = e; }
            int e1 = -1; float l1 = -3.0e38f;
#pragma unroll
            for (int e = 0; e < NE; ++e) if (e != e0 && lg[e] > l1) { l1 = lg[e]; e1 = e; }
            const float ex = __expf(l1 - l0), g0 = 1.f / (1.f + ex), g1 = ex * g0;
            if (F.lane == 0) { toke[2 * r] = e0; toke[2 * r + 1] = e1; tokg[2 * r] = g0; tokg[2 * r + 1] = g1; EB[2 * rl] = e0; EB[2 * rl + 1] = e1; }
        }
        __syncthreads();
        if (F.tid < NE) { int c = 0; for (int a = 0; a < 128; ++a) c += (EB[a] == F.tid) ? 1 : 0;
            BASE[F.tid] = (int)__hip_atomic_fetch_add(cnt + 64 * F.tid, (unsigned)c, __ATOMIC_RELAXED, __HIP_MEMORY_SCOPE_AGENT); }
        __syncthreads();
        if (F.tid < 128) { const int e = EB[F.tid]; int rank = 0; for (int a = 0; a < F.tid; ++a) rank += (EB[a] == e) ? 1 : 0;
            slot[(size_t)(blk * 64) * 2 + F.tid] = BASE[e] + rank; }
        __syncthreads();
    }
}
__device__ __forceinline__ int moe_segments(const unsigned* cnt, int (&cntv)[NE], int (&pstart)[NE], int (&pend)[NE]) {
    int acc = 0;
#pragma unroll
    for (int e = 0; e < NE; ++e) { cntv[e] = (int)__hip_atomic_load(cnt + 64 * e, __ATOMIC_RELAXED, __HIP_MEMORY_SCOPE_AGENT); pstart[e] = acc; acc += (cntv[e] + 255) & ~255; pend[e] = acc; }
    return acc;
}
__device__ __forceinline__ void moe_gather_phase(const Frame& F, const bf16* xb, bf16* xr, const unsigned* cnt) {
    int cntv[NE], pstart[NE], pend[NE]; moe_segments(cnt, cntv, pstart, pend);
    const int* toke = (const int*)(F.ws + S_TOKE); const float* tokg = (const float*)(F.ws + S_TOKG); const int* slot = (const int*)(F.ws + S_SLOT);
    int* rowtok = (int*)(F.ws + S_ROWTOK); float* rowgate = (float*)(F.ws + S_ROWGATE);
    const int gw = F.bid * NWAVES + F.wave, NGW = F.G * NWAVES;
    for (int a = gw; a < 2 * M; a += NGW) {
        const int e = toke[a]; int ps = 0;
#pragma unroll
        for (int j = 0; j < NE; ++j) ps = (e == j) ? pstart[j] : ps;
        const int dest = ps + slot[a]; const int t = a >> 1;
        const u32x4* src = (const u32x4*)(xb + (size_t)t * D); u32x4* dst = (u32x4*)(xr + (size_t)dest * D);
        dst[F.lane] = src[F.lane]; dst[F.lane + 64] = src[F.lane + 64];
        if (F.lane == 0) { rowtok[dest] = a; rowgate[dest] = tokg[a]; }
    }
    for (int i = gw; i < NE * 256; i += NGW) {
        const int e = i >> 8, j = i & 255; int ps = 0, cv = 0, pe = 0;
#pragma unroll
        for (int q = 0; q < NE; ++q) { ps = (e == q) ? pstart[q] : ps; cv = (e == q) ? cntv[q] : cv; pe = (e == q) ? pend[q] : pe; }
        const int r = ps + cv + j;
        if (r < pe) { u32x4* dst = (u32x4*)(xr + (size_t)r * D); const u32x4 z = (u32x4){0u, 0u, 0u, 0u}; dst[F.lane] = z; dst[F.lane + 64] = z; if (F.lane == 0) { rowtok[r] = -1; rowgate[r] = 0.f; } }
    }
}
__device__ __forceinline__ void ln_moe_phase(const Frame& F, const float* xf, const bf16* yk, float* outf, bf16* xb, const float* g, const float* b) {
    const int gw = F.bid * NWAVES + F.wave, NGW = F.G * NWAVES;
    for (int r = gw; r < M; r += NGW) {
        f32x4 v[4];
#pragma unroll
        for (int j = 0; j < 4; ++j) { const size_t o = (size_t)r * D + 4 * F.lane + 256 * j; const f32x4 x = *(const f32x4*)(xf + o);
            const u32x2 a = *(const u32x2*)(yk + o), c = *(const u32x2*)(yk + (size_t)M * D + o);
            v[j].x = x.x * ALPHA + bflo(a.x) + bflo(c.x); v[j].y = x.y * ALPHA + bfhi(a.x) + bfhi(c.x); v[j].z = x.z * ALPHA + bflo(a.y) + bflo(c.y); v[j].w = x.w * ALPHA + bfhi(a.y) + bfhi(c.y); }
        ln_row(v, g, b, F.lane);
        store_row(v, outf + (size_t)r * D, xb + (size_t)r * D, F.lane);
    }
}
__device__ __forceinline__ void cvt_rows_phase(const Frame& F, const float* x, bf16* xb) {
    const int gw = F.bid * NWAVES + F.wave, NGW = F.G * NWAVES;
    for (int r = gw; r < M; r += NGW) {
#pragma unroll
        for (int j = 0; j < 4; ++j) { const size_t o = (size_t)r * D + 4 * F.lane + 256 * j; const f32x4 v = *(const f32x4*)(x + o);
            u32x2 w; w.x = cvt_pk_bf16(v.x, v.y); w.y = cvt_pk_bf16(v.z, v.w); *(u32x2*)(xb + o) = w; }
    }
}
__device__ __forceinline__ void gmlp_stats_phase(const Frame& F, const bf16* uv, float* stats) {
    const int gw = F.bid * NWAVES + F.wave, NGW = F.G * NWAVES;
    for (int r = gw; r < M; r += NGW) {
        const u32x4* p = (const u32x4*)(uv + (size_t)r * 4096 + 2048);
        float x[32]; float s = 0.f;
#pragma unroll
        for (int j = 0; j < 4; ++j) { const u32x4 w = p[F.lane + 64 * j];
            x[8 * j + 0] = bflo(w.x); x[8 * j + 1] = bfhi(w.x); x[8 * j + 2] = bflo(w.y); x[8 * j + 3] = bfhi(w.y); x[8 * j + 4] = bflo(w.z); x[8 * j + 5] = bfhi(w.z); x[8 * j + 6] = bflo(w.w); x[8 * j + 7] = bfhi(w.w); }
#pragma unroll
        for (int i = 0; i < 32; ++i) s += x[i];
        const float mean = wave_sum(s) * (1.f / 2048.f); float s2 = 0.f;
#pragma unroll
        for (int i = 0; i < 32; ++i) { const float d = x[i] - mean; s2 += d * d; }
        const float rstd = __builtin_amdgcn_rsqf(wave_sum(s2) * (1.f / 2048.f) + LN_EPS);
        if (F.lane == 0) { stats[2 * r] = mean; stats[2 * r + 1] = rstd; }
    }
}
constexpr int GM_WS = 136, GM_VS = 136;
__device__ __forceinline__ void gmlp_spatial_phase(const Frame& F, const bf16* uv, const float* stats, const float* ws_in  , const float* bs  ,
                                                   const float* lng, const float* lnb, bf16* gated) {
    LAS bf16* Ws = (LAS bf16*)F.lds;
    LAS bf16* Vt = (LAS bf16*)(F.lds + 128 * GM_WS * 2);
    const int tid = F.tid, lane = F.lane, w = F.wave, wr = w >> 2, wc = w & 3, fr = lane & 15, fq = lane >> 4;
    for (int u = F.bid; u < 1024; u += F.G) {
        const int bc = u >> 3, g = u & 7; const size_t rowbase = (size_t)bc * 128;
        { const int t = tid >> 2, c0 = (tid & 3) * 32; const float* wp = ws_in + ((size_t)g * 128 + t) * 128 + c0;
#pragma unroll
            for (int q = 0; q < 4; ++q) { const f32x4 a = *(const f32x4*)(wp + 8 * q), b = *(const f32x4*)(wp + 8 * q + 4); const int s0 = c0 + 8 * q;
                u32x4 o; o.x = cvt_pk_bf16(s0 + 0 <= t ? a.x : 0.f, s0 + 1 <= t ? a.y : 0.f); o.y = cvt_pk_bf16(s0 + 2 <= t ? a.z : 0.f, s0 + 3 <= t ? a.w : 0.f);
                o.z = cvt_pk_bf16(s0 + 4 <= t ? b.x : 0.f, s0 + 5 <= t ? b.y : 0.f); o.w = cvt_pk_bf16(s0 + 6 <= t ? b.z : 0.f, s0 + 7 <= t ? b.w : 0.f);
                *(LAS u32x4*)(Ws + t * GM_WS + s0) = o; } }
        { const int so = tid & 15, dq = tid >> 4; const int col = 256 * g + 8 * dq;
            const f32x4 g0 = *(const f32x4*)(lng + col), g1 = *(const f32x4*)(lng + col + 4), b0 = *(const f32x4*)(lnb + col), b1 = *(const f32x4*)(lnb + col + 4);
            float vv[8][8];
#pragma unroll
            for (int j = 0; j < 8; ++j) { const size_t r = rowbase + 8 * so + j; const u32x4 wv = *(const u32x4*)(uv + r * 4096 + 2048 + col); const float mean = stats[2 * r], rstd = stats[2 * r + 1];
                vv[j][0] = (bflo(wv.x) - mean) * rstd * g0.x + b0.x; vv[j][1] = (bfhi(wv.x) - mean) * rstd * g0.y + b0.y; vv[j][2] = (bflo(wv.y) - mean) * rstd * g0.z + b0.z; vv[j][3] = (bfhi(wv.y) - mean) * rstd * g0.w + b0.w;
                vv[j][4] = (bflo(wv.z) - mean) * rstd * g1.x + b1.x; vv[j][5] = (bfhi(wv.z) - mean) * rstd * g1.y + b1.y; vv[j][6] = (bflo(wv.w) - mean) * rstd * g1.z + b1.z; vv[j][7] = (bfhi(wv.w) - mean) * rstd * g1.w + b1.w; }
#pragma unroll
            for (int dd = 0; dd < 8; ++dd) { u32x4 o; o.x = cvt_pk_bf16(vv[0][dd], vv[1][dd]); o.y = cvt_pk_bf16(vv[2][dd], vv[3][dd]); o.z = cvt_pk_bf16(vv[4][dd], vv[5][dd]); o.w = cvt_pk_bf16(vv[6][dd], vv[7][dd]);
                *(LAS u32x4*)(Vt + (8 * dq + dd) * GM_VS + 8 * so) = o; } }
        __syncthreads();
        f32x4 acc[4][4];
#pragma unroll
        for (int a = 0; a < 4; ++a)
#pragma unroll
            for (int b = 0; b < 4; ++b) acc[a][b] = (f32x4){0.f, 0.f, 0.f, 0.f};
        const int nks = wr ? 4 : 2;
        for (int ks = 0; ks < nks; ++ks) {
            bf16x8 wf[4], vf[4];
#pragma unroll
            for (int mt = 0; mt < 4; ++mt) wf[mt] = *(const LAS bf16x8*)(Ws + (64 * wr + 16 * mt + fr) * GM_WS + 32 * ks + 8 * fq);
#pragma unroll
            for (int nt = 0; nt < 4; ++nt) vf[nt] = *(const LAS bf16x8*)(Vt + (64 * wc + 16 * nt + fr) * GM_VS + 32 * ks + 8 * fq);
#pragma unroll
            for (int mt = 0; mt < 4; ++mt)
#pragma unroll
                for (int nt = 0; nt < 4; ++nt) acc[mt][nt] = __builtin_amdgcn_mfma_f32_16x16x32_bf16(vf[nt], wf[mt], acc[mt][nt], 0, 0, 0);
        }
#pragma unroll
        for (int mt = 0; mt < 4; ++mt) { const int tl = 64 * wr + 16 * mt + fr; const float bias = bs[g * 128 + tl]; const size_t r = rowbase + tl;
#pragma unroll
            for (int nt = 0; nt < 4; ++nt) { const int col = 256 * g + 64 * wc + 16 * nt + 4 * fq; const u32x2 uu = *(const u32x2*)(uv + r * 4096 + col);
                const f32x4 sv = acc[mt][nt] + bias;
                u32x2 o; o.x = cvt_pk_bf16(bflo(uu.x) * sv.x, bfhi(uu.x) * sv.y); o.y = cvt_pk_bf16(bflo(uu.y) * sv.z, bfhi(uu.y) * sv.w);
                *(u32x2*)(gated + r * 2048 + col) = o; } }
        __syncthreads();
    }
}
constexpr int PB_LD = 3584, PB_QI = 3072, PB_KI = 3328, PB_WI = 3392;
__device__ __forceinline__ unsigned sortable(float s) { const unsigned b = __float_as_uint(s + 0.0f); return b ^ ((b >> 31) ? 0xffffffffu : 0x80000000u); }
__device__ __forceinline__ void dsa_topk_phase(const Frame& F, const bf16* proj, u64* mask) {
    LAS unsigned* SC = (LAS unsigned*)F.lds;
    const int lane = F.lane, w = F.wave, fr = lane & 15, fq = lane >> 4;
    for (int it = 0; it < 1024 / 256 + 1; ++it) {
        const int idx = it * F.G + F.bid; if (idx >= 1024) break;
        const int b = idx >> 7, tq0 = idx & 127; const int tq = ((idx >> 8) & 1) ? 127 - tq0 : tq0;
        const int t0 = 16 * tq; const size_t rb = (size_t)b * SEQ;
        bf16x8 qf[4][2]; float wq[4];
        { const bf16* qp = proj + (rb + t0 + fr) * PB_LD;
#pragma unroll
            for (int h = 0; h < 4; ++h) {
#pragma unroll
                for (int ks = 0; ks < 2; ++ks) qf[h][ks] = *(const bf16x8*)(qp + PB_QI + 64 * h + 32 * ks + 8 * fq);
                wq[h] = bf2f(qp[PB_WI + h]); } }
        for (int kt = w; kt <= tq; kt += NWAVES) {
            const bf16* kp = proj + (rb + 16 * kt + fr) * PB_LD + PB_KI + 8 * fq;
            const bf16x8 kf0 = *(const bf16x8*)kp, kf1 = *(const bf16x8*)(kp + 32);
            f32x4 sc = (f32x4){0.f, 0.f, 0.f, 0.f};
#pragma unroll
            for (int h = 0; h < 4; ++h) { f32x4 d = (f32x4){0.f, 0.f, 0.f, 0.f};
                d = __builtin_amdgcn_mfma_f32_16x16x32_bf16(kf0, qf[h][0], d, 0, 0, 0); d = __builtin_amdgcn_mfma_f32_16x16x32_bf16(kf1, qf[h][1], d, 0, 0, 0);
                sc.x += wq[h] * fmaxf(d.x, 0.f); sc.y += wq[h] * fmaxf(d.y, 0.f); sc.z += wq[h] * fmaxf(d.z, 0.f); sc.w += wq[h] * fmaxf(d.w, 0.f); }
            u32x4 o; o.x = sortable(sc.x); o.y = sortable(sc.y); o.z = sortable(sc.z); o.w = sortable(sc.w);
            *(LAS u32x4*)(SC + fr * 2048 + 16 * kt + 4 * fq) = o;
        }
        __syncthreads();
        for (int qq = 0; qq < 2; ++qq) {
            const int ql = 2 * w + qq, t = t0 + ql;
            u64* mrow = mask + (rb + t) * 32;
            unsigned key[32];
#pragma unroll
            for (int j = 0; j < 32; ++j) { const int s = 64 * j + lane; key[j] = (s <= t) ? SC[ql * 2048 + s] : 0u; }
            unsigned T = 0u; int need = 0;
            if (t >= 256) {
                for (int bit = 31; bit >= 0; --bit) {
                    const unsigned cand = T | (1u << bit); int c = 0;
#pragma unroll
                    for (int j = 0; j < 32; ++j) c += __builtin_popcountll(__ballot(key[j] >= cand));
                    if (c >= 256) T = cand;
                }
                int ngt = 0;
#pragma unroll
                for (int j = 0; j < 32; ++j) ngt += __builtin_popcountll(__ballot(key[j] > T));
                need = 256 - ngt;
            }
            int running = 0;
#pragma unroll
            for (int j = 0; j < 32; ++j) {
                const bool adm = (64 * j + lane) <= t;
                const bool gt = key[j] > T, eq = (key[j] == T);
                const u64 eqm = __ballot(eq && adm);
                const int rank = running + __builtin_popcountll(eqm & ((1ull << lane) - 1ull));
                const bool sel = adm && (gt || (t < 256) || (eq && rank < need));
                const u64 word = __ballot(sel);
                running += __builtin_popcountll(eqm);
                if (lane == 0) mrow[j] = word;
            }
        }
        __syncthreads();
    }
}
template <int DK> struct AttnCfg { static constexpr int KP = DK + 8, VP = 72, KBYTES = 64 * KP * 2, VBYTES = 64 * VP * 2, BUF = KBYTES + VBYTES; };
struct AttnArgs { const bf16* Q; int ldq, qoff;
                  const bf16* K1; int ldk1, k1off, k1hs;
                  const bf16* K2; int ldk2;
                  const bf16* V; int ldv, voff, vhs;
                  bf16* O;
                  const u64* mask;
                  float scale_log2; };
__device__ __forceinline__ int crow(int r, int hi) { return (r & 3) + 8 * (r >> 2) + 4 * hi; }
template <int DK, bool MASKED>
__device__ __forceinline__ void attn_unit(const Frame& F, const AttnArgs& A, int b, int h, int qb) {
    typedef AttnCfg<DK> C;
    const int tid = F.tid, lane = F.lane, w = F.wave, r32 = lane & 31, hi = lane >> 5;
    const size_t rb = (size_t)b * SEQ; const int q0 = qb * 256, qrow = q0 + 32 * w + r32;
    const int NT = (q0 + 256) / 64;
    constexpr int NKS = DK / 16;
    bf16x8 qf[NKS];
    { const bf16* qp = A.Q + (rb + qrow) * A.ldq + A.qoff + h * DK + 8 * hi;
#pragma unroll
        for (int ks = 0; ks < NKS; ++ks) qf[ks] = *(const bf16x8*)(qp + 16 * ks); }
    const int skey = tid >> 3, sch = tid & 7;
    const int skey2 = (tid + 512) / 12, sch2 = (tid + 512) % 12;
    const int skey1 = (DK == 96) ? tid / 12 : skey, sch1 = (DK == 96) ? tid % 12 : sch;
    u32x4 kreg0, kreg1 = (u32x4){0u, 0u, 0u, 0u}, vreg; u64 mw = 0ull;
#define ATT_LOAD_TILE(kt_) do { const size_t kr = rb + 64 * (kt_); \
        if (DK == 64) { kreg0 = *(const u32x4*)(A.K1 + (kr + skey) * A.ldk1 + A.k1off + h * A.k1hs + 8 * sch); } \
        else { \
            kreg0 = (sch1 < 8) ? *(const u32x4*)(A.K1 + (kr + skey1) * A.ldk1 + A.k1off + h * A.k1hs + 8 * sch1) : *(const u32x4*)(A.K2 + (kr + skey1) * A.ldk2 + 8 * (sch1 - 8)); \
            if (tid < 256) kreg1 = (sch2 < 8) ? *(const u32x4*)(A.K1 + (kr + skey2) * A.ldk1 + A.k1off + h * A.k1hs + 8 * sch2) : *(const u32x4*)(A.K2 + (kr + skey2) * A.ldk2 + 8 * (sch2 - 8)); \
        } \
        vreg = *(const u32x4*)(A.V + (kr + skey) * A.ldv + A.voff + h * A.vhs + 8 * sch); \
        if (MASKED) mw = A.mask[(rb + qrow) * 32 + (kt_)]; } while (0)
#define ATT_STORE_TILE(buf_) do { LAS unsigned char* base = F.lds + (buf_) * C::BUF; \
        *(LAS u32x4*)(base + (skey1 * C::KP + 8 * sch1) * 2) = kreg0; \
        if (DK == 96) { if (tid < 256) *(LAS u32x4*)(base + (skey2 * C::KP + 8 * sch2) * 2) = kreg1; } \
        *(LAS u32x4*)(base + C::KBYTES + (skey * C::VP + 8 * sch) * 2) = vreg; } while (0)
    float m_run = -1.0e30f, l_run = 0.f; f32x16 o0 = {}, o1 = {};
    ATT_LOAD_TILE(0); u64 mcur = mw; ATT_STORE_TILE(0); __syncthreads();
    const int wq_max = q0 + 32 * w + 31, wq_min = q0 + 32 * w;
    for (int kt = 0; kt < NT; ++kt) {
        if (kt + 1 < NT) ATT_LOAD_TILE(kt + 1);
        if (64 * kt <= wq_max) {
            const LAS unsigned char* kb = F.lds + (kt & 1) * C::BUF; const LAS unsigned char* vb = kb + C::KBYTES;
            f32x16 p0 = {}, p1 = {};
#pragma unroll
            for (int ks = 0; ks < NKS; ++ks) {
                const bf16x8 a0 = *(const LAS bf16x8*)(kb + (r32 * C::KP + 16 * ks + 8 * hi) * 2), a1 = *(const LAS bf16x8*)(kb + ((32 + r32) * C::KP + 16 * ks + 8 * hi) * 2);
                p0 = __builtin_amdgcn_mfma_f32_32x32x16_bf16(a0, qf[ks], p0, 0, 0, 0); p1 = __builtin_amdgcn_mfma_f32_32x32x16_bf16(a1, qf[ks], p1, 0, 0, 0);
            }
            const float NEG = -1.0e30f;
            if (MASKED) { const unsigned lo = (unsigned)mcur >> (4 * hi), hh = (unsigned)(mcur >> 32) >> (4 * hi);
#pragma unroll
                for (int r = 0; r < 16; ++r) { const int bitp = (r & 3) + 8 * (r >> 2); p0[r] = ((lo >> bitp) & 1u) ? p0[r] * A.scale_log2 : NEG; p1[r] = ((hh >> bitp) & 1u) ? p1[r] * A.scale_log2 : NEG; }
            } else if (64 * kt + 63 > wq_min) {
#pragma unroll
                for (int r = 0; r < 16; ++r) { const int kv = 64 * kt + crow(r, hi); p0[r] = (kv <= qrow) ? p0[r] * A.scale_log2 : NEG; p1[r] = (kv + 32 <= qrow) ? p1[r] * A.scale_log2 : NEG; }
            } else {
#pragma unroll
                for (int r = 0; r < 16; ++r) { p0[r] *= A.scale_log2; p1[r] *= A.scale_log2; }
            }
            float mx = p0[0];
#pragma unroll
            for (int r = 1; r < 16; ++r) mx = fmaxf(mx, p0[r]);
#pragma unroll
            for (int r = 0; r < 16; ++r) mx = fmaxf(mx, p1[r]);
            { auto rr = __builtin_amdgcn_permlane32_swap(__float_as_uint(mx), __float_as_uint(mx), false, false); mx = fmaxf(__uint_as_float(rr[0]), __uint_as_float(rr[1])); }
            const float m_new = fmaxf(m_run, mx), alpha = fast_exp2(m_run - m_new); m_run = m_new;
            float ps = 0.f;
#pragma unroll
            for (int r = 0; r < 16; ++r) { p0[r] = fast_exp2(p0[r] - m_new); p1[r] = fast_exp2(p1[r] - m_new); ps += p0[r] + p1[r]; }
            l_run = l_run * alpha + ps;
#pragma unroll
            for (int r = 0; r < 16; ++r) { o0[r] *= alpha; o1[r] *= alpha; }
            bf16x8 pk[4];
#pragma unroll
            for (int s = 0; s < 2; ++s) {
                u32x4 a; a.x = cvt_pk_bf16(p0[8 * s + 0], p0[8 * s + 1]); a.y = cvt_pk_bf16(p0[8 * s + 2], p0[8 * s + 3]); a.z = cvt_pk_bf16(p0[8 * s + 4], p0[8 * s + 5]); a.w = cvt_pk_bf16(p0[8 * s + 6], p0[8 * s + 7]);
                u32x4 c; c.x = cvt_pk_bf16(p1[8 * s + 0], p1[8 * s + 1]); c.y = cvt_pk_bf16(p1[8 * s + 2], p1[8 * s + 3]); c.z = cvt_pk_bf16(p1[8 * s + 4], p1[8 * s + 5]); c.w = cvt_pk_bf16(p1[8 * s + 6], p1[8 * s + 7]);
                pk[s] = __builtin_bit_cast(bf16x8, a); pk[2 + s] = __builtin_bit_cast(bf16x8, c); }
            const int gi = (lane >> 4) & 1, q4 = (lane & 15) >> 2, p4 = lane & 3;
            const LAS unsigned char* vlane = vb + ((4 * hi + q4) * C::VP + 16 * gi + 4 * p4) * 2;
#pragma unroll
            for (int s4 = 0; s4 < 4; ++s4) {
#pragma unroll
                for (int db = 0; db < 2; ++db) {
                    const s16x4 lo4 = __builtin_bit_cast(s16x4, __builtin_amdgcn_ds_read_tr16_b64_v4i16((LAS s16x4*)(vlane + ((16 * s4) * C::VP + 32 * db) * 2)));
                    const s16x4 hi4 = __builtin_bit_cast(s16x4, __builtin_amdgcn_ds_read_tr16_b64_v4i16((LAS s16x4*)(vlane + ((16 * s4 + 8) * C::VP + 32 * db) * 2)));
                    const bf16x8 vf = (bf16x8){lo4[0], lo4[1], lo4[2], lo4[3], hi4[0], hi4[1], hi4[2], hi4[3]};
                    if (db == 0) o0 = __builtin_amdgcn_mfma_f32_32x32x16_bf16(vf, pk[s4], o0, 0, 0, 0); else o1 = __builtin_amdgcn_mfma_f32_32x32x16_bf16(vf, pk[s4], o1, 0, 0, 0);
                }
            }
        }
        if (kt + 1 < NT) { ATT_STORE_TILE((kt + 1) & 1); mcur = mw; }
        __syncthreads();
    }
    { auto rr = __builtin_amdgcn_permlane32_swap(__float_as_uint(l_run), __float_as_uint(l_run), false, false); l_run = __uint_as_float(rr[0]) + __uint_as_float(rr[1]); }
    const float inv = 1.0f / l_run;
    bf16* op = A.O + (rb + qrow) * D + h * 64 + 4 * hi;
#pragma unroll
    for (int g4 = 0; g4 < 4; ++g4) {
        u32x2 a; a.x = cvt_pk_bf16(o0[4 * g4 + 0] * inv, o0[4 * g4 + 1] * inv); a.y = cvt_pk_bf16(o0[4 * g4 + 2] * inv, o0[4 * g4 + 3] * inv);
        u32x2 c; c.x = cvt_pk_bf16(o1[4 * g4 + 0] * inv, o1[4 * g4 + 1] * inv); c.y = cvt_pk_bf16(o1[4 * g4 + 2] * inv, o1[4 * g4 + 3] * inv);
        *(u32x2*)(op + 8 * g4) = a; *(u32x2*)(op + 32 + 8 * g4) = c;
    }
}
#undef ATT_LOAD_TILE
#undef ATT_STORE_TILE
template <int DK, bool MASKED>
__device__ __forceinline__ void attn_phase(const Frame& F, const AttnArgs& A) {
    for (int i = 0; i < 4; ++i) {
        const int u = i * F.G + F.bid; if (u >= 1024) break;
        const int bh = u >> 3, qp = u & 7, qb = ((u >> 8) & 1) ? 7 - qp : qp;
        attn_unit<DK, MASKED>(F, A, bh >> 4, bh & 15, qb);
    }
}
constexpr int HG_QS = 136, HG_HS = 72, HG_VS = 72, HG_SS = 136;
constexpr int HG_QT = 0, HG_KT = HG_QT + 64 * HG_QS * 2, HG_KH = HG_KT + 64 * HG_QS * 2, HG_VT = HG_KH + 128 * HG_HS * 2, HG_SB = HG_VT + 32 * HG_VS * 2,
              HG_GL = HG_SB + 2 * 32 * HG_SS * 2, HG_SEG = HG_GL + 512, HG_END = HG_SEG + 4 * 128 * 4;
static_assert(HG_END <= RING_BYTES, "hgrn2 LDS");
__device__ __forceinline__ void hgrn2_scan_phase(const Frame& F, const bf16* proj, const float* lb_logits  , float* opre  ) {
    LAS bf16* Qt = (LAS bf16*)(F.lds + HG_QT); LAS bf16* Kt = (LAS bf16*)(F.lds + HG_KT); LAS bf16* Kh = (LAS bf16*)(F.lds + HG_KH); LAS bf16* Vt = (LAS bf16*)(F.lds + HG_VT);
    LAS bf16* Sb = (LAS bf16*)(F.lds + HG_SB); LAS float* GL = (LAS float*)(F.lds + HG_GL); LAS float* SEG = (LAS float*)(F.lds + HG_SEG);
    const int tid = F.tid, lane = F.lane, w = F.wave, fr = lane & 15, fq = lane >> 4;
    for (int u = F.bid; u < 256; u += F.G) {
        const int b = u >> 5, h = (u >> 2) & 7, vq = u & 3;
        const size_t rb = (size_t)b * SEQ;
        const int k = tid & 127, tseg = tid >> 7;
        float lbv; { const int c = 128 * h + k; const float a0 = lb_logits[c], a1 = lb_logits[1024 + c], a2 = lb_logits[2048 + c], a3 = lb_logits[3072 + c];
            const float mx = fmaxf(fmaxf(a0, a1), fmaxf(a2, a3)); const float e0 = __expf(a0 - mx), e1 = __expf(a1 - mx), e2 = __expf(a2 - mx), e3 = __expf(a3 - mx);
            lbv = (e1 + e2) / (e0 + e1 + e2 + e3); }
        f32x4 sacc[2]; sacc[0] = (f32x4){0.f, 0.f, 0.f, 0.f}; sacc[1] = sacc[0];
        for (int i = tid; i < 2 * 32 * HG_SS / 2; i += NTHREADS) ((LAS unsigned*)Sb)[i] = 0u;
        const int vt = w & 1, tt = w >> 1;
        for (int c = 0; c < 32; ++c) {
            const size_t r0 = rb + 64 * c;
            float gl[16], kk[16], qv[16];
            { const bf16* pp = proj + (r0 + 16 * tseg) * 4096 + 128 * h + k; float run = 0.f;
#pragma unroll
                for (int j = 0; j < 16; ++j) { const float fp = bf2f(pp[(size_t)j * 4096 + 1024]); qv[j] = bf2f(pp[(size_t)j * 4096]);
                    const float sg = sigmoidf_(fp); const float f = lbv + (1.f - lbv) * sg; kk[j] = (1.f - lbv) * (1.f - sg); run += __logf(f); gl[j] = run; }
                SEG[tseg * 128 + k] = run; }
            if (tid < 256) { const int so = tid & 7, v = tid >> 3; const bf16* vp = proj + (r0 + 8 * so) * 4096 + 2048 + 128 * h + 32 * vq + v;
                u32x4 o; o.x = (unsigned)vp[0] | ((unsigned)vp[4096] << 16); o.y = (unsigned)vp[2 * 4096] | ((unsigned)vp[3 * 4096] << 16);
                o.z = (unsigned)vp[4 * 4096] | ((unsigned)vp[5 * 4096] << 16); o.w = (unsigned)vp[6 * 4096] | ((unsigned)vp[7 * 4096] << 16);
                *(LAS u32x4*)(Vt + v * HG_VS + 8 * so) = o; }
            __syncthreads();
            { float off = 0.f, tot = 0.f;
#pragma unroll
                for (int s = 0; s < 4; ++s) { const float sv = SEG[s * 128 + k]; off += (s < tseg) ? sv : 0.f; tot += sv; }
                if (tseg == 0) GL[k] = tot;
                unsigned kh[8];
#pragma unroll
                for (int j = 0; j < 16; ++j) { const float G = off + gl[j]; const float eg = __expf(G);
                    const float qs = qv[j] * eg, ks = kk[j] * __expf(-G), khv = kk[j] * __expf(tot - G);
                    Qt[(16 * tseg + j) * HG_QS + k] = (bf16)(cvt_pk_bf16(qs, 0.f) & 0xffffu); Kt[(16 * tseg + j) * HG_QS + k] = (bf16)(cvt_pk_bf16(ks, 0.f) & 0xffffu);
                    if (j & 1) kh[j >> 1] = (kh[j >> 1] & 0xffffu) | (cvt_pk_bf16(0.f, khv) & 0xffff0000u); else kh[j >> 1] = cvt_pk_bf16(khv, 0.f) & 0xffffu; }
                *(LAS u32x4*)(Kh + k * HG_HS + 16 * tseg) = (u32x4){kh[0], kh[1], kh[2], kh[3]}; *(LAS u32x4*)(Kh + k * HG_HS + 16 * tseg + 8) = (u32x4){kh[4], kh[5], kh[6], kh[7]}; }
            __syncthreads();
            const LAS bf16* Sbc = Sb + (c & 1) * 32 * HG_SS; LAS bf16* Sbn = Sb + ((c + 1) & 1) * 32 * HG_SS;
            bf16x8 bq[4];
#pragma unroll
            for (int ks = 0; ks < 4; ++ks) bq[ks] = *(const LAS bf16x8*)(Qt + (16 * tt + fr) * HG_QS + 32 * ks + 8 * fq);
            f32x4 sc[4];
#pragma unroll
            for (int st = 0; st < 4; ++st) { sc[st] = (f32x4){0.f, 0.f, 0.f, 0.f};
                if (st <= tt) {
#pragma unroll
                    for (int ks = 0; ks < 4; ++ks) { const bf16x8 ka = *(const LAS bf16x8*)(Kt + (16 * st + fr) * HG_QS + 32 * ks + 8 * fq); sc[st] = __builtin_amdgcn_mfma_f32_16x16x32_bf16(ka, bq[ks], sc[st], 0, 0, 0); }
                    if (st == tt) {
#pragma unroll
                        for (int i = 0; i < 4; ++i) if (4 * fq + i > fr) sc[st][i] = 0.f; } } }
            f32x4 oacc = (f32x4){0.f, 0.f, 0.f, 0.f};
#pragma unroll
            for (int m = 0; m < 2; ++m) {
                u32x4 pw; pw.x = cvt_pk_bf16(sc[2 * m][0], sc[2 * m][1]); pw.y = cvt_pk_bf16(sc[2 * m][2], sc[2 * m][3]); pw.z = cvt_pk_bf16(sc[2 * m + 1][0], sc[2 * m + 1][1]); pw.w = cvt_pk_bf16(sc[2 * m + 1][2], sc[2 * m + 1][3]);
                const LAS bf16* vp = Vt + (16 * vt + fr) * HG_VS + 32 * m + 4 * fq;
                const u32x2 va = *(const LAS u32x2*)vp, vb = *(const LAS u32x2*)(vp + 16);
                const bf16x8 vf = __builtin_bit_cast(bf16x8, (u32x4){va.x, va.y, vb.x, vb.y});
                oacc = __builtin_amdgcn_mfma_f32_16x16x32_bf16(vf, __builtin_bit_cast(bf16x8, pw), oacc, 0, 0, 0);
            }
#pragma unroll
            for (int ks = 0; ks < 4; ++ks) { const bf16x8 sa = *(const LAS bf16x8*)(Sbc + (16 * vt + fr) * HG_SS + 32 * ks + 8 * fq); oacc = __builtin_amdgcn_mfma_f32_16x16x32_bf16(sa, bq[ks], oacc, 0, 0, 0); }
            *(f32x4*)(opre + (r0 + 16 * tt + fr) * D + 128 * h + 32 * vq + 16 * vt + 4 * fq) = oacc;
#pragma unroll
            for (int x = 0; x < 2; ++x) { const int kt = tt + 4 * x;
                const f32x4 dec = *(const LAS f32x4*)(GL + 16 * kt + 4 * fq);
                f32x4 a = sacc[x]; a.x *= __expf(dec.x); a.y *= __expf(dec.y); a.z *= __expf(dec.z); a.w *= __expf(dec.w);
#pragma unroll
                for (int m = 0; m < 2; ++m) { const bf16x8 ka = *(const LAS bf16x8*)(Kh + (16 * kt + fr) * HG_HS + 32 * m + 8 * fq), vbf = *(const LAS bf16x8*)(Vt + (16 * vt + fr) * HG_VS + 32 * m + 8 * fq);
                    a = __builtin_amdgcn_mfma_f32_16x16x32_bf16(ka, vbf, a, 0, 0, 0); }
                sacc[x] = a;
                u32x2 o; o.x = cvt_pk_bf16(a.x, a.y); o.y = cvt_pk_bf16(a.z, a.w);
                *(LAS u32x2*)(Sbn + (16 * vt + fr) * HG_SS + 16 * kt + 4 * fq) = o; }
            __syncthreads();
        }
    }
}
__device__ __forceinline__ void hgrn2_norm_phase(const Frame& F, const float* opre, const bf16* proj, const float* ng, bf16* ob) {
    const int gw = F.bid * NWAVES + F.wave, NGW = F.G * NWAVES, lane = F.lane;
    for (int r = gw; r < M; r += NGW) {
#pragma unroll
        for (int j = 0; j < 4; ++j) { const int col = 4 * lane + 256 * j; const f32x4 v = *(const f32x4*)(opre + (size_t)r * D + col);
            float ss = (v.x * v.x + v.y * v.y) + (v.z * v.z + v.w * v.w);
#pragma unroll
            for (int o = 1; o < 32; o <<= 1) ss += __shfl_xor(ss, o);
            const float rs = __builtin_amdgcn_rsqf(ss * (1.f / 128.f) + RMS_EPS);
            const f32x4 g4 = *(const f32x4*)(ng + (col & 127)); const u32x2 gt = *(const u32x2*)(proj + (size_t)r * 4096 + 3072 + col);
            u32x2 o; o.x = cvt_pk_bf16(v.x * rs * g4.x * siluf_(bflo(gt.x)), v.y * rs * g4.y * siluf_(bfhi(gt.x))); o.y = cvt_pk_bf16(v.z * rs * g4.z * siluf_(bflo(gt.y)), v.w * rs * g4.w * siluf_(bfhi(gt.y)));
            *(u32x2*)(ob + (size_t)r * D + col) = o; }
    }
}
__device__ __forceinline__ void mla_norm_phase(const Frame& F, const float* projd, const int* positions, const float* qg, const float* kvg, bf16* cq, bf16* ckv, bf16* kr, float* ang) {
    const int gw = F.bid * NWAVES + F.wave, NGW = F.G * NWAVES, lane = F.lane;
    for (int r = gw; r < M; r += NGW) {
        const f32x4 a = *(const f32x4*)(projd + (size_t)r * 512 + 8 * lane), c = *(const f32x4*)(projd + (size_t)r * 512 + 8 * lane + 4);
        float x[8] = {a.x, a.y, a.z, a.w, c.x, c.y, c.z, c.w};
        float ss = 0.f;
#pragma unroll
        for (int i = 0; i < 8; ++i) ss += x[i] * x[i];
        float s16 = ss;
#pragma unroll
        for (int o = 1; o < 16; o <<= 1) s16 += __shfl_xor(s16, o);
        const float s32 = s16 + __shfl_xor(s16, 16);
        float px[8];
#pragma unroll
        for (int i = 0; i < 8; ++i) px[i] = __shfl_xor(x[i], 2);
        if (lane < 32) {
            const float rs = __builtin_amdgcn_rsqf(s32 * (1.f / 256.f) + RMS_EPS);
            const f32x4 g0 = *(const f32x4*)(qg + 8 * lane), g1 = *(const f32x4*)(qg + 8 * lane + 4);
            u32x4 o; o.x = cvt_pk_bf16(x[0] * rs * g0.x, x[1] * rs * g0.y); o.y = cvt_pk_bf16(x[2] * rs * g0.z, x[3] * rs * g0.w); o.z = cvt_pk_bf16(x[4] * rs * g1.x, x[5] * rs * g1.y); o.w = cvt_pk_bf16(x[6] * rs * g1.z, x[7] * rs * g1.w);
            *(u32x4*)(cq + (size_t)r * 256 + 8 * lane) = o;
        } else if (lane < 48) {
            const int l2 = lane - 32; const float rs = __builtin_amdgcn_rsqf(s16 * (1.f / 128.f) + RMS_EPS);
            const f32x4 g0 = *(const f32x4*)(kvg + 8 * l2), g1 = *(const f32x4*)(kvg + 8 * l2 + 4);
            u32x4 o; o.x = cvt_pk_bf16(x[0] * rs * g0.x, x[1] * rs * g0.y); o.y = cvt_pk_bf16(x[2] * rs * g0.z, x[3] * rs * g0.w); o.z = cvt_pk_bf16(x[4] * rs * g1.x, x[5] * rs * g1.y); o.w = cvt_pk_bf16(x[6] * rs * g1.z, x[7] * rs * g1.w);
            *(u32x4*)(ckv + (size_t)r * 256 + 8 * l2) = o;
        } else {
            *(u32x4*)(ckv + (size_t)r * 256 + 128 + 8 * (lane - 48)) = (u32x4){0u, 0u, 0u, 0u};
            if (lane < 52) {
                const int l3 = lane - 48, i0 = 8 * (l3 & 1); const bool second = l3 >= 2; const float pos = (float)positions[r];
                float outv[8];
#pragma unroll
                for (int i = 0; i < 8; ++i) { const float invf = fast_exp2(-(float)(i0 + i) * (13.287712379549449f / 16.f)); const float an = pos * invf; float rev = an * 0.15915494309189535f; rev = rev - floorf(rev); const float cs = __builtin_amdgcn_cosf(rev), sn = __builtin_amdgcn_sinf(rev);
                    outv[i] = second ? (x[i] * cs + px[i] * sn) : (x[i] * cs - px[i] * sn);
                    if (!second) { ang[(size_t)r * 32 + 2 * (i0 + i)] = cs; ang[(size_t)r * 32 + 2 * (i0 + i) + 1] = sn; } }
                u32x4 o; o.x = cvt_pk_bf16(outv[0], outv[1]); o.y = cvt_pk_bf16(outv[2], outv[3]); o.z = cvt_pk_bf16(outv[4], outv[5]); o.w = cvt_pk_bf16(outv[6], outv[7]);
                *(u32x4*)(kr + (size_t)r * 32 + 8 * l3) = o;
            }
        }
    }
}
__device__ __forceinline__ void mla_qrope_phase(const Frame& F, bf16* q, const float* ang) {
    const int gw = F.bid * NWAVES + F.wave, NGW = F.G * NWAVES, lane = F.lane;
    const int hh = lane >> 2, part = lane & 3, i0 = 8 * (part & 1); const bool second = part >= 2;
    for (int r = gw; r < M; r += NGW) {
        bf16* p = q + (size_t)r * 1536 + 96 * hh + 64 + 8 * part;
        const u32x4 wv = *(const u32x4*)p;
        float x[8] = {bflo(wv.x), bfhi(wv.x), bflo(wv.y), bfhi(wv.y), bflo(wv.z), bfhi(wv.z), bflo(wv.w), bfhi(wv.w)};
        float outv[8];
#pragma unroll
        for (int i = 0; i < 8; ++i) { const float px = __shfl_xor(x[i], 2); const f32x2 cssn = *(const f32x2*)(ang + (size_t)r * 32 + 2 * (i0 + i));
            outv[i] = second ? (x[i] * cssn.x + px * cssn.y) : (x[i] * cssn.x - px * cssn.y); }
        u32x4 o; o.x = cvt_pk_bf16(outv[0], outv[1]); o.y = cvt_pk_bf16(outv[2], outv[3]); o.z = cvt_pk_bf16(outv[4], outv[5]); o.w = cvt_pk_bf16(outv[6], outv[7]);
        *(u32x4*)p = o;
    }
}
constexpr int NPHASE = 37;
#ifndef MK_ONE_LAUNCH
#define MK_ONE_LAUNCH 0
#endif
#ifndef MK_NRUN
#define MK_NRUN NPHASE
#endif
__global__ void __launch_bounds__(NTHREADS, 2) fwd_kernel(Args args) {
    extern __shared__ __attribute__((aligned(16))) unsigned char lds_raw[];
    Frame F;
    F.lds = (LAS unsigned char*)lds_raw;
    F.tid = threadIdx.x; F.lane = F.tid & 63; F.wave = __builtin_amdgcn_readfirstlane(F.tid >> 6);
    F.G = gridDim.x; F.bid = blockIdx.x;
    F.ws = args.ws; F.ctl = (unsigned*)(args.ws + WS_CTL);
    unsigned char* ws = args.ws;
    const int lo = args.ph_lo, hi = args.ph_hi;
    for (int u = F.tid; u < (LDS_BYTES - LDSCTL_OFF) / 4; u += NTHREADS) ((LAS unsigned*)(F.lds + LDSCTL_OFF))[u] = 0u;
    __syncthreads();
    XcdBarrier bar; bar.bar = F.ctl + CW_BAR; bar.x = 0; bar.st = nullptr;
    const bool multi = (hi - lo) > 1;
    if (multi) bar = xcd_barrier_post(F.ctl + CW_BAR, (volatile LAS unsigned*)(F.lds + LDSCTL_OFF + 64));
#define IN(k) (lo <= (k) && (k) < hi)
#define SEAM(k) do { if (IN(k) && IN((k) + 1)) xcd_barrier(bar); } while (0)
#define INP(i) ((const float*)args.in[i])
    float* XF = args.out;
    bf16* XB = (bf16*)(ws + WS_XB);
    bf16* H = (bf16*)(ws + B_H);
    bf16* OB = (bf16*)(ws + B_OB);
    bf16* XR = (bf16*)(ws + WS_R2); bf16* YK = (bf16*)(ws + WS_R2);
    LAS unsigned char* ring = F.lds;

#define GEMM(EpiT, Aptr, lda_, Bptr, Nn, Kk, epi) do { pg8::Gemm g_{(Aptr), (Bptr), M, (Nn), (Kk), (lda_), 0}; pg8::StaticOrder S_; S_.init(M, (Nn), F.G, F.bid); \
        pg8::gemm_phase<EpiT, pg8::StaticOrder>(ring, g_, S_, (epi)); } while (0)
#define FFN_DENSE(p0, WGU, WDN, lg, lb) do { \
        if (IN(p0)) { GEMM(pg8::EpiSwiGLU, XB, D, (const bf16*)(ws + (WGU)), 2 * FF, D, (pg8::EpiSwiGLU{H, FF})); } SEAM(p0); \
        if (IN((p0) + 1)) { GEMM(pg8::EpiResid, H, FF, (const bf16*)(ws + (WDN)), D, FF, (pg8::EpiResid{XF, XF, ALPHA})); } SEAM((p0) + 1); \
        if (IN((p0) + 2)) { ln_phase(F, XF, XB, (lg), (lb)); } SEAM((p0) + 2); } while (0)
#define FFN_MOE(p0, slot_, WR, WGU, WDN, lmg, lmb, lfg, lfb, OUTF) do { \
        unsigned* cnt_ = F.ctl + CW_CNT + (slot_) * 512; \
        if (IN(p0)) { ln_route_phase(F, XF, XB, (lmg), (lmb), (WR), cnt_); } SEAM(p0); \
        if (IN((p0) + 1)) { moe_gather_phase(F, XB, XR, cnt_); } SEAM((p0) + 1); \
        if (IN((p0) + 2)) { int cv_[NE], ps_[NE]; pg8::MoeOrder S_; const int rows_ = moe_segments(cnt_, cv_, ps_, S_.pend); S_.so.init(rows_, 2 * FF, F.G, F.bid); \
            pg8::Gemm g_{XR, (const bf16*)(ws + (WGU)), rows_, 2 * FF, D, D, (size_t)2 * FF * D}; pg8::gemm_phase<pg8::EpiSwiGLU, pg8::MoeOrder>(ring, g_, S_, pg8::EpiSwiGLU{H, FF}); } SEAM((p0) + 2); \
        if (IN((p0) + 3)) { int cv_[NE], ps_[NE]; pg8::MoeOrder S_; const int rows_ = moe_segments(cnt_, cv_, ps_, S_.pend); S_.so.init(rows_, D, F.G, F.bid); \
            pg8::Gemm g_{H, (const bf16*)(ws + (WDN)), rows_, D, FF, FF, (size_t)D * FF}; \
            pg8::gemm_phase<pg8::EpiMoeDown, pg8::MoeOrder>(ring, g_, S_, pg8::EpiMoeDown{YK, (const int*)(ws + S_ROWTOK), (const float*)(ws + S_ROWGATE)}); } SEAM((p0) + 3); \
        if (IN((p0) + 4)) { ln_moe_phase(F, XF, YK, (OUTF), XB, (lfg), (lfb)); } SEAM((p0) + 4); } while (0)

    if (IN(0)) {
        convert_matrix(F, INP(I_A_WIN), 1024, 4096, (bf16*)(ws + W_A_IN), 1024, 4096, 0, 1);
        convert_matrix(F, INP(I_A_WOUT), 2048, 1024, (bf16*)(ws + W_A_OUT), 2048, 1024, 0, 1);
        convert_matrix(F, INP(I_B_WIN), 1024, 3396, (bf16*)(ws + W_B_IN), 1024, 3584, 0, 1);
        convert_matrix(F, INP(I_B_WOUT), 1024, 1024, (bf16*)(ws + W_B_OUT), 1024, 1024, 0, 1);
        convert_matrix(F, INP(I_C_WIN), 1024, 4096, (bf16*)(ws + W_C_IN), 1024, 4096, 0, 1);
        convert_matrix(F, INP(I_C_WOUT), 1024, 1024, (bf16*)(ws + W_C_OUT), 1024, 1024, 0, 1);
        convert_matrix(F, INP(I_D_WIN), 1024, 416, (bf16*)(ws + W_D_IN), 1024, 512, 0, 1);
        convert_matrix(F, INP(I_D_WUQ), 256, 1536, (bf16*)(ws + W_D_UQ), 256, 1536, 0, 1);
        convert_matrix(F, INP(I_D_WUKV), 128, 2048, (bf16*)(ws + W_D_UKV), 256, 2048, 0, 1);
        convert_matrix(F, INP(I_D_WOUT), 1024, 1024, (bf16*)(ws + W_D_OUT), 1024, 1024, 0, 1);
        convert_matrix(F, INP(I_F0_GU), 1024, 2 * FF, (bf16*)(ws + W_F0_GU), 1024, 2 * FF, 1, 1);
        convert_matrix(F, INP(I_F0_DN), FF, 1024, (bf16*)(ws + W_F0_DN), FF, 1024, 0, 1);
        convert_matrix(F, INP(I_F2_GU), 1024, 2 * FF, (bf16*)(ws + W_F2_GU), 1024, 2 * FF, 1, 1);
        convert_matrix(F, INP(I_F2_DN), FF, 1024, (bf16*)(ws + W_F2_DN), FF, 1024, 0, 1);
        convert_matrix(F, INP(I_M1_GU), 1024, 2 * FF, (bf16*)(ws + W_M1_GU), 1024, 2 * FF, 1, NE);
        convert_matrix(F, INP(I_M1_DN), FF, 1024, (bf16*)(ws + W_M1_DN), FF, 1024, 0, NE);
        convert_matrix(F, INP(I_M3_GU), 1024, 2 * FF, (bf16*)(ws + W_M3_GU), 1024, 2 * FF, 1, NE);
        convert_matrix(F, INP(I_M3_DN), FF, 1024, (bf16*)(ws + W_M3_DN), FF, 1024, 0, NE);
        cvt_rows_phase(F, INP(I_X), XB);
    }
    SEAM(0);
    { bf16* UV = (bf16*)(ws + B_UV); bf16* GATED = (bf16*)(ws + B_GATED); float* STATS = (float*)(ws + S_STATS);
      if (IN(1)) { GEMM(pg8::EpiBf16<1>, XB, D, (const bf16*)(ws + W_A_IN), 4096, D, (pg8::EpiBf16<1>{UV, 4096})); } SEAM(1);
      if (IN(2)) { gmlp_stats_phase(F, UV, STATS); } SEAM(2);
      if (IN(3)) { gmlp_spatial_phase(F, UV, STATS, INP(I_A_WS), INP(I_A_BS), INP(I_A_LNG), INP(I_A_LNB), GATED); } SEAM(3);
      if (IN(4)) { GEMM(pg8::EpiResid, GATED, 2048, (const bf16*)(ws + W_A_OUT), D, 2048, (pg8::EpiResid{INP(I_X), XF, ALPHA})); } SEAM(4);
      if (IN(5)) { ln_phase(F, XF, XB, INP(I_LNM_G), INP(I_LNM_B)); } SEAM(5); }
    FFN_DENSE(6, W_F0_GU, W_F0_DN, INP(I_LNF_G), INP(I_LNF_B));
    { bf16* PROJ = (bf16*)(ws + B_PROJB); u64* MASK = (u64*)(ws + S_MASK);
      if (IN(9)) { GEMM(pg8::EpiBf16<0>, XB, D, (const bf16*)(ws + W_B_IN), 3584, D, (pg8::EpiBf16<0>{PROJ, 3584})); } SEAM(9);
      if (IN(10)) { dsa_topk_phase(F, PROJ, MASK); } SEAM(10);
      if (IN(11)) { AttnArgs A; A.Q = PROJ; A.ldq = PB_LD; A.qoff = 0; A.K1 = PROJ; A.ldk1 = PB_LD; A.k1off = 1024; A.k1hs = 64; A.K2 = nullptr; A.ldk2 = 0; A.V = PROJ; A.ldv = PB_LD; A.voff = 2048; A.vhs = 64;
          A.O = OB; A.mask = MASK; A.scale_log2 = 0.125f * 1.4426950408889634f; attn_phase<64, true>(F, A); } SEAM(11);
      if (IN(12)) { GEMM(pg8::EpiResid, OB, D, (const bf16*)(ws + W_B_OUT), D, D, (pg8::EpiResid{XF, XF, ALPHA})); } SEAM(12); }
    FFN_MOE(13, 0, INP(I_M1_R), W_M1_GU, W_M1_DN, INP(I_LNM_G) + D, INP(I_LNM_B) + D, INP(I_LNF_G) + D, INP(I_LNF_B) + D, XF);
    { bf16* PROJ = (bf16*)(ws + B_PROJC); float* OPRE = (float*)(ws + B_OPRE);
      if (IN(18)) { GEMM(pg8::EpiBf16<0>, XB, D, (const bf16*)(ws + W_C_IN), 4096, D, (pg8::EpiBf16<0>{PROJ, 4096})); } SEAM(18);
      if (IN(19)) { hgrn2_scan_phase(F, PROJ, INP(I_C_LB), OPRE); } SEAM(19);
      if (IN(20)) { hgrn2_norm_phase(F, OPRE, PROJ, INP(I_C_NG), OB); } SEAM(20);
      if (IN(21)) { GEMM(pg8::EpiResid, OB, D, (const bf16*)(ws + W_C_OUT), D, D, (pg8::EpiResid{XF, XF, ALPHA})); } SEAM(21);
      if (IN(22)) { ln_phase(F, XF, XB, INP(I_LNM_G) + 2 * D, INP(I_LNM_B) + 2 * D); } SEAM(22); }
    FFN_DENSE(23, W_F2_GU, W_F2_DN, INP(I_LNF_G) + 2 * D, INP(I_LNF_B) + 2 * D);
    { float* PROJD = (float*)(ws + B_PROJD); bf16* CQ = (bf16*)(ws + B_CQ); bf16* CKV = (bf16*)(ws + B_CKV); bf16* Q = (bf16*)(ws + B_Q); bf16* KV = (bf16*)(ws + B_KV);
      bf16* KR = (bf16*)(ws + S_KR); float* ANG = (float*)(ws + S_ANG);
      if (IN(26)) { GEMM(pg8::EpiF32, XB, D, (const bf16*)(ws + W_D_IN), 512, D, (pg8::EpiF32{PROJD, 512})); } SEAM(26);
      if (IN(27)) { mla_norm_phase(F, PROJD, (const int*)args.in[I_POS], INP(I_D_QNG), INP(I_D_KVNG), CQ, CKV, KR, ANG); } SEAM(27);
      if (IN(28)) { GEMM(pg8::EpiBf16<0>, CQ, 256, (const bf16*)(ws + W_D_UQ), 1536, 256, (pg8::EpiBf16<0>{Q, 1536}));
                    GEMM(pg8::EpiBf16<0>, CKV, 256, (const bf16*)(ws + W_D_UKV), 2048, 256, (pg8::EpiBf16<0>{KV, 2048})); } SEAM(28);
      if (IN(29)) { mla_qrope_phase(F, Q, ANG); } SEAM(29);
      if (IN(30)) { AttnArgs A; A.Q = Q; A.ldq = 1536; A.qoff = 0; A.K1 = KV; A.ldk1 = 2048; A.k1off = 0; A.k1hs = 128; A.K2 = KR; A.ldk2 = 32; A.V = KV; A.ldv = 2048; A.voff = 64; A.vhs = 128;
          A.O = OB; A.mask = nullptr; A.scale_log2 = 0.10206207261596577f * 1.4426950408889634f; attn_phase<96, false>(F, A); } SEAM(30);
      if (IN(31)) { GEMM(pg8::EpiResid, OB, D, (const bf16*)(ws + W_D_OUT), D, D, (pg8::EpiResid{XF, XF, ALPHA})); } SEAM(31); }
    FFN_MOE(32, 1, INP(I_M3_R), W_M3_GU, W_M3_DN, INP(I_LNM_G) + 3 * D, INP(I_LNM_B) + 3 * D, INP(I_LNF_G) + 3 * D, INP(I_LNF_B) + 3 * D, args.out);
#undef IN
#undef SEAM
}

extern "C" void kernel_launch(void* const* d_in, const int* in_sizes, int n_in, void* d_out, int out_size, void* d_ws, size_t ws_size, hipStream_t stream) {
    static int grid = 0;
    if (grid == 0) {
        if (n_in != 34 || out_size != M * D || ws_size < WS_END) { fprintf(stderr, "kernel_launch: unexpected problem (n_in %d, out %d, ws %zu < %zu)\n", n_in, out_size, ws_size, (size_t)WS_END); grid = -1; return; }
        int dev = 0, cus = 0;
        if (hipGetDevice(&dev) != hipSuccess || hipDeviceGetAttribute(&cus, hipDeviceAttributeMultiprocessorCount, dev) != hipSuccess) { grid = -1; return; }
        if (hipFuncSetAttribute((const void*)fwd_kernel, hipFuncAttributeMaxDynamicSharedMemorySize, LDS_BYTES) != hipSuccess) { fprintf(stderr, "kernel_launch: hipFuncSetAttribute failed\n"); grid = -1; return; }
        int per_cu = 0;
        if (hipOccupancyMaxActiveBlocksPerMultiprocessor(&per_cu, (const void*)fwd_kernel, NTHREADS, LDS_BYTES) != hipSuccess || per_cu < 1) fprintf(stderr, "kernel_launch: occupancy query reports %d\n", per_cu);
        (void)hipGetLastError();
        grid = cus;
    }
    if (grid < 0) return;
    if (hipMemsetAsync((char*)d_ws + WS_CTL, 0, CTL_ZERO_BYTES, stream) != hipSuccess) return;
    Args a{};
    for (int i = 0; i < 34; ++i) a.in[i] = d_in[i];
    a.out = (float*)d_out; a.ws = (unsigned char*)d_ws;
#if MK_ONE_LAUNCH
    a.ph_lo = 0; a.ph_hi = MK_NRUN;
    hipLaunchKernelGGL(fwd_kernel, dim3(grid), dim3(NTHREADS), LDS_BYTES, stream, a);
#else
    for (int p = 0; p < MK_NRUN; ++p) { a.ph_lo = p; a.ph_hi = p + 1; hipLaunchKernelGGL(fwd_kernel, dim3(grid), dim3(NTHREADS), LDS_BYTES, stream, a); }
#endif
}
```

```cpp
#include <hip/hip_runtime.h>
#include <cstdio>
#include <cstdint>

#define LAS __attribute__((address_space(3)))
#define GAS __attribute__((address_space(1)))
typedef unsigned short bf16;
typedef short bf16x8 __attribute__((ext_vector_type(8)));
typedef short s16x4 __attribute__((ext_vector_type(4)));
typedef float f32x2 __attribute__((ext_vector_type(2)));
typedef float f32x4 __attribute__((ext_vector_type(4)));
typedef float f32x16 __attribute__((ext_vector_type(16)));
typedef unsigned u32x2 __attribute__((ext_vector_type(2)));
typedef unsigned u32x4 __attribute__((ext_vector_type(4)));
typedef unsigned long long u64;

constexpr int NB = 8, SEQ = 2048, D = 1024, M = NB * SEQ;
constexpr int FF = 3584, NE = 8;
constexpr int MOE_ROWS = 34816;
constexpr float ALPHA = 1.6817928305074290f;
constexpr float LN_EPS = 1e-5f, RMS_EPS = 1e-6f;
constexpr int NWAVES = 8, NTHREADS = 512;

constexpr size_t MiB = 1u << 20;
constexpr size_t WS_CTL = 0, CTL_ZERO_BYTES = 1 * MiB;
constexpr size_t WS_W0 = 1 * MiB;
constexpr size_t W_A_IN = WS_W0;
constexpr size_t W_A_OUT = W_A_IN + 8 * MiB;
constexpr size_t W_B_IN = W_A_OUT + 4 * MiB;
constexpr size_t W_B_OUT = W_B_IN + 7 * MiB;
constexpr size_t W_C_IN = W_B_OUT + 2 * MiB;
constexpr size_t W_C_OUT = W_C_IN + 8 * MiB;
constexpr size_t W_D_IN = W_C_OUT + 2 * MiB;
constexpr size_t W_D_UQ = W_D_IN + 1 * MiB;
constexpr size_t W_D_UKV = W_D_UQ + 1 * MiB;
constexpr size_t W_D_OUT = W_D_UKV + 1 * MiB;
constexpr size_t W_F0_GU = W_D_OUT + 2 * MiB;
constexpr size_t W_F0_DN = W_F0_GU + 14 * MiB;
constexpr size_t W_F2_GU = W_F0_DN + 7 * MiB;
constexpr size_t W_F2_DN = W_F2_GU + 14 * MiB;
constexpr size_t W_M1_GU = W_F2_DN + 7 * MiB;
constexpr size_t W_M1_DN = W_M1_GU + 112 * MiB;
constexpr size_t W_M3_GU = W_M1_DN + 56 * MiB;
constexpr size_t W_M3_DN = W_M3_GU + 112 * MiB;
constexpr size_t WS_WEND = W_M3_DN + 56 * MiB;
constexpr size_t WS_XB = WS_WEND;
constexpr size_t WS_SMALL = WS_XB + 32 * MiB;
constexpr size_t S_STATS = WS_SMALL;
constexpr size_t S_TOKE = WS_SMALL + 128 * 1024;
constexpr size_t S_TOKG = WS_SMALL + 256 * 1024;
constexpr size_t S_SLOT = WS_SMALL + 384 * 1024;
constexpr size_t S_ROWTOK = WS_SMALL + 512 * 1024;
constexpr size_t S_ROWGATE = WS_SMALL + 768 * 1024;
constexpr size_t S_ANG = WS_SMALL + 1 * MiB;
constexpr size_t S_KR = WS_SMALL + 3 * MiB;
constexpr size_t S_MASK = WS_SMALL + 4 * MiB;
constexpr size_t WS_BIG = WS_SMALL + 8 * MiB;
constexpr size_t WS_R2 = WS_BIG + 238 * MiB;
constexpr size_t WS_END = WS_R2 + 68 * MiB;
static_assert(WS_WEND == 415 * MiB, "weight map");
static_assert(WS_END <= 880 * MiB, "workspace budget");
constexpr size_t B_UV = WS_BIG, B_GATED = WS_BIG + 128 * MiB;
constexpr size_t B_PROJB = WS_BIG, B_OB = WS_BIG + 192 * MiB;
constexpr size_t B_PROJC = WS_BIG, B_OPRE = WS_BIG + 128 * MiB;
constexpr size_t B_PROJD = WS_BIG, B_CQ = WS_BIG + 32 * MiB, B_CKV = WS_BIG + 40 * MiB, B_Q = WS_BIG + 48 * MiB, B_KV = WS_BIG + 96 * MiB;
constexpr size_t B_H = WS_BIG;
constexpr int CW_BAR = 4096;
constexpr int CW_CNT = 16384;

constexpr int RING_BYTES = 131072;
constexpr int LDSCTL_OFF = RING_BYTES;
constexpr int LDS_BYTES = 147456;

typedef __bf16 bf16x2_t __attribute__((ext_vector_type(2)));
__device__ __forceinline__ unsigned cvt_pk_bf16(float lo, float hi) { const f32x2 v = {lo, hi}; const bf16x2_t b = __builtin_convertvector(v, bf16x2_t); return __builtin_bit_cast(unsigned, b); }
__device__ __forceinline__ float bf2f(unsigned short b) { return __uint_as_float((unsigned)b << 16); }
__device__ __forceinline__ float bflo(unsigned w) { return __uint_as_float(w << 16); }
__device__ __forceinline__ float bfhi(unsigned w) { return __uint_as_float(w & 0xffff0000u); }
__device__ __forceinline__ float fast_exp2(float x) { return __builtin_amdgcn_exp2f(x); }
__device__ __forceinline__ float fast_rcp(float x) { return __builtin_amdgcn_rcpf(x); }
__device__ __forceinline__ float sigmoidf_(float x) { return fast_rcp(1.0f + fast_exp2(-1.4426950408889634f * x)); }
__device__ __forceinline__ float siluf_(float x) { return x * sigmoidf_(x); }
__device__ __forceinline__ float gelu_tanh(float x) { const float u = x + 0.044715f * x * x * x; return x * fast_rcp(1.0f + fast_exp2(-2.302208198f * u)); }
__device__ __forceinline__ float wave_sum(float v) {
#pragma unroll
    for (int o = 1; o < 64; o <<= 1) v += __shfl_xor(v, o);
    return v;
}
#define LDS_WAIT() asm volatile("s_waitcnt lgkmcnt(0)" ::: "memory")
#define VM_WAIT() asm volatile("s_waitcnt vmcnt(0)" ::: "memory")
namespace pg8 {
constexpr int BM = 256, BK = 64, HALF = 128, HTB = HALF * BK * 2  , STAGE_BYTES = 8 * HTB, NXCD = 8, WGM = 8;
__host__ __device__ __forceinline__ int lds_byte(int r, int c) { const int st = (r >> 4) * 2 + (c >> 5), rr = r & 15, cc = c & 31, ob = rr * 64 + cc * 2; return st * 1024 + (ob ^ (((ob >> 9) & 1) << 5)); }
__host__ __device__ __forceinline__ void stage_rc(int b, int& R, int& C) { const int st = b / 1024, sb = b % 1024, swz = sb ^ (((sb >> 9) & 1) << 5); R = (st >> 1) * 16 + swz / 64; C = (st & 1) * 32 + (swz % 64) / 2; }
__host__ __device__ __forceinline__ int perm32(int rho) { const int n = rho >> 4, i = rho & 15; return 8 * (i >> 2) + 4 * n + (i & 3); }

struct Unit { int pm, pn, e; };
struct Gemm { const bf16* A; const bf16* Bt; int M, N, K, lda; size_t bes; };

struct StaticOrder {
    int nM, nN, nwg, G, c;
    __device__ void init(int M_, int N_, int G_, int c_) { nM = M_ / BM; nN = N_ / BM; nwg = nM * nN; G = G_; c = c_; }
    __device__ bool next(int i, Unit& u) const {
        const long L = (long)i * G + c; if (L >= nwg) return false;
        int wgid = (int)L; { const int q = nwg / NXCD, r = nwg % NXCD, xcd = wgid % NXCD, off = wgid / NXCD; wgid = (xcd < r ? xcd * (q + 1) : r * (q + 1) + (xcd - r) * q) + off; }
        const int nig = WGM * nN, gid = wgid / nig, fm = gid * WGM, gsz = (nM - fm) < WGM ? (nM - fm) : WGM;
        u.pm = fm + ((wgid % nig) % gsz); u.pn = (wgid % nig) / gsz; u.e = 0; return true;
    }
};
struct MoeOrder {
    StaticOrder so; int pend[NE];
    __device__ bool next(int i, Unit& u) const {
        if (!so.next(i, u)) return false;
        const int r0 = u.pm * BM; int e = 0;
#pragma unroll
        for (int j = 0; j < NE - 1; ++j) e += (r0 >= pend[j]) ? 1 : 0;
        u.e = e; return true;
    }
};

template <int ACT  > struct EpiBf16 {
    static constexpr bool PERM = true;
    bf16* O; int ldc;
    __device__ __forceinline__ void operator()(const f32x4 (&acc)[2][2][4][2], const Unit& u, int wr, int wc, int fr, int fq) const {
        const int row0 = u.pm * BM + wr * 64 + fr, col0 = u.pn * BM + wc * 32 + 8 * fq;
#pragma unroll
        for (int ai = 0; ai < 2; ++ai)
#pragma unroll
            for (int m = 0; m < 4; ++m) { bf16* rowp = O + (size_t)(row0 + ai * HALF + m * 16) * ldc + col0;
#pragma unroll
                for (int bj = 0; bj < 2; ++bj) { f32x4 v0 = acc[ai][bj][m][0], v1 = acc[ai][bj][m][1];
                    if (ACT == 1) { v0 = (f32x4){gelu_tanh(v0[0]), gelu_tanh(v0[1]), gelu_tanh(v0[2]), gelu_tanh(v0[3])}; v1 = (f32x4){gelu_tanh(v1[0]), gelu_tanh(v1[1]), gelu_tanh(v1[2]), gelu_tanh(v1[3])}; }
                    u32x4 w; w.x = cvt_pk_bf16(v0[0], v0[1]); w.y = cvt_pk_bf16(v0[2], v0[3]); w.z = cvt_pk_bf16(v1[0], v1[1]); w.w = cvt_pk_bf16(v1[2], v1[3]);
                    *(u32x4*)(rowp + bj * HALF) = w; } }
    }
};
struct EpiSwiGLU {
    static constexpr bool PERM = true;
    bf16* H; int ldh;
    __device__ __forceinline__ void operator()(const f32x4 (&acc)[2][2][4][2], const Unit& u, int wr, int wc, int fr, int fq) const {
        const int row0 = u.pm * BM + wr * 64 + fr, col0 = u.pn * HALF + wc * 32 + 8 * fq;
#pragma unroll
        for (int ai = 0; ai < 2; ++ai)
#pragma unroll
            for (int m = 0; m < 4; ++m) { bf16* rowp = H + (size_t)(row0 + ai * HALF + m * 16) * ldh + col0;
                const f32x4 g0 = acc[ai][0][m][0], g1 = acc[ai][0][m][1], u0 = acc[ai][1][m][0], u1 = acc[ai][1][m][1];
                u32x4 w; w.x = cvt_pk_bf16(siluf_(g0[0]) * u0[0], siluf_(g0[1]) * u0[1]); w.y = cvt_pk_bf16(siluf_(g0[2]) * u0[2], siluf_(g0[3]) * u0[3]);
                w.z = cvt_pk_bf16(siluf_(g1[0]) * u1[0], siluf_(g1[1]) * u1[1]); w.w = cvt_pk_bf16(siluf_(g1[2]) * u1[2], siluf_(g1[3]) * u1[3]);
                *(u32x4*)rowp = w; }
    }
};
struct EpiResid {
    static constexpr bool PERM = false;
    const float* X; float* Y; float alpha;
    __device__ __forceinline__ void operator()(const f32x4 (&acc)[2][2][4][2], const Unit& u, int wr, int wc, int fr, int fq) const {
        const int row0 = u.pm * BM + wr * 64 + fr, col0 = u.pn * BM + wc * 32 + 4 * fq;
#pragma unroll
        for (int ai = 0; ai < 2; ++ai)
#pragma unroll
            for (int m = 0; m < 4; ++m) { const size_t off = (size_t)(row0 + ai * HALF + m * 16) * D + col0;
#pragma unroll
                for (int bj = 0; bj < 2; ++bj)
#pragma unroll
                    for (int n = 0; n < 2; ++n) { const f32x4 xv = *(const f32x4*)(X + off + bj * HALF + n * 16); *(f32x4*)(Y + off + bj * HALF + n * 16) = xv * alpha + acc[ai][bj][m][n]; } }
    }
};
struct EpiF32 {
    static constexpr bool PERM = false;
    float* C; int ldc;
    __device__ __forceinline__ void operator()(const f32x4 (&acc)[2][2][4][2], const Unit& u, int wr, int wc, int fr, int fq) const {
        const int row0 = u.pm * BM + wr * 64 + fr, col0 = u.pn * BM + wc * 32 + 4 * fq;
#pragma unroll
        for (int ai = 0; ai < 2; ++ai)
#pragma unroll
            for (int m = 0; m < 4; ++m) { float* rowp = C + (size_t)(row0 + ai * HALF + m * 16) * ldc + col0;
#pragma unroll
                for (int bj = 0; bj < 2; ++bj)
#pragma unroll
                    for (int n = 0; n < 2; ++n) *(f32x4*)(rowp + bj * HALF + n * 16) = acc[ai][bj][m][n]; }
    }
};
struct EpiMoeDown {
    static constexpr bool PERM = true;
    bf16* YK; const int* rowtok; const float* rowgate;
    __device__ __forceinline__ void operator()(const f32x4 (&acc)[2][2][4][2], const Unit& u, int wr, int wc, int fr, int fq) const {
        const int row0 = u.pm * BM + wr * 64 + fr, col0 = u.pn * BM + wc * 32 + 8 * fq;
#pragma unroll
        for (int ai = 0; ai < 2; ++ai)
#pragma unroll
            for (int m = 0; m < 4; ++m) { const int r = row0 + ai * HALF + m * 16; const int rt = rowtok[r]; const float gt = rowgate[r];
                if (rt >= 0) { bf16* rowp = YK + (size_t)(rt & 1) * ((size_t)M * D) + (size_t)(rt >> 1) * D + col0;
#pragma unroll
                    for (int bj = 0; bj < 2; ++bj) { const f32x4 v0 = acc[ai][bj][m][0] * gt, v1 = acc[ai][bj][m][1] * gt;
                        u32x4 w; w.x = cvt_pk_bf16(v0[0], v0[1]); w.y = cvt_pk_bf16(v0[2], v0[3]); w.z = cvt_pk_bf16(v1[0], v1[1]); w.w = cvt_pk_bf16(v1[2], v1[3]);
                        *(u32x4*)(rowp + bj * HALF) = w; } } }
    }
};

template <class Epi, class Sched>
__device__ __forceinline__ void gemm_phase(LAS unsigned char* lds, const Gemm g, const Sched& S, const Epi& E) {
    const int tid = threadIdx.x, wid = __builtin_amdgcn_readfirstlane(tid >> 6), lane = tid & 63, wr = wid >> 2, wc = wid & 3, fr = lane & 15, fq = lane >> 4;
    const int K = g.K, nt = K / BK;
    unsigned voffA[2], voffB[2];
#pragma unroll
    for (int i = 0; i < 2; ++i) { int R, C; stage_rc(tid * 16 + i * 8192, R, C); const int Rb = Epi::PERM ? ((R & ~31) + perm32(R & 31)) : R;
        voffA[i] = (unsigned)(R * g.lda + C) * 2u; voffB[i] = (unsigned)(Rb * K + C) * 2u; }
    const size_t kstep = (size_t)(BK * 2);
    const size_t hstepA = (size_t)HALF * g.lda * 2, tstepA = 2 * hstepA;
    const size_t hstepB = (size_t)HALF * K * 2, tstepB = 2 * hstepB;
    const size_t besB = g.bes * 2;
    const unsigned ldsw = (unsigned)wid * 1024u;
    const int aoff = lds_byte(wr * 64 + fr, fq * 8), boff = lds_byte(wc * 32 + fr, fq * 8);
#define PG8_SA(b, h) (((b) * 2 + (h)) * HTB)
#define PG8_SB(b, h) ((4 + (b) * 2 + (h)) * HTB)
#define PG8_STAGE(bufoff, gbase, voff) do { _Pragma("unroll") for (int _i = 0; _i < 2; ++_i) \
        __builtin_amdgcn_global_load_lds((const unsigned*)((const char*)(gbase) + (voff)[_i]), (LAS unsigned*)(lds + (bufoff) + ldsw + _i * 8192), 16, 0, 0); } while (0)
#define PG8_LDA(dst, b, h) do { _Pragma("unroll") for (int m = 0; m < 4; ++m) _Pragma("unroll") for (int k = 0; k < 2; ++k) dst[m][k] = *(const LAS bf16x8*)(lds + PG8_SA(b, h) + aoff + m * 2048 + k * 1024); } while (0)
#define PG8_LDB(dst, b, h) do { _Pragma("unroll") for (int n = 0; n < 2; ++n) _Pragma("unroll") for (int k = 0; k < 2; ++k) dst[n][k] = *(const LAS bf16x8*)(lds + PG8_SB(b, h) + boff + n * 2048 + k * 1024); } while (0)
#define PG8_MMA(ai, bj, At, Bt) do { __builtin_amdgcn_s_setprio(1); _Pragma("unroll") for (int m = 0; m < 4; ++m) _Pragma("unroll") for (int n = 0; n < 2; ++n) _Pragma("unroll") for (int k = 0; k < 2; ++k) \
        acc[ai][bj][m][n] = __builtin_amdgcn_mfma_f32_16x16x32_bf16(Bt[n][k], At[m][k], acc[ai][bj][m][n], 0, 0, 0); __builtin_amdgcn_s_setprio(0); } while (0)
#define PG8_WAIT_V(n) asm volatile("s_waitcnt vmcnt(" #n ")" ::: "memory")
#define PG8_WAIT_L(n) asm volatile("s_waitcnt lgkmcnt(" #n ")" ::: "memory")
#define PG8_BAR __builtin_amdgcn_s_barrier()
#define PG8_SCHED __builtin_amdgcn_sched_barrier(0)
    Unit cur, nxt; int ui = 0;
    if (!S.next(0, cur)) return;
    f32x4 acc[2][2][4][2];
#pragma unroll
    for (int a = 0; a < 2; ++a)
#pragma unroll
        for (int b = 0; b < 2; ++b)
#pragma unroll
            for (int m = 0; m < 4; ++m)
#pragma unroll
                for (int n = 0; n < 2; ++n) acc[a][b][m][n] = (f32x4){0.f, 0.f, 0.f, 0.f};
    bf16x8 At[4][2], B0[2][2], B1[2][2];
    const char* cA = (const char*)g.A + (size_t)cur.pm * tstepA; const char* cB = (const char*)g.Bt + (size_t)cur.e * besB + (size_t)cur.pn * tstepB;
    PG8_STAGE(PG8_SB(0, 0), cB, voffB); PG8_STAGE(PG8_SB(0, 1), cB + hstepB, voffB); PG8_STAGE(PG8_SA(0, 0), cA, voffA); PG8_STAGE(PG8_SA(0, 1), cA + hstepA, voffA);
    if (wr == 1) PG8_BAR;
    PG8_WAIT_V(2); PG8_BAR;
    PG8_STAGE(PG8_SB(1, 0), cB + kstep, voffB); PG8_STAGE(PG8_SA(1, 0), cA + kstep, voffA); PG8_STAGE(PG8_SB(1, 1), cB + hstepB + kstep, voffB);
    PG8_WAIT_V(6); PG8_BAR;
    for (;;) {
        const bool has_next = S.next(ui + 1, nxt);
        const char* nA = has_next ? (const char*)g.A + (size_t)nxt.pm * tstepA : cA; const char* nB = has_next ? (const char*)g.Bt + (size_t)nxt.e * besB + (size_t)nxt.pn * tstepB : cB;
        for (int t = 0; t < nt; t += 2) {
            const bool last = (t == nt - 2);
            const char* a1 = cA + (size_t)(t + 1) * kstep;
            const char* a2 = last ? nA : cA + (size_t)(t + 2) * kstep; const char* b2 = last ? nB : cB + (size_t)(t + 2) * kstep;
            const char* a3 = a2 + kstep; const char* b3 = b2 + kstep;
            PG8_LDB(B0, 0, 0); PG8_LDB(B1, 0, 1); PG8_SCHED; PG8_LDA(At, 0, 0); PG8_STAGE(PG8_SA(1, 1), a1 + hstepA, voffA);
            PG8_WAIT_V(8); PG8_WAIT_L(0); PG8_BAR; PG8_MMA(0, 0, At, B0); PG8_MMA(0, 1, At, B1); PG8_BAR; PG8_SCHED;
            PG8_LDA(At, 0, 1); PG8_STAGE(PG8_SB(0, 0), b2, voffB); PG8_STAGE(PG8_SB(0, 1), b2 + hstepB, voffB); PG8_STAGE(PG8_SA(0, 0), a2, voffA);
            PG8_WAIT_V(8); PG8_WAIT_L(0); PG8_BAR; PG8_MMA(1, 0, At, B0); PG8_MMA(1, 1, At, B1); PG8_BAR; PG8_SCHED;
            PG8_LDB(B0, 1, 0); PG8_LDB(B1, 1, 1); PG8_SCHED; PG8_LDA(At, 1, 0); PG8_STAGE(PG8_SA(0, 1), a2 + hstepA, voffA);
            PG8_WAIT_V(8); PG8_WAIT_L(0); PG8_BAR; PG8_MMA(0, 0, At, B0); PG8_MMA(0, 1, At, B1); PG8_BAR; PG8_SCHED;
            PG8_LDA(At, 1, 1); PG8_STAGE(PG8_SB(1, 0), b3, voffB); PG8_STAGE(PG8_SB(1, 1), b3 + hstepB, voffB); PG8_STAGE(PG8_SA(1, 0), a3, voffA);
            PG8_WAIT_V(8); PG8_WAIT_L(0); PG8_BAR; PG8_MMA(1, 0, At, B0); PG8_MMA(1, 1, At, B1); PG8_BAR; PG8_SCHED;
        }
        if (wr == 0) PG8_BAR;
        E(acc, cur, wr, wc, fr, fq);
        if (!has_next) break;
#pragma unroll
        for (int a = 0; a < 2; ++a)
#pragma unroll
            for (int b = 0; b < 2; ++b)
#pragma unroll
                for (int m = 0; m < 4; ++m)
#pragma unroll
                    for (int n = 0; n < 2; ++n) acc[a][b][m][n] = (f32x4){0.f, 0.f, 0.f, 0.f};
        cur = nxt; cA = nA; cB = nB; ++ui;
        if (wr == 1) PG8_BAR;
    }
    PG8_WAIT_V(0);
    PG8_BAR;
#undef PG8_SA
#undef PG8_SB
#undef PG8_STAGE
#undef PG8_LDA
#undef PG8_LDB
#undef PG8_MMA
#undef PG8_WAIT_V
#undef PG8_WAIT_L
#undef PG8_BAR
#undef PG8_SCHED
}
}
#define XB_TMO      128
#define XB_XCNT(j)  (256  + 64 * (j))
#define XB_XSUB(j)  (1280 + 64 * (j))
#define XB_XGEN(j)  (2304 + 64 * (j))
#define XB_TOP      3328
#define XB_TOPGEN   3392
#define XCD_BAR_WORDS 3456
#define XB_SPIN_CAP (1u << 18)
__device__ __forceinline__ unsigned xb_ld(unsigned* p)              { return __hip_atomic_load(p, __ATOMIC_RELAXED, __HIP_MEMORY_SCOPE_AGENT); }
__device__ __forceinline__ unsigned xb_add(unsigned* p, unsigned v) { return __hip_atomic_fetch_add(p, v, __ATOMIC_RELAXED, __HIP_MEMORY_SCOPE_AGENT); }
__device__ __forceinline__ unsigned xb_xcc_id() { return (unsigned)__builtin_amdgcn_s_getreg((3 << 11) | 20) & 0xFu; }
#define XB_SPIN(cond, bar) do { unsigned _sp = 0; while (cond) { __builtin_amdgcn_s_sleep(1); \
    if ((++_sp & 255u) == 0u) { if (xb_ld(&(bar)[XB_TMO])) break; if (_sp > XB_SPIN_CAP) { atomicAdd(&(bar)[XB_TMO], 1u); break; } } } } while (0)
struct XcdBarrier { unsigned* bar; unsigned x; volatile LAS unsigned* st; };
__device__ __forceinline__ XcdBarrier xcd_barrier_post(unsigned* bar, volatile LAS unsigned* st) {
    XcdBarrier b; b.bar = bar; b.x = xb_xcc_id(); b.st = st;
    if (threadIdx.x == 0) (void)xb_add(&bar[XB_XCNT(b.x)], 1u);
    return b;
}
__device__ __forceinline__ void xcd_barrier_complete(unsigned* bar, unsigned x, unsigned& nloc, unsigned& nx) {
    const unsigned G = gridDim.x * gridDim.y * gridDim.z;
    unsigned sum, cnt, mine, sp = 0u;
    for (;;) {
        sum = 0u; cnt = 0u; mine = 0u;
#pragma unroll
        for (unsigned j = 0; j < 16; ++j) { const unsigned c = xb_ld(&bar[XB_XCNT(j)]); sum += c; cnt += (c > 0u) ? 1u : 0u; mine = (j == x) ? c : mine; }
        if (sum == G) break;
        __builtin_amdgcn_s_sleep(1);
        if ((++sp & 255u) == 0u) { if (xb_ld(&bar[XB_TMO])) break; if (sp > XB_SPIN_CAP) { atomicAdd(&bar[XB_TMO], 1u); break; } }
    }
    nloc = mine > 0u ? mine : 1u; nx = cnt > 0u ? cnt : 1u;
}
__device__ __forceinline__ void xcd_barrier(const XcdBarrier& b) {
    asm volatile("s_waitcnt vmcnt(0)" ::: "memory");
    __syncthreads();
    if (threadIdx.x == 0) {
        unsigned* bar = b.bar;
        __builtin_amdgcn_s_waitcnt(0);
        unsigned nloc = b.st[0], nx = b.st[1];
        if (nloc == 0u) { xcd_barrier_complete(bar, b.x, nloc, nx); b.st[0] = nloc; b.st[1] = nx; }
        const unsigned old = xb_add(&bar[XB_XSUB(b.x)], 1u);
        const unsigned gen = old / nloc;
        if (old + 1u == (gen + 1u) * nloc) {
            __builtin_amdgcn_fence(__ATOMIC_RELEASE, "agent");
            asm volatile("s_waitcnt vmcnt(0)" ::: "memory");
            const unsigned og = xb_add(&bar[XB_TOP], 1u);
            const unsigned tg = og / nx;
            if (og + 1u == (tg + 1u) * nx) xb_add(&bar[XB_TOPGEN], 1u);
            else XB_SPIN(xb_ld(&bar[XB_TOPGEN]) == tg, bar);
            __builtin_amdgcn_fence(__ATOMIC_ACQUIRE, "agent");
            xb_add(&bar[XB_XGEN(b.x)], 1u);
            asm volatile("s_waitcnt vmcnt(0)" ::: "memory");
        } else {
            XB_SPIN(xb_ld(&bar[XB_XGEN(b.x)]) == gen, bar);
            __builtin_amdgcn_fence(__ATOMIC_ACQUIRE, "agent");
            asm volatile("s_waitcnt vmcnt(0)" ::: "memory");
        }
    }
    __syncthreads();
}

struct Frame {
    LAS unsigned char* lds;
    unsigned* ctl;
    unsigned char* ws;
    int tid, lane, wave, G, bid;
};
struct Args { const void* in[34]; float* out; unsigned char* ws; int ph_lo, ph_hi; };

enum { I_X = 0, I_POS, I_A_WIN, I_A_LNG, I_A_LNB, I_A_WS, I_A_BS, I_A_WOUT, I_B_WIN, I_B_WOUT, I_C_WIN, I_C_LB, I_C_NG, I_C_WOUT,
       I_D_WIN, I_D_QNG, I_D_WUQ, I_D_KVNG, I_D_WUKV, I_D_WOUT, I_F0_GU, I_F0_DN, I_M1_R, I_M1_GU, I_M1_DN, I_F2_GU, I_F2_DN, I_M3_R, I_M3_GU, I_M3_DN,
       I_LNM_G, I_LNM_B, I_LNF_G, I_LNF_B };

__device__ __forceinline__ void transpose_item(const float* W, int Kv, int Nv, int ldw, bf16* WT, int Kp, int mode, LAS float* scr, int kb, int nb, int lane) {
    const int k0 = 64 * kb, n0 = 32 * nb;
    const int nn = n0 + (lane & 31);
#pragma unroll 8
    for (int i = 0; i < 32; ++i) { const int kk = 2 * i + (lane >> 5); const int k = k0 + kk;
        scr[kk * 33 + (lane & 31)] = (k < Kv && nn < Nv) ? W[(size_t)k * ldw + nn] : 0.f; }
    LDS_WAIT(); asm volatile("" ::: "memory");
    int drow0;
    if (mode == 0) drow0 = n0; else { const int j = (n0 < FF) ? n0 : n0 - FF; drow0 = 256 * (j >> 7) + (j & 127) + ((n0 < FF) ? 0 : 128); }
    const int c = lane & 7;
#pragma unroll
    for (int j = 0; j < 4; ++j) { const int n = (lane >> 3) + 8 * j; const LAS float* s = scr + (8 * c) * 33 + n;
        u32x4 o; o.x = cvt_pk_bf16(s[0 * 33], s[1 * 33]); o.y = cvt_pk_bf16(s[2 * 33], s[3 * 33]); o.z = cvt_pk_bf16(s[4 * 33], s[5 * 33]); o.w = cvt_pk_bf16(s[6 * 33], s[7 * 33]);
        *(u32x4*)(WT + (size_t)(drow0 + n) * Kp + k0 + 8 * c) = o; }
    LDS_WAIT(); asm volatile("" ::: "memory");
}
__device__ __forceinline__ void convert_matrix(const Frame& F, const float* W, int Kv, int Nv, bf16* WT, int Kp, int Np, int mode, int nmat) {
    LAS float* scr = (LAS float*)(F.lds + F.wave * 16384);
    const int gw = F.bid * NWAVES + F.wave, NGW = F.G * NWAVES;
    const int nkb = Kp / 64, nnb = Np / 32, per = nkb * nnb;
    const long total = (long)per * nmat;
    for (long it = gw; it < total; it += NGW) {
        const int mat = (int)(it / per), r = (int)(it % per);
        const int kb = r / nnb, nb = r % nnb;
        transpose_item(W + (size_t)mat * Kv * Nv, Kv, Nv, Nv, WT + (size_t)mat * Kp * Np, Kp, mode, scr, kb, nb, F.lane);
    }
}

__device__ __forceinline__ void ln_row(f32x4 (&v)[4], const float* g, const float* b, int lane) {
    float s = 0.f;
#pragma unroll
    for (int j = 0; j < 4; ++j) s += (v[j].x + v[j].y) + (v[j].z + v[j].w);
    const float mean = wave_sum(s) * (1.f / D); float s2 = 0.f;
#pragma unroll
    for (int j = 0; j < 4; ++j) { v[j] = v[j] - mean; s2 += (v[j].x * v[j].x + v[j].y * v[j].y) + (v[j].z * v[j].z + v[j].w * v[j].w); }
    const float rstd = __builtin_amdgcn_rsqf(wave_sum(s2) * (1.f / D) + LN_EPS);
#pragma unroll
    for (int j = 0; j < 4; ++j) { const f32x4 gg = *(const f32x4*)(g + 4 * lane + 256 * j), bb = *(const f32x4*)(b + 4 * lane + 256 * j); v[j] = v[j] * rstd * gg + bb; }
}
__device__ __forceinline__ void store_row(const f32x4 (&v)[4], float* of, bf16* ob, int lane) {
#pragma unroll
    for (int j = 0; j < 4; ++j) { *(f32x4*)(of + 4 * lane + 256 * j) = v[j];
        u32x2 w; w.x = cvt_pk_bf16(v[j].x, v[j].y); w.y = cvt_pk_bf16(v[j].z, v[j].w); *(u32x2*)(ob + 4 * lane + 256 * j) = w; }
}
__device__ __forceinline__ void ln_phase(const Frame& F, float* xf, bf16* xb, const float* g, const float* b) {
    const int gw = F.bid * NWAVES + F.wave, NGW = F.G * NWAVES;
    for (int r = gw; r < M; r += NGW) {
        f32x4 v[4];
#pragma unroll
        for (int j = 0; j < 4; ++j) v[j] = *(const f32x4*)(xf + (size_t)r * D + 4 * F.lane + 256 * j);
        ln_row(v, g, b, F.lane);
        store_row(v, xf + (size_t)r * D, xb + (size_t)r * D, F.lane);
    }
}
__device__ __forceinline__ void ln_route_phase(const Frame& F, float* xf, bf16* xb, const float* g, const float* b, const float* wr, unsigned* cnt  ) {
    LAS float* WR = (LAS float*)F.lds;
    LAS int* EB = (LAS int*)(F.lds + 32768);
    LAS int* BASE = (LAS int*)(F.lds + 32768 + 512);
    for (int i = F.tid; i < D * NE / 4; i += NTHREADS) ((LAS f32x4*)WR)[i] = ((const f32x4*)wr)[i];
    __syncthreads();
    int* toke = (int*)(F.ws + S_TOKE); float* tokg = (float*)(F.ws + S_TOKG); int* slot = (int*)(F.ws + S_SLOT);
    for (int blk = F.bid; blk < M / 64; blk += F.G) {
        for (int i = 0; i < 8; ++i) {
            const int rl = F.wave * 8 + i, r = blk * 64 + rl;
            f32x4 v[4];
#pragma unroll
            for (int j = 0; j < 4; ++j) v[j] = *(const f32x4*)(xf + (size_t)r * D + 4 * F.lane + 256 * j);
            ln_row(v, g, b, F.lane);
            store_row(v, xf + (size_t)r * D, xb + (size_t)r * D, F.lane);
            float lg[NE];
#pragma unroll
            for (int e = 0; e < NE; ++e) lg[e] = 0.f;
#pragma unroll
            for (int j = 0; j < 4; ++j)
#pragma unroll
                for (int c = 0; c < 4; ++c) { const LAS f32x4* wp = (const LAS f32x4*)(WR + (size_t)(4 * F.lane + 256 * j + c) * NE); const f32x4 w0 = wp[0], w1 = wp[1]; const float xv = v[j][c];
                    lg[0] += xv * w0.x; lg[1] += xv * w0.y; lg[2] += xv * w0.z; lg[3] += xv * w0.w; lg[4] += xv * w1.x; lg[5] += xv * w1.y; lg[6] += xv * w1.z; lg[7] += xv * w1.w; }
#pragma unroll
            for (int e = 0; e < NE; ++e) lg[e] = wave_sum(lg[e]);
            int e0 = 0; float l0 = lg[0];
#pragma unroll
            for (int e = 1; e < NE; ++e) if (lg[e] > l0) { l0 = lg[e]; e0 = e; }
            int e1 = -1; float l1 = -3.0e38f;
#pragma unroll
            for (int e = 0; e < NE; ++e) if (e != e0 && lg[e] > l1) { l1 = lg[e]; e1 = e; }
            const float ex = __expf(l1 - l0), g0 = 1.f / (1.f + ex), g1 = ex * g0;
            if (F.lane == 0) { toke[2 * r] = e0; toke[2 * r + 1] = e1; tokg[2 * r] = g0; tokg[2 * r + 1] = g1; EB[2 * rl] = e0; EB[2 * rl + 1] = e1; }
        }
        __syncthreads();
        if (F.tid < NE) { int c = 0; for (int a = 0; a < 128; ++a) c += (EB[a] == F.tid) ? 1 : 0;
            BASE[F.tid] = (int)__hip_atomic_fetch_add(cnt + 64 * F.tid, (unsigned)c, __ATOMIC_RELAXED, __HIP_MEMORY_SCOPE_AGENT); }
        __syncthreads();
        if (F.tid < 128) { const int e = EB[F.tid]; int rank = 0; for (int a = 0; a < F.tid; ++a) rank += (EB[a] == e) ? 1 : 0;
            slot[(size_t)(blk * 64) * 2 + F.tid] = BASE[e] + rank; }
        __syncthreads();
    }
}
__device__ __forceinline__ int moe_segments(const unsigned* cnt, int (&cntv)[NE], int (&pstart)[NE], int (&pend)[NE]) {
    int acc = 0;
#pragma unroll
    for (int e = 0; e < NE; ++e) { cntv[e] = (int)__hip_atomic_load(cnt + 64 * e, __ATOMIC_RELAXED, __HIP_MEMORY_SCOPE_AGENT); pstart[e] = acc; acc += (cntv[e] + 255) & ~255; pend[e] = acc; }
    return acc;
}
__device__ __forceinline__ void moe_gather_phase(const Frame& F, const bf16* xb, bf16* xr, const unsigned* cnt) {
    int cntv[NE], pstart[NE], pend[NE]; moe_segments(cnt, cntv, pstart, pend);
    const int* toke = (const int*)(F.ws + S_TOKE); const float* tokg = (const float*)(F.ws + S_TOKG); const int* slot = (const int*)(F.ws + S_SLOT);
    int* rowtok = (int*)(F.ws + S_ROWTOK); float* rowgate = (float*)(F.ws + S_ROWGATE);
    const int gw = F.bid * NWAVES + F.wave, NGW = F.G * NWAVES;
    for (int a = gw; a < 2 * M; a += NGW) {
        const int e = toke[a]; int ps = 0;
#pragma unroll
        for (int j = 0; j < NE; ++j) ps = (e == j) ? pstart[j] : ps;
        const int dest = ps + slot[a]; const int t = a >> 1;
        const u32x4* src = (const u32x4*)(xb + (size_t)t * D); u32x4* dst = (u32x4*)(xr + (size_t)dest * D);
        dst[F.lane] = src[F.lane]; dst[F.lane + 64] = src[F.lane + 64];
        if (F.lane == 0) { rowtok[dest] = a; rowgate[dest] = tokg[a]; }
    }
    for (int i = gw; i < NE * 256; i += NGW) {
        const int e = i >> 8, j = i & 255; int ps = 0, cv = 0, pe = 0;
#pragma unroll
        for (int q = 0; q < NE; ++q) { ps = (e == q) ? pstart[q] : ps; cv = (e == q) ? cntv[q] : cv; pe = (e == q) ? pend[q] : pe; }
        const int r = ps + cv + j;
        if (r < pe) { u32x4* dst = (u32x4*)(xr + (size_t)r * D); const u32x4 z = (u32x4){0u, 0u, 0u, 0u}; dst[F.lane] = z; dst[F.lane + 64] = z; if (F.lane == 0) { rowtok[r] = -1; rowgate[r] = 0.f; } }
    }
}
__device__ __forceinline__ void ln_moe_phase(const Frame& F, const float* xf, const bf16* yk, float* outf, bf16* xb, const float* g, const float* b) {
    const int gw = F.bid * NWAVES + F.wave, NGW = F.G * NWAVES;
    for (int r = gw; r < M; r += NGW) {
        f32x4 v[4];
#pragma unroll
        for (int j = 0; j < 4; ++j) { const size_t o = (size_t)r * D + 4 * F.lane + 256 * j; const f32x4 x = *(const f32x4*)(xf + o);
            const u32x2 a = *(const u32x2*)(yk + o), c = *(const u32x2*)(yk + (size_t)M * D + o);
            v[j].x = x.x * ALPHA + bflo(a.x) + bflo(c.x); v[j].y = x.y * ALPHA + bfhi(a.x) + bfhi(c.x); v[j].z = x.z * ALPHA + bflo(a.y) + bflo(c.y); v[j].w = x.w * ALPHA + bfhi(a.y) + bfhi(c.y); }
        ln_row(v, g, b, F.lane);
        store_row(v, outf + (size_t)r * D, xb + (size_t)r * D, F.lane);
    }
}
__device__ __forceinline__ void cvt_rows_phase(const Frame& F, const float* x, bf16* xb) {
    const int gw = F.bid * NWAVES + F.wave, NGW = F.G * NWAVES;
    for (int r = gw; r < M; r += NGW) {
#pragma unroll
        for (int j = 0; j < 4; ++j) { const size_t o = (size_t)r * D + 4 * F.lane + 256 * j; const f32x4 v = *(const f32x4*)(x + o);
            u32x2 w; w.x = cvt_pk_bf16(v.x, v.y); w.y = cvt_pk_bf16(v.z, v.w); *(u32x2*)(xb + o) = w; }
    }
}
__device__ __forceinline__ void gmlp_stats_phase(const Frame& F, const bf16* uv, float* stats) {
    const int gw = F.bid * NWAVES + F.wave, NGW = F.G * NWAVES;
    for (int r = gw; r < M; r += NGW) {
        const u32x4* p = (const u32x4*)(uv + (size_t)r * 4096 + 2048);
        float x[32]; float s = 0.f;
#pragma unroll
        for (int j = 0; j < 4; ++j) { const u32x4 w = p[F.lane + 64 * j];
            x[8 * j + 0] = bflo(w.x); x[8 * j + 1] = bfhi(w.x); x[8 * j + 2] = bflo(w.y); x[8 * j + 3] = bfhi(w.y); x[8 * j + 4] = bflo(w.z); x[8 * j + 5] = bfhi(w.z); x[8 * j + 6] = bflo(w.w); x[8 * j + 7] = bfhi(w.w); }
#pragma unroll
        for (int i = 0; i < 32; ++i) s += x[i];
        const float mean = wave_sum(s) * (1.f / 2048.f); float s2 = 0.f;
#pragma unroll
        for (int i = 0; i < 32; ++i) { const float d = x[i] - mean; s2 += d * d; }
        const float rstd = __builtin_amdgcn_rsqf(wave_sum(s2) * (1.f / 2048.f) + LN_EPS);
        if (F.lane == 0) { stats[2 * r] = mean; stats[2 * r + 1] = rstd; }
    }
}
constexpr int GM_WS = 136, GM_VS = 136;
__device__ __forceinline__ void gmlp_spatial_phase(const Frame& F, const bf16* uv, const float* stats, const float* ws_in  , const float* bs  ,
                                                   const float* lng, const float* lnb, bf16* gated) {
    LAS bf16* Ws = (LAS bf16*)F.lds;
    LAS bf16* Vt = (LAS bf16*)(F.lds + 128 * GM_WS * 2);
    const int tid = F.tid, lane = F.lane, w = F.wave, wr = w >> 2, wc = w & 3, fr = lane & 15, fq = lane >> 4;
    for (int u = F.bid; u < 1024; u += F.G) {
        const int bc = u >> 3, g = u & 7; const size_t rowbase = (size_t)bc * 128;
        { const int t = tid >> 2, c0 = (tid & 3) * 32; const float* wp = ws_in + ((size_t)g * 128 + t) * 128 + c0;
#pragma unroll
            for (int q = 0; q < 4; ++q) { const f32x4 a = *(const f32x4*)(wp + 8 * q), b = *(const f32x4*)(wp + 8 * q + 4); const int s0 = c0 + 8 * q;
                u32x4 o; o.x = cvt_pk_bf16(s0 + 0 <= t ? a.x : 0.f, s0 + 1 <= t ? a.y : 0.f); o.y = cvt_pk_bf16(s0 + 2 <= t ? a.z : 0.f, s0 + 3 <= t ? a.w : 0.f);
                o.z = cvt_pk_bf16(s0 + 4 <= t ? b.x : 0.f, s0 + 5 <= t ? b.y : 0.f); o.w = cvt_pk_bf16(s0 + 6 <= t ? b.z : 0.f, s0 + 7 <= t ? b.w : 0.f);
                *(LAS u32x4*)(Ws + t * GM_WS + s0) = o; } }
        { const int so = tid & 15, dq = tid >> 4; const int col = 256 * g + 8 * dq;
            const f32x4 g0 = *(const f32x4*)(lng + col), g1 = *(const f32x4*)(lng + col + 4), b0 = *(const f32x4*)(lnb + col), b1 = *(const f32x4*)(lnb + col + 4);
            float vv[8][8];
#pragma unroll
            for (int j = 0; j < 8; ++j) { const size_t r = rowbase + 8 * so + j; const u32x4 wv = *(const u32x4*)(uv + r * 4096 + 2048 + col); const float mean = stats[2 * r], rstd = stats[2 * r + 1];
                vv[j][0] = (bflo(wv.x) - mean) * rstd * g0.x + b0.x; vv[j][1] = (bfhi(wv.x) - mean) * rstd * g0.y + b0.y; vv[j][2] = (bflo(wv.y) - mean) * rstd * g0.z + b0.z; vv[j][3] = (bfhi(wv.y) - mean) * rstd * g0.w + b0.w;
                vv[j][4] = (bflo(wv.z) - mean) * rstd * g1.x + b1.x; vv[j][5] = (bfhi(wv.z) - mean) * rstd * g1.y + b1.y; vv[j][6] = (bflo(wv.w) - mean) * rstd * g1.z + b1.z; vv[j][7] = (bfhi(wv.w) - mean) * rstd * g1.w + b1.w; }
#pragma unroll
            for (int dd = 0; dd < 8; ++dd) { u32x4 o; o.x = cvt_pk_bf16(vv[0][dd], vv[1][dd]); o.y = cvt_pk_bf16(vv[2][dd], vv[3][dd]); o.z = cvt_pk_bf16(vv[4][dd], vv[5][dd]); o.w = cvt_pk_bf16(vv[6][dd], vv[7][dd]);
                *(LAS u32x4*)(Vt + (8 * dq + dd) * GM_VS + 8 * so) = o; } }
        __syncthreads();
        f32x4 acc[4][4];
#pragma unroll
        for (int a = 0; a < 4; ++a)
#pragma unroll
            for (int b = 0; b < 4; ++b) acc[a][b] = (f32x4){0.f, 0.f, 0.f, 0.f};
        const int nks = wr ? 4 : 2;
        for (int ks = 0; ks < nks; ++ks) {
            bf16x8 wf[4], vf[4];
#pragma unroll
            for (int mt = 0; mt < 4; ++mt) wf[mt] = *(const LAS bf16x8*)(Ws + (64 * wr + 16 * mt + fr) * GM_WS + 32 * ks + 8 * fq);
#pragma unroll
            for (int nt = 0; nt < 4; ++nt) vf[nt] = *(const LAS bf16x8*)(Vt + (64 * wc + 16 * nt + fr) * GM_VS + 32 * ks + 8 * fq);
#pragma unroll
            for (int mt = 0; mt < 4; ++mt)
#pragma unroll
                for (int nt = 0; nt < 4; ++nt) acc[mt][nt] = __builtin_amdgcn_mfma_f32_16x16x32_bf16(vf[nt], wf[mt], acc[mt][nt], 0, 0, 0);
        }
#pragma unroll
        for (int mt = 0; mt < 4; ++mt) { const int tl = 64 * wr + 16 * mt + fr; const float bias = bs[g * 128 + tl]; const size_t r = rowbase + tl;
#pragma unroll
            for (int nt = 0; nt < 4; ++nt) { const int col = 256 * g + 64 * wc + 16 * nt + 4 * fq; const u32x2 uu = *(const u32x2*)(uv + r * 4096 + col);
                const f32x4 sv = acc[mt][nt] + bias;
                u32x2 o; o.x = cvt_pk_bf16(bflo(uu.x) * sv.x, bfhi(uu.x) * sv.y); o.y = cvt_pk_bf16(bflo(uu.y) * sv.z, bfhi(uu.y) * sv.w);
                *(u32x2*)(gated + r * 2048 + col) = o; } }
        __syncthreads();
    }
}
constexpr int PB_LD = 3584, PB_QI = 3072, PB_KI = 3328, PB_WI = 3392;
__device__ __forceinline__ unsigned sortable(float s) { const unsigned b = __float_as_uint(s + 0.0f); return b ^ ((b >> 31) ? 0xffffffffu : 0x80000000u); }
__device__ __forceinline__ void dsa_topk_phase(const Frame& F, const bf16* proj, u64* mask) {
    LAS unsigned* SC = (LAS unsigned*)F.lds;
    const int lane = F.lane, w = F.wave, fr = lane & 15, fq = lane >> 4;
    for (int it = 0; it < 1024 / 256 + 1; ++it) {
        const int idx = it * F.G + F.bid; if (idx >= 1024) break;
        const int b = idx >> 7, tq0 = idx & 127; const int tq = ((idx >> 8) & 1) ? 127 - tq0 : tq0;
        const int t0 = 16 * tq; const size_t rb = (size_t)b * SEQ;
        bf16x8 qf[4][2]; float wq[4];
        { const bf16* qp = proj + (rb + t0 + fr) * PB_LD;
#pragma unroll
            for (int h = 0; h < 4; ++h) {
#pragma unroll
                for (int ks = 0; ks < 2; ++ks) qf[h][ks] = *(const bf16x8*)(qp + PB_QI + 64 * h + 32 * ks + 8 * fq);
                wq[h] = bf2f(qp[PB_WI + h]); } }
        for (int kt = w; kt <= tq; kt += NWAVES) {
            const bf16* kp = proj + (rb + 16 * kt + fr) * PB_LD + PB_KI + 8 * fq;
            const bf16x8 kf0 = *(const bf16x8*)kp, kf1 = *(const bf16x8*)(kp + 32);
            f32x4 sc = (f32x4){0.f, 0.f, 0.f, 0.f};
#pragma unroll
            for (int h = 0; h < 4; ++h) { f32x4 d = (f32x4){0.f, 0.f, 0.f, 0.f};
                d = __builtin_amdgcn_mfma_f32_16x16x32_bf16(kf0, qf[h][0], d, 0, 0, 0); d = __builtin_amdgcn_mfma_f32_16x16x32_bf16(kf1, qf[h][1], d, 0, 0, 0);
                sc.x += wq[h] * fmaxf(d.x, 0.f); sc.y += wq[h] * fmaxf(d.y, 0.f); sc.z += wq[h] * fmaxf(d.z, 0.f); sc.w += wq[h] * fmaxf(d.w, 0.f); }
            u32x4 o; o.x = sortable(sc.x); o.y = sortable(sc.y); o.z = sortable(sc.z); o.w = sortable(sc.w);
            *(LAS u32x4*)(SC + fr * 2048 + 16 * kt + 4 * fq) = o;
        }
        __syncthreads();
        for (int qq = 0; qq < 2; ++qq) {
            const int ql = 2 * w + qq, t = t0 + ql;
            u64* mrow = mask + (rb + t) * 32;
            unsigned key[32];
#pragma unroll
            for (int j = 0; j < 32; ++j) { const int s = 64 * j + lane; key[j] = (s <= t) ? SC[ql * 2048 + s] : 0u; }
            unsigned T = 0u; int need = 0;
            if (t >= 256) {
                for (int bit = 31; bit >= 0; --bit) {
                    const unsigned cand = T | (1u << bit); int c = 0;
#pragma unroll
                    for (int j = 0; j < 32; ++j) c += __builtin_popcountll(__ballot(key[j] >= cand));
                    if (c >= 256) T = cand;
                }
                int ngt = 0;
#pragma unroll
                for (int j = 0; j < 32; ++j) ngt += __builtin_popcountll(__ballot(key[j] > T));
                need = 256 - ngt;
            }
            int running = 0;
#pragma unroll
            for (int j = 0; j < 32; ++j) {
                const bool adm = (64 * j + lane) <= t;
                const bool gt = key[j] > T, eq = (key[j] == T);
                const u64 eqm = __ballot(eq && adm);
                const int rank = running + __builtin_popcountll(eqm & ((1ull << lane) - 1ull));
                const bool sel = adm && (gt || (t < 256) || (eq && rank < need));
                const u64 word = __ballot(sel);
                running += __builtin_popcountll(eqm);
                if (lane == 0) mrow[j] = word;
            }
        }
        __syncthreads();
    }
}
template <int DK> struct AttnCfg { static constexpr int KP = DK + 8, VP = 72, KBYTES = 64 * KP * 2, VBYTES = 64 * VP * 2, BUF = KBYTES + VBYTES; };
struct AttnArgs { const bf16* Q; int ldq, qoff;
                  const bf16* K1; int ldk1, k1off, k1hs;
                  const bf16* K2; int ldk2;
                  const bf16* V; int ldv, voff, vhs;
                  bf16* O;
                  const u64* mask;
                  float scale_log2; };
__device__ __forceinline__ int crow(int r, int hi) { return (r & 3) + 8 * (r >> 2) + 4 * hi; }
template <int DK, bool MASKED>
__device__ __forceinline__ void attn_unit(const Frame& F, const AttnArgs& A, int b, int h, int qb) {
    typedef AttnCfg<DK> C;
    const int tid = F.tid, lane = F.lane, w = F.wave, r32 = lane & 31, hi = lane >> 5;
    const size_t rb = (size_t)b * SEQ; const int q0 = qb * 256, qrow = q0 + 32 * w + r32;
    const int NT = (q0 + 256) / 64;
    constexpr int NKS = DK / 16;
    bf16x8 qf[NKS];
    { const bf16* qp = A.Q + (rb + qrow) * A.ldq + A.qoff + h * DK + 8 * hi;
#pragma unroll
        for (int ks = 0; ks < NKS; ++ks) qf[ks] = *(const bf16x8*)(qp + 16 * ks); }
    const int skey = tid >> 3, sch = tid & 7;
    const int skey2 = (tid + 512) / 12, sch2 = (tid + 512) % 12;
    const int skey1 = (DK == 96) ? tid / 12 : skey, sch1 = (DK == 96) ? tid % 12 : sch;
    u32x4 kreg0, kreg1 = (u32x4){0u, 0u, 0u, 0u}, vreg; u64 mw = 0ull;
#define ATT_LOAD_TILE(kt_) do { const size_t kr = rb + 64 * (kt_); \
        if (DK == 64) { kreg0 = *(const u32x4*)(A.K1 + (kr + skey) * A.ldk1 + A.k1off + h * A.k1hs + 8 * sch); } \
        else { \
            kreg0 = (sch1 < 8) ? *(const u32x4*)(A.K1 + (kr + skey1) * A.ldk1 + A.k1off + h * A.k1hs + 8 * sch1) : *(const u32x4*)(A.K2 + (kr + skey1) * A.ldk2 + 8 * (sch1 - 8)); \
            if (tid < 256) kreg1 = (sch2 < 8) ? *(const u32x4*)(A.K1 + (kr + skey2) * A.ldk1 + A.k1off + h * A.k1hs + 8 * sch2) : *(const u32x4*)(A.K2 + (kr + skey2) * A.ldk2 + 8 * (sch2 - 8)); \
        } \
        vreg = *(const u32x4*)(A.V + (kr + skey) * A.ldv + A.voff + h * A.vhs + 8 * sch); \
        if (MASKED) mw = A.mask[(rb + qrow) * 32 + (kt_)]; } while (0)
#define ATT_STORE_TILE(buf_) do { LAS unsigned char* base = F.lds + (buf_) * C::BUF; \
        *(LAS u32x4*)(base + (skey1 * C::KP + 8 * sch1) * 2) = kreg0; \
        if (DK == 96) { if (tid < 256) *(LAS u32x4*)(base + (skey2 * C::KP + 8 * sch2) * 2) = kreg1; } \
        *(LAS u32x4*)(base + C::KBYTES + (skey * C::VP + 8 * sch) * 2) = vreg; } while (0)
    float m_run = -1.0e30f, l_run = 0.f; f32x16 o0 = {}, o1 = {};
    ATT_LOAD_TILE(0); u64 mcur = mw; ATT_STORE_TILE(0); __syncthreads();
    const int wq_max = q0 + 32 * w + 31, wq_min = q0 + 32 * w;
    for (int kt = 0; kt < NT; ++kt) {
        if (kt + 1 < NT) ATT_LOAD_TILE(kt + 1);
        if (64 * kt <= wq_max) {
            const LAS unsigned char* kb = F.lds + (kt & 1) * C::BUF; const LAS unsigned char* vb = kb + C::KBYTES;
            f32x16 p0 = {}, p1 = {};
#pragma unroll
            for (int ks = 0; ks < NKS; ++ks) {
                const bf16x8 a0 = *(const LAS bf16x8*)(kb + (r32 * C::KP + 16 * ks + 8 * hi) * 2), a1 = *(const LAS bf16x8*)(kb + ((32 + r32) * C::KP + 16 * ks + 8 * hi) * 2);
                p0 = __builtin_amdgcn_mfma_f32_32x32x16_bf16(a0, qf[ks], p0, 0, 0, 0); p1 = __builtin_amdgcn_mfma_f32_32x32x16_bf16(a1, qf[ks], p1, 0, 0, 0);
            }
            const float NEG = -1.0e30f;
            if (MASKED) { const unsigned lo = (unsigned)mcur >> (4 * hi), hh = (unsigned)(mcur >> 32) >> (4 * hi);
#pragma unroll
                for (int r = 0; r < 16; ++r) { const int bitp = (r & 3) + 8 * (r >> 2); p0[r] = ((lo >> bitp) & 1u) ? p0[r] * A.scale_log2 : NEG; p1[r] = ((hh >> bitp) & 1u) ? p1[r] * A.scale_log2 : NEG; }
            } else if (64 * kt + 63 > wq_min) {
#pragma unroll
                for (int r = 0; r < 16; ++r) { const int kv = 64 * kt + crow(r, hi); p0[r] = (kv <= qrow) ? p0[r] * A.scale_log2 : NEG; p1[r] = (kv + 32 <= qrow) ? p1[r] * A.scale_log2 : NEG; }
            } else {
#pragma unroll
                for (int r = 0; r < 16; ++r) { p0[r] *= A.scale_log2; p1[r] *= A.scale_log2; }
            }
            float mx = p0[0];
#pragma unroll
            for (int r = 1; r < 16; ++r) mx = fmaxf(mx, p0[r]);
#pragma unroll
            for (int r = 0; r < 16; ++r) mx = fmaxf(mx, p1[r]);
            { auto rr = __builtin_amdgcn_permlane32_swap(__float_as_uint(mx), __float_as_uint(mx), false, false); mx = fmaxf(__uint_as_float(rr[0]), __uint_as_float(rr[1])); }
            const float m_new = fmaxf(m_run, mx), alpha = fast_exp2(m_run - m_new); m_run = m_new;
            float ps = 0.f;
#pragma unroll
            for (int r = 0; r < 16; ++r) { p0[r] = fast_exp2(p0[r] - m_new); p1[r] = fast_exp2(p1[r] - m_new); ps += p0[r] + p1[r]; }
            l_run = l_run * alpha + ps;
#pragma unroll
            for (int r = 0; r < 16; ++r) { o0[r] *= alpha; o1[r] *= alpha; }
            bf16x8 pk[4];
#pragma unroll
            for (int s = 0; s < 2; ++s) {
                u32x4 a; a.x = cvt_pk_bf16(p0[8 * s + 0], p0[8 * s + 1]); a.y = cvt_pk_bf16(p0[8 * s + 2], p0[8 * s + 3]); a.z = cvt_pk_bf16(p0[8 * s + 4], p0[8 * s + 5]); a.w = cvt_pk_bf16(p0[8 * s + 6], p0[8 * s + 7]);
                u32x4 c; c.x = cvt_pk_bf16(p1[8 * s + 0], p1[8 * s + 1]); c.y = cvt_pk_bf16(p1[8 * s + 2], p1[8 * s + 3]); c.z = cvt_pk_bf16(p1[8 * s + 4], p1[8 * s + 5]); c.w = cvt_pk_bf16(p1[8 * s + 6], p1[8 * s + 7]);
                pk[s] = __builtin_bit_cast(bf16x8, a); pk[2 + s] = __builtin_bit_cast(bf16x8, c); }
            const int gi = (lane >> 4) & 1, q4 = (lane & 15) >> 2, p4 = lane & 3;
            const LAS unsigned char* vlane = vb + ((4 * hi + q4) * C::VP + 16 * gi + 4 * p4) * 2;
#pragma unroll
            for (int s4 = 0; s4 < 4; ++s4) {
#pragma unroll
                for (int db = 0; db < 2; ++db) {
                    const s16x4 lo4 = __builtin_bit_cast(s16x4, __builtin_amdgcn_ds_read_tr16_b64_v4i16((LAS s16x4*)(vlane + ((16 * s4) * C::VP + 32 * db) * 2)));
                    const s16x4 hi4 = __builtin_bit_cast(s16x4, __builtin_amdgcn_ds_read_tr16_b64_v4i16((LAS s16x4*)(vlane + ((16 * s4 + 8) * C::VP + 32 * db) * 2)));
                    const bf16x8 vf = (bf16x8){lo4[0], lo4[1], lo4[2], lo4[3], hi4[0], hi4[1], hi4[2], hi4[3]};
                    if (db == 0) o0 = __builtin_amdgcn_mfma_f32_32x32x16_bf16(vf, pk[s4], o0, 0, 0, 0); else o1 = __builtin_amdgcn_mfma_f32_32x32x16_bf16(vf, pk[s4], o1, 0, 0, 0);
                }
            }
        }
        if (kt + 1 < NT) { ATT_STORE_TILE((kt + 1) & 1); mcur = mw; }
        __syncthreads();
    }
    { auto rr = __builtin_amdgcn_permlane32_swap(__float_as_uint(l_run), __float_as_uint(l_run), false, false); l_run = __uint_as_float(rr[0]) + __uint_as_float(rr[1]); }
    const float inv = 1.0f / l_run;
    bf16* op = A.O + (rb + qrow) * D + h * 64 + 4 * hi;
#pragma unroll
    for (int g4 = 0; g4 < 4; ++g4) {
        u32x2 a; a.x = cvt_pk_bf16(o0[4 * g4 + 0] * inv, o0[4 * g4 + 1] * inv); a.y = cvt_pk_bf16(o0[4 * g4 + 2] * inv, o0[4 * g4 + 3] * inv);
        u32x2 c; c.x = cvt_pk_bf16(o1[4 * g4 + 0] * inv, o1[4 * g4 + 1] * inv); c.y = cvt_pk_bf16(o1[4 * g4 + 2] * inv, o1[4 * g4 + 3] * inv);
        *(u32x2*)(op + 8 * g4) = a; *(u32x2*)(op + 32 + 8 * g4) = c;
    }
}
#undef ATT_LOAD_TILE
#undef ATT_STORE_TILE
template <int DK, bool MASKED>
__device__ __forceinline__ void attn_phase(const Frame& F, const AttnArgs& A) {
    for (int i = 0; i < 4; ++i) {
        const int u = i * F.G + F.bid; if (u >= 1024) break;
        const int bh = u >> 3, qp = u & 7, qb = ((u >> 8) & 1) ? 7 - qp : qp;
        attn_unit<DK, MASKED>(F, A, bh >> 4, bh & 15, qb);
    }
}
constexpr int HG_QS = 136, HG_HS = 72, HG_VS = 72, HG_SS = 136;
constexpr int HG_QT = 0, HG_KT = HG_QT + 64 * HG_QS * 2, HG_KH = HG_KT + 64 * HG_QS * 2, HG_VT = HG_KH + 128 * HG_HS * 2, HG_SB = HG_VT + 32 * HG_VS * 2,
              HG_GL = HG_SB + 2 * 32 * HG_SS * 2, HG_SEG = HG_GL + 512, HG_END = HG_SEG + 4 * 128 * 4;
static_assert(HG_END <= RING_BYTES, "hgrn2 LDS");
__device__ __forceinline__ void hgrn2_scan_phase(const Frame& F, const bf16* proj, const float* lb_logits  , float* opre  ) {
    LAS bf16* Qt = (LAS bf16*)(F.lds + HG_QT); LAS bf16* Kt = (LAS bf16*)(F.lds + HG_KT); LAS bf16* Kh = (LAS bf16*)(F.lds + HG_KH); LAS bf16* Vt = (LAS bf16*)(F.lds + HG_VT);
    LAS bf16* Sb = (LAS bf16*)(F.lds + HG_SB); LAS float* GL = (LAS float*)(F.lds + HG_GL); LAS float* SEG = (LAS float*)(F.lds + HG_SEG);
    const int tid = F.tid, lane = F.lane, w = F.wave, fr = lane & 15, fq = lane >> 4;
    for (int u = F.bid; u < 256; u += F.G) {
        const int b = u >> 5, h = (u >> 2) & 7, vq = u & 3;
        const size_t rb = (size_t)b * SEQ;
        const int k = tid & 127, tseg = tid >> 7;
        float lbv; { const int c = 128 * h + k; const float a0 = lb_logits[c], a1 = lb_logits[1024 + c], a2 = lb_logits[2048 + c], a3 = lb_logits[3072 + c];
            const float mx = fmaxf(fmaxf(a0, a1), fmaxf(a2, a3)); const float e0 = __expf(a0 - mx), e1 = __expf(a1 - mx), e2 = __expf(a2 - mx), e3 = __expf(a3 - mx);
            lbv = (e1 + e2) / (e0 + e1 + e2 + e3); }
        f32x4 sacc[2]; sacc[0] = (f32x4){0.f, 0.f, 0.f, 0.f}; sacc[1] = sacc[0];
        for (int i = tid; i < 2 * 32 * HG_SS / 2; i += NTHREADS) ((LAS unsigned*)Sb)[i] = 0u;
        const int vt = w & 1, tt = w >> 1;
        for (int c = 0; c < 32; ++c) {
            const size_t r0 = rb + 64 * c;
            float gl[16], kk[16], qv[16];
            { const bf16* pp = proj + (r0 + 16 * tseg) * 4096 + 128 * h + k; float run = 0.f;
#pragma unroll
                for (int j = 0; j < 16; ++j) { const float fp = bf2f(pp[(size_t)j * 4096 + 1024]); qv[j] = bf2f(pp[(size_t)j * 4096]);
                    const float sg = sigmoidf_(fp); const float f = lbv + (1.f - lbv) * sg; kk[j] = (1.f - lbv) * (1.f - sg); run += __logf(f); gl[j] = run; }
                SEG[tseg * 128 + k] = run; }
            if (tid < 256) { const int so = tid & 7, v = tid >> 3; const bf16* vp = proj + (r0 + 8 * so) * 4096 + 2048 + 128 * h + 32 * vq + v;
                u32x4 o; o.x = (unsigned)vp[0] | ((unsigned)vp[4096] << 16); o.y = (unsigned)vp[2 * 4096] | ((unsigned)vp[3 * 4096] << 16);
                o.z = (unsigned)vp[4 * 4096] | ((unsigned)vp[5 * 4096] << 16); o.w = (unsigned)vp[6 * 4096] | ((unsigned)vp[7 * 4096] << 16);
                *(LAS u32x4*)(Vt + v * HG_VS + 8 * so) = o; }
            __syncthreads();
            { float off = 0.f, tot = 0.f;
#pragma unroll
                for (int s = 0; s < 4; ++s) { const float sv = SEG[s * 128 + k]; off += (s < tseg) ? sv : 0.f; tot += sv; }
                if (tseg == 0) GL[k] = tot;
                unsigned kh[8];
#pragma unroll
                for (int j = 0; j < 16; ++j) { const float G = off + gl[j]; const float eg = __expf(G);
                    const float qs = qv[j] * eg, ks = kk[j] * __expf(-G), khv = kk[j] * __expf(tot - G);
                    Qt[(16 * tseg + j) * HG_QS + k] = (bf16)(cvt_pk_bf16(qs, 0.f) & 0xffffu); Kt[(16 * tseg + j) * HG_QS + k] = (bf16)(cvt_pk_bf16(ks, 0.f) & 0xffffu);
                    if (j & 1) kh[j >> 1] = (kh[j >> 1] & 0xffffu) | (cvt_pk_bf16(0.f, khv) & 0xffff0000u); else kh[j >> 1] = cvt_pk_bf16(khv, 0.f) & 0xffffu; }
                *(LAS u32x4*)(Kh + k * HG_HS + 16 * tseg) = (u32x4){kh[0], kh[1], kh[2], kh[3]}; *(LAS u32x4*)(Kh + k * HG_HS + 16 * tseg + 8) = (u32x4){kh[4], kh[5], kh[6], kh[7]}; }
            __syncthreads();
            const LAS bf16* Sbc = Sb + (c & 1) * 32 * HG_SS; LAS bf16* Sbn = Sb + ((c + 1) & 1) * 32 * HG_SS;
            bf16x8 bq[4];
#pragma unroll
            for (int ks = 0; ks < 4; ++ks) bq[ks] = *(const LAS bf16x8*)(Qt + (16 * tt + fr) * HG_QS + 32 * ks + 8 * fq);
            f32x4 sc[4];
#pragma unroll
            for (int st = 0; st < 4; ++st) { sc[st] = (f32x4){0.f, 0.f, 0.f, 0.f};
                if (st <= tt) {
#pragma unroll
                    for (int ks = 0; ks < 4; ++ks) { const bf16x8 ka = *(const LAS bf16x8*)(Kt + (16 * st + fr) * HG_QS + 32 * ks + 8 * fq); sc[st] = __builtin_amdgcn_mfma_f32_16x16x32_bf16(ka, bq[ks], sc[st], 0, 0, 0); }
                    if (st == tt) {
#pragma unroll
                        for (int i = 0; i < 4; ++i) if (4 * fq + i > fr) sc[st][i] = 0.f; } } }
            f32x4 oacc = (f32x4){0.f, 0.f, 0.f, 0.f};
#pragma unroll
            for (int m = 0; m < 2; ++m) {
                u32x4 pw; pw.x = cvt_pk_bf16(sc[2 * m][0], sc[2 * m][1]); pw.y = cvt_pk_bf16(sc[2 * m][2], sc[2 * m][3]); pw.z = cvt_pk_bf16(sc[2 * m + 1][0], sc[2 * m + 1][1]); pw.w = cvt_pk_bf16(sc[2 * m + 1][2], sc[2 * m + 1][3]);
                const LAS bf16* vp = Vt + (16 * vt + fr) * HG_VS + 32 * m + 4 * fq;
                const u32x2 va = *(const LAS u32x2*)vp, vb = *(const LAS u32x2*)(vp + 16);
                const bf16x8 vf = __builtin_bit_cast(bf16x8, (u32x4){va.x, va.y, vb.x, vb.y});
                oacc = __builtin_amdgcn_mfma_f32_16x16x32_bf16(vf, __builtin_bit_cast(bf16x8, pw), oacc, 0, 0, 0);
            }
#pragma unroll
            for (int ks = 0; ks < 4; ++ks) { const bf16x8 sa = *(const LAS bf16x8*)(Sbc + (16 * vt + fr) * HG_SS + 32 * ks + 8 * fq); oacc = __builtin_amdgcn_mfma_f32_16x16x32_bf16(sa, bq[ks], oacc, 0, 0, 0); }
            *(f32x4*)(opre + (r0 + 16 * tt + fr) * D + 128 * h + 32 * vq + 16 * vt + 4 * fq) = oacc;
#pragma unroll
            for (int x = 0; x < 2; ++x) { const int kt = tt + 4 * x;
                const f32x4 dec = *(const LAS f32x4*)(GL + 16 * kt + 4 * fq);
                f32x4 a = sacc[x]; a.x *= __expf(dec.x); a.y *= __expf(dec.y); a.z *= __expf(dec.z); a.w *= __expf(dec.w);
#pragma unroll
                for (int m = 0; m < 2; ++m) { const bf16x8 ka = *(const LAS bf16x8*)(Kh + (16 * kt + fr) * HG_HS + 32 * m + 8 * fq), vbf = *(const LAS bf16x8*)(Vt + (16 * vt + fr) * HG_VS + 32 * m + 8 * fq);
                    a = __builtin_amdgcn_mfma_f32_16x16x32_bf16(ka, vbf, a, 0, 0, 0); }
                sacc[x] = a;
                u32x2 o; o.x = cvt_pk_bf16(a.x, a.y); o.y = cvt_pk_bf16(a.z, a.w);
                *(LAS u32x2*)(Sbn + (16 * vt + fr) * HG_SS + 16 * kt + 4 * fq) = o; }
            __syncthreads();
        }
    }
}
__device__ __forceinline__ void hgrn2_norm_phase(const Frame& F, const float* opre, const bf16* proj, const float* ng, bf16* ob) {
    const int gw = F.bid * NWAVES + F.wave, NGW = F.G * NWAVES, lane = F.lane;
    for (int r = gw; r < M; r += NGW) {
#pragma unroll
        for (int j = 0; j < 4; ++j) { const int col = 4 * lane + 256 * j; const f32x4 v = *(const f32x4*)(opre + (size_t)r * D + col);
            float ss = (v.x * v.x + v.y * v.y) + (v.z * v.z + v.w * v.w);
#pragma unroll
            for (int o = 1; o < 32; o <<= 1) ss += __shfl_xor(ss, o);
            const float rs = __builtin_amdgcn_rsqf(ss * (1.f / 128.f) + RMS_EPS);
            const f32x4 g4 = *(const f32x4*)(ng + (col & 127)); const u32x2 gt = *(const u32x2*)(proj + (size_t)r * 4096 + 3072 + col);
            u32x2 o; o.x = cvt_pk_bf16(v.x * rs * g4.x * siluf_(bflo(gt.x)), v.y * rs * g4.y * siluf_(bfhi(gt.x))); o.y = cvt_pk_bf16(v.z * rs * g4.z * siluf_(bflo(gt.y)), v.w * rs * g4.w * siluf_(bfhi(gt.y)));
            *(u32x2*)(ob + (size_t)r * D + col) = o; }
    }
}
__device__ __forceinline__ void mla_norm_phase(const Frame& F, const float* projd, const int* positions, const float* qg, const float* kvg, bf16* cq, bf16* ckv, bf16* kr, float* ang) {
    const int gw = F.bid * NWAVES + F.wave, NGW = F.G * NWAVES, lane = F.lane;
    for (int r = gw; r < M; r += NGW) {
        const f32x4 a = *(const f32x4*)(projd + (size_t)r * 512 + 8 * lane), c = *(const f32x4*)(projd + (size_t)r * 512 + 8 * lane + 4);
        float x[8] = {a.x, a.y, a.z, a.w, c.x, c.y, c.z, c.w};
        float ss = 0.f;
#pragma unroll
        for (int i = 0; i < 8; ++i) ss += x[i] * x[i];
        float s16 = ss;
#pragma unroll
        for (int o = 1; o < 16; o <<= 1) s16 += __shfl_xor(s16, o);
        const float s32 = s16 + __shfl_xor(s16, 16);
        float px[8];
#pragma unroll
        for (int i = 0; i < 8; ++i) px[i] = __shfl_xor(x[i], 2);
        if (lane < 32) {
            const float rs = __builtin_amdgcn_rsqf(s32 * (1.f / 256.f) + RMS_EPS);
            const f32x4 g0 = *(const f32x4*)(qg + 8 * lane), g1 = *(const f32x4*)(qg + 8 * lane + 4);
            u32x4 o; o.x = cvt_pk_bf16(x[0] * rs * g0.x, x[1] * rs * g0.y); o.y = cvt_pk_bf16(x[2] * rs * g0.z, x[3] * rs * g0.w); o.z = cvt_pk_bf16(x[4] * rs * g1.x, x[5] * rs * g1.y); o.w = cvt_pk_bf16(x[6] * rs * g1.z, x[7] * rs * g1.w);
            *(u32x4*)(cq + (size_t)r * 256 + 8 * lane) = o;
        } else if (lane < 48) {
            const int l2 = lane - 32; const float rs = __builtin_amdgcn_rsqf(s16 * (1.f / 128.f) + RMS_EPS);
            const f32x4 g0 = *(const f32x4*)(kvg + 8 * l2), g1 = *(const f32x4*)(kvg + 8 * l2 + 4);
            u32x4 o; o.x = cvt_pk_bf16(x[0] * rs * g0.x, x[1] * rs * g0.y); o.y = cvt_pk_bf16(x[2] * rs * g0.z, x[3] * rs * g0.w); o.z = cvt_pk_bf16(x[4] * rs * g1.x, x[5] * rs * g1.y); o.w = cvt_pk_bf16(x[6] * rs * g1.z, x[7] * rs * g1.w);
            *(u32x4*)(ckv + (size_t)r * 256 + 8 * l2) = o;
        } else {
            *(u32x4*)(ckv + (size_t)r * 256 + 128 + 8 * (lane - 48)) = (u32x4){0u, 0u, 0u, 0u};
            if (lane < 52) {
                const int l3 = lane - 48, i0 = 8 * (l3 & 1); const bool second = l3 >= 2; const float pos = (float)positions[r];
                float outv[8];
#pragma unroll
                for (int i = 0; i < 8; ++i) { const float invf = fast_exp2(-(float)(i0 + i) * (13.287712379549449f / 16.f)); const float an = pos * invf; float rev = an * 0.15915494309189535f; rev = rev - floorf(rev); const float cs = __builtin_amdgcn_cosf(rev), sn = __builtin_amdgcn_sinf(rev);
                    outv[i] = second ? (x[i] * cs + px[i] * sn) : (x[i] * cs - px[i] * sn);
                    if (!second) { ang[(size_t)r * 32 + 2 * (i0 + i)] = cs; ang[(size_t)r * 32 + 2 * (i0 + i) + 1] = sn; } }
                u32x4 o; o.x = cvt_pk_bf16(outv[0], outv[1]); o.y = cvt_pk_bf16(outv[2], outv[3]); o.z = cvt_pk_bf16(outv[4], outv[5]); o.w = cvt_pk_bf16(outv[6], outv[7]);
                *(u32x4*)(kr + (size_t)r * 32 + 8 * l3) = o;
            }
        }
    }
}
__device__ __forceinline__ void mla_qrope_phase(const Frame& F, bf16* q, const float* ang) {
    const int gw = F.bid * NWAVES + F.wave, NGW = F.G * NWAVES, lane = F.lane;
    const int hh = lane >> 2, part = lane & 3, i0 = 8 * (part & 1); const bool second = part >= 2;
    for (int r = gw; r < M; r += NGW) {
        bf16* p = q + (size_t)r * 1536 + 96 * hh + 64 + 8 * part;
        const u32x4 wv = *(const u32x4*)p;
        float x[8] = {bflo(wv.x), bfhi(wv.x), bflo(wv.y), bfhi(wv.y), bflo(wv.z), bfhi(wv.z), bflo(wv.w), bfhi(wv.w)};
        float outv[8];
#pragma unroll
        for (int i = 0; i < 8; ++i) { const float px = __shfl_xor(x[i], 2); const f32x2 cssn = *(const f32x2*)(ang + (size_t)r * 32 + 2 * (i0 + i));
            outv[i] = second ? (x[i] * cssn.x + px * cssn.y) : (x[i] * cssn.x - px * cssn.y); }
        u32x4 o; o.x = cvt_pk_bf16(outv[0], outv[1]); o.y = cvt_pk_bf16(outv[2], outv[3]); o.z = cvt_pk_bf16(outv[4], outv[5]); o.w = cvt_pk_bf16(outv[6], outv[7]);
        *(u32x4*)p = o;
    }
}
constexpr int NPHASE = 37;
#ifndef MK_ONE_LAUNCH
#define MK_ONE_LAUNCH 1
#endif
#ifndef MK_NRUN
#define MK_NRUN NPHASE
#endif
__global__ void __launch_bounds__(NTHREADS, 2) fwd_kernel(Args args) {
    extern __shared__ __attribute__((aligned(16))) unsigned char lds_raw[];
    Frame F;
    F.lds = (LAS unsigned char*)lds_raw;
    F.tid = threadIdx.x; F.lane = F.tid & 63; F.wave = __builtin_amdgcn_readfirstlane(F.tid >> 6);
    F.G = gridDim.x; F.bid = blockIdx.x;
    F.ws = args.ws; F.ctl = (unsigned*)(args.ws + WS_CTL);
    unsigned char* ws = args.ws;
    const int lo = args.ph_lo, hi = args.ph_hi;
    for (int u = F.tid; u < (LDS_BYTES - LDSCTL_OFF) / 4; u += NTHREADS) ((LAS unsigned*)(F.lds + LDSCTL_OFF))[u] = 0u;
    __syncthreads();
    XcdBarrier bar; bar.bar = F.ctl + CW_BAR; bar.x = 0; bar.st = nullptr;
    const bool multi = (hi - lo) > 1;
    if (multi) bar = xcd_barrier_post(F.ctl + CW_BAR, (volatile LAS unsigned*)(F.lds + LDSCTL_OFF + 64));
#define IN(k) (lo <= (k) && (k) < hi)
#define SEAM(k) do { if (IN(k) && IN((k) + 1)) xcd_barrier(bar); } while (0)
#define INP(i) ((const float*)args.in[i])
    float* XF = args.out;
    bf16* XB = (bf16*)(ws + WS_XB);
    bf16* H = (bf16*)(ws + B_H);
    bf16* OB = (bf16*)(ws + B_OB);
    bf16* XR = (bf16*)(ws + WS_R2); bf16* YK = (bf16*)(ws + WS_R2);
    LAS unsigned char* ring = F.lds;

#define GEMM(EpiT, Aptr, lda_, Bptr, Nn, Kk, epi) do { pg8::Gemm g_{(Aptr), (Bptr), M, (Nn), (Kk), (lda_), 0}; pg8::StaticOrder S_; S_.init(M, (Nn), F.G, F.bid); \
        pg8::gemm_phase<EpiT, pg8::StaticOrder>(ring, g_, S_, (epi)); } while (0)
#define FFN_DENSE(p0, WGU, WDN, lg, lb) do { \
        if (IN(p0)) { GEMM(pg8::EpiSwiGLU, XB, D, (const bf16*)(ws + (WGU)), 2 * FF, D, (pg8::EpiSwiGLU{H, FF})); } SEAM(p0); \
        if (IN((p0) + 1)) { GEMM(pg8::EpiResid, H, FF, (const bf16*)(ws + (WDN)), D, FF, (pg8::EpiResid{XF, XF, ALPHA})); } SEAM((p0) + 1); \
        if (IN((p0) + 2)) { ln_phase(F, XF, XB, (lg), (lb)); } SEAM((p0) + 2); } while (0)
#define FFN_MOE(p0, slot_, WR, WGU, WDN, lmg, lmb, lfg, lfb, OUTF) do { \
        unsigned* cnt_ = F.ctl + CW_CNT + (slot_) * 512; \
        if (IN(p0)) { ln_route_phase(F, XF, XB, (lmg), (lmb), (WR), cnt_); } SEAM(p0); \
        if (IN((p0) + 1)) { moe_gather_phase(F, XB, XR, cnt_); } SEAM((p0) + 1); \
        if (IN((p0) + 2)) { int cv_[NE], ps_[NE]; pg8::MoeOrder S_; const int rows_ = moe_segments(cnt_, cv_, ps_, S_.pend); S_.so.init(rows_, 2 * FF, F.G, F.bid); \
            pg8::Gemm g_{XR, (const bf16*)(ws + (WGU)), rows_, 2 * FF, D, D, (size_t)2 * FF * D}; pg8::gemm_phase<pg8::EpiSwiGLU, pg8::MoeOrder>(ring, g_, S_, pg8::EpiSwiGLU{H, FF}); } SEAM((p0) + 2); \
        if (IN((p0) + 3)) { int cv_[NE], ps_[NE]; pg8::MoeOrder S_; const int rows_ = moe_segments(cnt_, cv_, ps_, S_.pend); S_.so.init(rows_, D, F.G, F.bid); \
            pg8::Gemm g_{H, (const bf16*)(ws + (WDN)), rows_, D, FF, FF, (size_t)D * FF}; \
            pg8::gemm_phase<pg8::EpiMoeDown, pg8::MoeOrder>(ring, g_, S_, pg8::EpiMoeDown{YK, (const int*)(ws + S_ROWTOK), (const float*)(ws + S_ROWGATE)}); } SEAM((p0) + 3); \
        if (IN((p0) + 4)) { ln_moe_phase(F, XF, YK, (OUTF), XB, (lfg), (lfb)); } SEAM((p0) + 4); } while (0)

    if (IN(0)) {
        convert_matrix(F, INP(I_A_WIN), 1024, 4096, (bf16*)(ws + W_A_IN), 1024, 4096, 0, 1);
        convert_matrix(F, INP(I_A_WOUT), 2048, 1024, (bf16*)(ws + W_A_OUT), 2048, 1024, 0, 1);
        convert_matrix(F, INP(I_B_WIN), 1024, 3396, (bf16*)(ws + W_B_IN), 1024, 3584, 0, 1);
        convert_matrix(F, INP(I_B_WOUT), 1024, 1024, (bf16*)(ws + W_B_OUT), 1024, 1024, 0, 1);
        convert_matrix(F, INP(I_C_WIN), 1024, 4096, (bf16*)(ws + W_C_IN), 1024, 4096, 0, 1);
        convert_matrix(F, INP(I_C_WOUT), 1024, 1024, (bf16*)(ws + W_C_OUT), 1024, 1024, 0, 1);
        convert_matrix(F, INP(I_D_WIN), 1024, 416, (bf16*)(ws + W_D_IN), 1024, 512, 0, 1);
        convert_matrix(F, INP(I_D_WUQ), 256, 1536, (bf16*)(ws + W_D_UQ), 256, 1536, 0, 1);
        convert_matrix(F, INP(I_D_WUKV), 128, 2048, (bf16*)(ws + W_D_UKV), 256, 2048, 0, 1);
        convert_matrix(F, INP(I_D_WOUT), 1024, 1024, (bf16*)(ws + W_D_OUT), 1024, 1024, 0, 1);
        convert_matrix(F, INP(I_F0_GU), 1024, 2 * FF, (bf16*)(ws + W_F0_GU), 1024, 2 * FF, 1, 1);
        convert_matrix(F, INP(I_F0_DN), FF, 1024, (bf16*)(ws + W_F0_DN), FF, 1024, 0, 1);
        convert_matrix(F, INP(I_F2_GU), 1024, 2 * FF, (bf16*)(ws + W_F2_GU), 1024, 2 * FF, 1, 1);
        convert_matrix(F, INP(I_F2_DN), FF, 1024, (bf16*)(ws + W_F2_DN), FF, 1024, 0, 1);
        convert_matrix(F, INP(I_M1_GU), 1024, 2 * FF, (bf16*)(ws + W_M1_GU), 1024, 2 * FF, 1, NE);
        convert_matrix(F, INP(I_M1_DN), FF, 1024, (bf16*)(ws + W_M1_DN), FF, 1024, 0, NE);
        convert_matrix(F, INP(I_M3_GU), 1024, 2 * FF, (bf16*)(ws + W_M3_GU), 1024, 2 * FF, 1, NE);
        convert_matrix(F, INP(I_M3_DN), FF, 1024, (bf16*)(ws + W_M3_DN), FF, 1024, 0, NE);
        cvt_rows_phase(F, INP(I_X), XB);
    }
    SEAM(0);
    { bf16* UV = (bf16*)(ws + B_UV); bf16* GATED = (bf16*)(ws + B_GATED); float* STATS = (float*)(ws + S_STATS);
      if (IN(1)) { GEMM(pg8::EpiBf16<1>, XB, D, (const bf16*)(ws + W_A_IN), 4096, D, (pg8::EpiBf16<1>{UV, 4096})); } SEAM(1);
      if (IN(2)) { gmlp_stats_phase(F, UV, STATS); } SEAM(2);
      if (IN(3)) { gmlp_spatial_phase(F, UV, STATS, INP(I_A_WS), INP(I_A_BS), INP(I_A_LNG), INP(I_A_LNB), GATED); } SEAM(3);
      if (IN(4)) { GEMM(pg8::EpiResid, GATED, 2048, (const bf16*)(ws + W_A_OUT), D, 2048, (pg8::EpiResid{INP(I_X), XF, ALPHA})); } SEAM(4);
      if (IN(5)) { ln_phase(F, XF, XB, INP(I_LNM_G), INP(I_LNM_B)); } SEAM(5); }
    FFN_DENSE(6, W_F0_GU, W_F0_DN, INP(I_LNF_G), INP(I_LNF_B));
    { bf16* PROJ = (bf16*)(ws + B_PROJB); u64* MASK = (u64*)(ws + S_MASK);
      if (IN(9)) { GEMM(pg8::EpiBf16<0>, XB, D, (const bf16*)(ws + W_B_IN), 3584, D, (pg8::EpiBf16<0>{PROJ, 3584})); } SEAM(9);
      if (IN(10)) { dsa_topk_phase(F, PROJ, MASK); } SEAM(10);
      if (IN(11)) { AttnArgs A; A.Q = PROJ; A.ldq = PB_LD; A.qoff = 0; A.K1 = PROJ; A.ldk1 = PB_LD; A.k1off = 1024; A.k1hs = 64; A.K2 = nullptr; A.ldk2 = 0; A.V = PROJ; A.ldv = PB_LD; A.voff = 2048; A.vhs = 64;
          A.O = OB; A.mask = MASK; A.scale_log2 = 0.125f * 1.4426950408889634f; attn_phase<64, true>(F, A); } SEAM(11);
      if (IN(12)) { GEMM(pg8::EpiResid, OB, D, (const bf16*)(ws + W_B_OUT), D, D, (pg8::EpiResid{XF, XF, ALPHA})); } SEAM(12); }
    FFN_MOE(13, 0, INP(I_M1_R), W_M1_GU, W_M1_DN, INP(I_LNM_G) + D, INP(I_LNM_B) + D, INP(I_LNF_G) + D, INP(I_LNF_B) + D, XF);
    { bf16* PROJ = (bf16*)(ws + B_PROJC); float* OPRE = (float*)(ws + B_OPRE);
      if (IN(18)) { GEMM(pg8::EpiBf16<0>, XB, D, (const bf16*)(ws + W_C_IN), 4096, D, (pg8::EpiBf16<0>{PROJ, 4096})); } SEAM(18);
      if (IN(19)) { hgrn2_scan_phase(F, PROJ, INP(I_C_LB), OPRE); } SEAM(19);
      if (IN(20)) { hgrn2_norm_phase(F, OPRE, PROJ, INP(I_C_NG), OB); } SEAM(20);
      if (IN(21)) { GEMM(pg8::EpiResid, OB, D, (const bf16*)(ws + W_C_OUT), D, D, (pg8::EpiResid{XF, XF, ALPHA})); } SEAM(21);
      if (IN(22)) { ln_phase(F, XF, XB, INP(I_LNM_G) + 2 * D, INP(I_LNM_B) + 2 * D); } SEAM(22); }
    FFN_DENSE(23, W_F2_GU, W_F2_DN, INP(I_LNF_G) + 2 * D, INP(I_LNF_B) + 2 * D);
    { float* PROJD = (float*)(ws + B_PROJD); bf16* CQ = (bf16*)(ws + B_CQ); bf16* CKV = (bf16*)(ws + B_CKV); bf16* Q = (bf16*)(ws + B_Q); bf16* KV = (bf16*)(ws + B_KV);
      bf16* KR = (bf16*)(ws + S_KR); float* ANG = (float*)(ws + S_ANG);
      if (IN(26)) { GEMM(pg8::EpiF32, XB, D, (const bf16*)(ws + W_D_IN), 512, D, (pg8::EpiF32{PROJD, 512})); } SEAM(26);
      if (IN(27)) { mla_norm_phase(F, PROJD, (const int*)args.in[I_POS], INP(I_D_QNG), INP(I_D_KVNG), CQ, CKV, KR, ANG); } SEAM(27);
      if (IN(28)) { GEMM(pg8::EpiBf16<0>, CQ, 256, (const bf16*)(ws + W_D_UQ), 1536, 256, (pg8::EpiBf16<0>{Q, 1536}));
                    GEMM(pg8::EpiBf16<0>, CKV, 256, (const bf16*)(ws + W_D_UKV), 2048, 256, (pg8::EpiBf16<0>{KV, 2048})); } SEAM(28);
      if (IN(29)) { mla_qrope_phase(F, Q, ANG); } SEAM(29);
      if (IN(30)) { AttnArgs A; A.Q = Q; A.ldq = 1536; A.qoff = 0; A.K1 = KV; A.ldk1 = 2048; A.k1off = 0; A.k1hs = 128; A.K2 = KR; A.ldk2 = 32; A.V = KV; A.ldv = 2048; A.voff = 64; A.vhs = 128;
          A.O = OB; A.mask = nullptr; A.scale_log2 = 0.10206207261596577f * 1.4426950408889634f; attn_phase<96, false>(F, A); } SEAM(30);
      if (IN(31)) { GEMM(pg8::EpiResid, OB, D, (const bf16*)(ws + W_D_OUT), D, D, (pg8::EpiResid{XF, XF, ALPHA})); } SEAM(31); }
    FFN_MOE(32, 1, INP(I_M3_R), W_M3_GU, W_M3_DN, INP(I_LNM_G) + 3 * D, INP(I_LNM_B) + 3 * D, INP(I_LNF_G) + 3 * D, INP(I_LNF_B) + 3 * D, args.out);
#undef IN
#undef SEAM
}

extern "C" void kernel_launch(void* const* d_in, const int* in_sizes, int n_in, void* d_out, int out_size, void* d_ws, size_t ws_size, hipStream_t stream) {
    static int grid = 0;
    if (grid == 0) {
        if (n_in != 34 || out_size != M * D || ws_size < WS_END) { fprintf(stderr, "kernel_launch: unexpected problem (n_in %d, out %d, ws %zu < %zu)\n", n_in, out_size, ws_size, (size_t)WS_END); grid = -1; return; }
        int dev = 0, cus = 0;
        if (hipGetDevice(&dev) != hipSuccess || hipDeviceGetAttribute(&cus, hipDeviceAttributeMultiprocessorCount, dev) != hipSuccess) { grid = -1; return; }
        if (hipFuncSetAttribute((const void*)fwd_kernel, hipFuncAttributeMaxDynamicSharedMemorySize, LDS_BYTES) != hipSuccess) { fprintf(stderr, "kernel_launch: hipFuncSetAttribute failed\n"); grid = -1; return; }
        int per_cu = 0;
        if (hipOccupancyMaxActiveBlocksPerMultiprocessor(&per_cu, (const void*)fwd_kernel, NTHREADS, LDS_BYTES) != hipSuccess || per_cu < 1) fprintf(stderr, "kernel_launch: occupancy query reports %d\n", per_cu);
        (void)hipGetLastError();
        grid = cus;
    }
    if (grid < 0) return;
    if (hipMemsetAsync((char*)d_ws + WS_CTL, 0, CTL_ZERO_BYTES, stream) != hipSuccess) return;
    Args a{};
    for (int i = 0; i < 34; ++i) a.in[i] = d_in[i];
    a.out = (float*)d_out; a.ws = (unsigned char*)d_ws;
#if MK_ONE_LAUNCH
    a.ph_lo = 0; a.ph_hi = MK_NRUN;
    hipLaunchKernelGGL(fwd_kernel, dim3(grid), dim3(NTHREADS), LDS_BYTES, stream, a);
#else
    for (int p = 0; p < MK_NRUN; ++p) { a.ph_lo = p; a.ph_hi = p + 1; hipLaunchKernelGGL(fwd_kernel, dim3(grid), dim3(NTHREADS), LDS_BYTES, stream, a); }
#endif
}
```

```cpp
#include <hip/hip_runtime.h>
#include <cstdio>
#include <cstdint>

#define LAS __attribute__((address_space(3)))
#define GAS __attribute__((address_space(1)))
typedef unsigned short bf16;
typedef short bf16x8 __attribute__((ext_vector_type(8)));
typedef short s16x4 __attribute__((ext_vector_type(4)));
typedef float f32x2 __attribute__((ext_vector_type(2)));
typedef float f32x4 __attribute__((ext_vector_type(4)));
typedef float f32x16 __attribute__((ext_vector_type(16)));
typedef unsigned u32x2 __attribute__((ext_vector_type(2)));
typedef unsigned u32x4 __attribute__((ext_vector_type(4)));
typedef unsigned long long u64;

constexpr int NB = 8, SEQ = 2048, D = 1024, M = NB * SEQ;
constexpr int FF = 3584, NE = 8;
constexpr int MOE_ROWS = 34816;
constexpr float ALPHA = 1.6817928305074290f;
constexpr float LN_EPS = 1e-5f, RMS_EPS = 1e-6f;
constexpr int NWAVES = 8, NTHREADS = 512;

constexpr size_t MiB = 1u << 20;
constexpr size_t WS_CTL = 0, CTL_ZERO_BYTES = 1 * MiB;
constexpr size_t WS_W0 = 1 * MiB;
constexpr size_t W_A_IN = WS_W0;
constexpr size_t W_A_OUT = W_A_IN + 8 * MiB;
constexpr size_t W_B_IN = W_A_OUT + 4 * MiB;
constexpr size_t W_B_OUT = W_B_IN + 7 * MiB;
constexpr size_t W_C_IN = W_B_OUT + 2 * MiB;
constexpr size_t W_C_OUT = W_C_IN + 8 * MiB;
constexpr size_t W_D_IN = W_C_OUT + 2 * MiB;
constexpr size_t W_D_UQ = W_D_IN + 1 * MiB;
constexpr size_t W_D_UKV = W_D_UQ + 1 * MiB;
constexpr size_t W_D_OUT = W_D_UKV + 1 * MiB;
constexpr size_t W_F0_GU = W_D_OUT + 2 * MiB;
constexpr size_t W_F0_DN = W_F0_GU + 14 * MiB;
constexpr size_t W_F2_GU = W_F0_DN + 7 * MiB;
constexpr size_t W_F2_DN = W_F2_GU + 14 * MiB;
constexpr size_t W_M1_GU = W_F2_DN + 7 * MiB;
constexpr size_t W_M1_DN = W_M1_GU + 112 * MiB;
constexpr size_t W_M3_GU = W_M1_DN + 56 * MiB;
constexpr size_t W_M3_DN = W_M3_GU + 112 * MiB;
constexpr size_t WS_WEND = W_M3_DN + 56 * MiB;
constexpr size_t WS_XB = WS_WEND;
constexpr size_t WS_SMALL = WS_XB + 32 * MiB;
constexpr size_t S_STATS = WS_SMALL;
constexpr size_t S_TOKE = WS_SMALL + 128 * 1024;
constexpr size_t S_TOKG = WS_SMALL + 256 * 1024;
constexpr size_t S_SLOT = WS_SMALL + 384 * 1024;
constexpr size_t S_ROWTOK = WS_SMALL + 512 * 1024;
constexpr size_t S_ROWGATE = WS_SMALL + 768 * 1024;
constexpr size_t S_ANG = WS_SMALL + 1 * MiB;
constexpr size_t S_KR = WS_SMALL + 3 * MiB;
constexpr size_t S_MASK = WS_SMALL + 4 * MiB;
constexpr size_t WS_BIG = WS_SMALL + 8 * MiB;
constexpr size_t WS_R2 = WS_BIG + 238 * MiB;
constexpr size_t WS_END = WS_R2 + 68 * MiB;
static_assert(WS_WEND == 415 * MiB, "weight map");
static_assert(WS_END <= 880 * MiB, "workspace budget");
constexpr size_t B_UV = WS_BIG, B_GATED = WS_BIG + 128 * MiB;
constexpr size_t B_PROJB = WS_BIG, B_OB = WS_BIG + 192 * MiB;
constexpr size_t B_PROJC = WS_BIG, B_OPRE = WS_BIG + 128 * MiB;
constexpr size_t B_PROJD = WS_BIG, B_CQ = WS_BIG + 32 * MiB, B_CKV = WS_BIG + 40 * MiB, B_Q = WS_BIG + 48 * MiB, B_KV = WS_BIG + 96 * MiB;
constexpr size_t B_H = WS_BIG;
constexpr int CW_BAR = 4096;
constexpr int CW_CNT = 16384;

constexpr int RING_BYTES = 131072;
constexpr int LDSCTL_OFF = RING_BYTES;
constexpr int LDS_BYTES = 147456;

typedef __bf16 bf16x2_t __attribute__((ext_vector_type(2)));
__device__ __forceinline__ unsigned cvt_pk_bf16(float lo, float hi) { const f32x2 v = {lo, hi}; const bf16x2_t b = __builtin_convertvector(v, bf16x2_t); return __builtin_bit_cast(unsigned, b); }
__device__ __forceinline__ float bf2f(unsigned short b) { return __uint_as_float((unsigned)b << 16); }
__device__ __forceinline__ float bflo(unsigned w) { return __uint_as_float(w << 16); }
__device__ __forceinline__ float bfhi(unsigned w) { return __uint_as_float(w & 0xffff0000u); }
__device__ __forceinline__ float fast_exp2(float x) { return __builtin_amdgcn_exp2f(x); }
__device__ __forceinline__ float fast_rcp(float x) { return __builtin_amdgcn_rcpf(x); }
__device__ __forceinline__ float sigmoidf_(float x) { return fast_rcp(1.0f + fast_exp2(-1.4426950408889634f * x)); }
__device__ __forceinline__ float siluf_(float x) { return x * sigmoidf_(x); }
__device__ __forceinline__ float gelu_tanh(float x) { const float u = x + 0.044715f * x * x * x; return x * fast_rcp(1.0f + fast_exp2(-2.302208198f * u)); }
__device__ __forceinline__ float wave_sum(float v) {
#pragma unroll
    for (int o = 1; o < 64; o <<= 1) v += __shfl_xor(v, o);
    return v;
}
#define LDS_WAIT() asm volatile("s_waitcnt lgkmcnt(0)" ::: "memory")
#define VM_WAIT() asm volatile("s_waitcnt vmcnt(0)" ::: "memory")
#define LDS_BARRIER() asm volatile("s_waitcnt lgkmcnt(0)\n\ts_barrier" ::: "memory")
namespace pg8 {
constexpr int BM = 256, BK = 64, HALF = 128, HTB = HALF * BK * 2  , STAGE_BYTES = 8 * HTB, NXCD = 8, WGM = 8;
__host__ __device__ __forceinline__ int lds_byte(int r, int c) { const int st = (r >> 4) * 2 + (c >> 5), rr = r & 15, cc = c & 31, ob = rr * 64 + cc * 2; return st * 1024 + (ob ^ (((ob >> 9) & 1) << 5)); }
__host__ __device__ __forceinline__ void stage_rc(int b, int& R, int& C) { const int st = b / 1024, sb = b % 1024, swz = sb ^ (((sb >> 9) & 1) << 5); R = (st >> 1) * 16 + swz / 64; C = (st & 1) * 32 + (swz % 64) / 2; }
__host__ __device__ __forceinline__ int perm32(int rho) { const int n = rho >> 4, i = rho & 15; return 8 * (i >> 2) + 4 * n + (i & 3); }

struct Unit { int pm, pn, e; };
struct Gemm { const bf16* A; const bf16* Bt; int M, N, K, lda; size_t bes; };

struct StaticOrder {
    int nM, nN, nwg, G, c;
    __device__ void init(int M_, int N_, int G_, int c_) { nM = M_ / BM; nN = N_ / BM; nwg = nM * nN; G = G_; c = c_; }
    __device__ bool next(int i, Unit& u) const {
        const long L = (long)i * G + c; if (L >= nwg) return false;
        int wgid = (int)L; { const int q = nwg / NXCD, r = nwg % NXCD, xcd = wgid % NXCD, off = wgid / NXCD; wgid = (xcd < r ? xcd * (q + 1) : r * (q + 1) + (xcd - r) * q) + off; }
        const int nig = WGM * nN, gid = wgid / nig, fm = gid * WGM, gsz = (nM - fm) < WGM ? (nM - fm) : WGM;
        u.pm = fm + ((wgid % nig) % gsz); u.pn = (wgid % nig) / gsz; u.e = 0; return true;
    }
};
struct MoeOrder {
    StaticOrder so; int pend[NE];
    __device__ bool next(int i, Unit& u) const {
        if (!so.next(i, u)) return false;
        const int r0 = u.pm * BM; int e = 0;
#pragma unroll
        for (int j = 0; j < NE - 1; ++j) e += (r0 >= pend[j]) ? 1 : 0;
        u.e = e; return true;
    }
};

template <int ACT  > struct EpiBf16 {
    static constexpr bool PERM = true;
    bf16* O; int ldc;
    __device__ __forceinline__ void operator()(const f32x4 (&acc)[2][2][4][2], const Unit& u, int wr, int wc, int fr, int fq) const {
        const int row0 = u.pm * BM + wr * 64 + fr, col0 = u.pn * BM + wc * 32 + 8 * fq;
#pragma unroll
        for (int ai = 0; ai < 2; ++ai)
#pragma unroll
            for (int m = 0; m < 4; ++m) { bf16* rowp = O + (size_t)(row0 + ai * HALF + m * 16) * ldc + col0;
#pragma unroll
                for (int bj = 0; bj < 2; ++bj) { f32x4 v0 = acc[ai][bj][m][0], v1 = acc[ai][bj][m][1];
                    if (ACT == 1) { v0 = (f32x4){gelu_tanh(v0[0]), gelu_tanh(v0[1]), gelu_tanh(v0[2]), gelu_tanh(v0[3])}; v1 = (f32x4){gelu_tanh(v1[0]), gelu_tanh(v1[1]), gelu_tanh(v1[2]), gelu_tanh(v1[3])}; }
                    u32x4 w; w.x = cvt_pk_bf16(v0[0], v0[1]); w.y = cvt_pk_bf16(v0[2], v0[3]); w.z = cvt_pk_bf16(v1[0], v1[1]); w.w = cvt_pk_bf16(v1[2], v1[3]);
                    *(u32x4*)(rowp + bj * HALF) = w; } }
    }
};
struct EpiSwiGLU {
    static constexpr bool PERM = true;
    bf16* H; int ldh;
    __device__ __forceinline__ void operator()(const f32x4 (&acc)[2][2][4][2], const Unit& u, int wr, int wc, int fr, int fq) const {
        const int row0 = u.pm * BM + wr * 64 + fr, col0 = u.pn * HALF + wc * 32 + 8 * fq;
#pragma unroll
        for (int ai = 0; ai < 2; ++ai)
#pragma unroll
            for (int m = 0; m < 4; ++m) { bf16* rowp = H + (size_t)(row0 + ai * HALF + m * 16) * ldh + col0;
                const f32x4 g0 = acc[ai][0][m][0], g1 = acc[ai][0][m][1], u0 = acc[ai][1][m][0], u1 = acc[ai][1][m][1];
                u32x4 w; w.x = cvt_pk_bf16(siluf_(g0[0]) * u0[0], siluf_(g0[1]) * u0[1]); w.y = cvt_pk_bf16(siluf_(g0[2]) * u0[2], siluf_(g0[3]) * u0[3]);
                w.z = cvt_pk_bf16(siluf_(g1[0]) * u1[0], siluf_(g1[1]) * u1[1]); w.w = cvt_pk_bf16(siluf_(g1[2]) * u1[2], siluf_(g1[3]) * u1[3]);
                *(u32x4*)rowp = w; }
    }
};
struct EpiResid {
    static constexpr bool PERM = false;
    const bf16* X; float* Y; float alpha;
    __device__ __forceinline__ void operator()(const f32x4 (&acc)[2][2][4][2], const Unit& u, int wr, int wc, int fr, int fq) const {
        const int row0 = u.pm * BM + wr * 64 + fr, col0 = u.pn * BM + wc * 32 + 4 * fq;
#pragma unroll
        for (int ai = 0; ai < 2; ++ai)
#pragma unroll
            for (int m = 0; m < 4; ++m) { const size_t off = (size_t)(row0 + ai * HALF + m * 16) * D + col0;
#pragma unroll
                for (int bj = 0; bj < 2; ++bj)
#pragma unroll
                    for (int n = 0; n < 2; ++n) { const u32x2 xw = *(const u32x2*)(X + off + bj * HALF + n * 16); const f32x4 xv = (f32x4){bflo(xw.x), bfhi(xw.x), bflo(xw.y), bfhi(xw.y)};
                        *(f32x4*)(Y + off + bj * HALF + n * 16) = xv * alpha + acc[ai][bj][m][n]; } }
    }
};
struct EpiF32 {
    static constexpr bool PERM = false;
    float* C; int ldc;
    __device__ __forceinline__ void operator()(const f32x4 (&acc)[2][2][4][2], const Unit& u, int wr, int wc, int fr, int fq) const {
        const int row0 = u.pm * BM + wr * 64 + fr, col0 = u.pn * BM + wc * 32 + 4 * fq;
#pragma unroll
        for (int ai = 0; ai < 2; ++ai)
#pragma unroll
            for (int m = 0; m < 4; ++m) { float* rowp = C + (size_t)(row0 + ai * HALF + m * 16) * ldc + col0;
#pragma unroll
                for (int bj = 0; bj < 2; ++bj)
#pragma unroll
                    for (int n = 0; n < 2; ++n) *(f32x4*)(rowp + bj * HALF + n * 16) = acc[ai][bj][m][n]; }
    }
};
struct EpiMoeDown {
    static constexpr bool PERM = true;
    bf16* YK; const int* rowtok; const float* rowgate;
    __device__ __forceinline__ void operator()(const f32x4 (&acc)[2][2][4][2], const Unit& u, int wr, int wc, int fr, int fq) const {
        const int row0 = u.pm * BM + wr * 64 + fr, col0 = u.pn * BM + wc * 32 + 8 * fq;
#pragma unroll
        for (int ai = 0; ai < 2; ++ai)
#pragma unroll
            for (int m = 0; m < 4; ++m) { const int r = row0 + ai * HALF + m * 16; const int rt = rowtok[r]; const float gt = rowgate[r];
                if (rt >= 0) { bf16* rowp = YK + (size_t)(rt & 1) * ((size_t)M * D) + (size_t)(rt >> 1) * D + col0;
#pragma unroll
                    for (int bj = 0; bj < 2; ++bj) { const f32x4 v0 = acc[ai][bj][m][0] * gt, v1 = acc[ai][bj][m][1] * gt;
                        u32x4 w; w.x = cvt_pk_bf16(v0[0], v0[1]); w.y = cvt_pk_bf16(v0[2], v0[3]); w.z = cvt_pk_bf16(v1[0], v1[1]); w.w = cvt_pk_bf16(v1[2], v1[3]);
                        *(u32x4*)(rowp + bj * HALF) = w; } } }
    }
};

template <class Epi, class Sched>
__device__ __forceinline__ void gemm_phase(LAS unsigned char* lds, const Gemm g, const Sched& S, const Epi& E) {
    const int tid = threadIdx.x, wid = __builtin_amdgcn_readfirstlane(tid >> 6), lane = tid & 63, wr = wid >> 2, wc = wid & 3, fr = lane & 15, fq = lane >> 4;
    const int K = g.K, nt = K / BK;
    unsigned voffA[2], voffB[2];
#pragma unroll
    for (int i = 0; i < 2; ++i) { int R, C; stage_rc(tid * 16 + i * 8192, R, C); const int Rb = Epi::PERM ? ((R & ~31) + perm32(R & 31)) : R;
        voffA[i] = (unsigned)(R * g.lda + C) * 2u; voffB[i] = (unsigned)(Rb * K + C) * 2u; }
    const size_t kstep = (size_t)(BK * 2);
    const size_t hstepA = (size_t)HALF * g.lda * 2, tstepA = 2 * hstepA;
    const size_t hstepB = (size_t)HALF * K * 2, tstepB = 2 * hstepB;
    const size_t besB = g.bes * 2;
    const unsigned ldsw = (unsigned)wid * 1024u;
    const int aoff = lds_byte(wr * 64 + fr, fq * 8), boff = lds_byte(wc * 32 + fr, fq * 8);
#define PG8_SA(b, h) (((b) * 2 + (h)) * HTB)
#define PG8_SB(b, h) ((4 + (b) * 2 + (h)) * HTB)
#define PG8_STAGE(bufoff, gbase, voff) do { _Pragma("unroll") for (int _i = 0; _i < 2; ++_i) \
        __builtin_amdgcn_global_load_lds((const unsigned*)((const char*)(gbase) + (voff)[_i]), (LAS unsigned*)(lds + (bufoff) + ldsw + _i * 8192), 16, 0, 0); } while (0)
#define PG8_LDA(dst, b, h) do { _Pragma("unroll") for (int m = 0; m < 4; ++m) _Pragma("unroll") for (int k = 0; k < 2; ++k) dst[m][k] = *(const LAS bf16x8*)(lds + PG8_SA(b, h) + aoff + m * 2048 + k * 1024); } while (0)
#define PG8_LDB(dst, b, h) do { _Pragma("unroll") for (int n = 0; n < 2; ++n) _Pragma("unroll") for (int k = 0; k < 2; ++k) dst[n][k] = *(const LAS bf16x8*)(lds + PG8_SB(b, h) + boff + n * 2048 + k * 1024); } while (0)
#define PG8_MMA(ai, bj, At, Bt) do { __builtin_amdgcn_s_setprio(1); _Pragma("unroll") for (int m = 0; m < 4; ++m) _Pragma("unroll") for (int n = 0; n < 2; ++n) _Pragma("unroll") for (int k = 0; k < 2; ++k) \
        acc[ai][bj][m][n] = __builtin_amdgcn_mfma_f32_16x16x32_bf16(Bt[n][k], At[m][k], acc[ai][bj][m][n], 0, 0, 0); __builtin_amdgcn_s_setprio(0); } while (0)
#define PG8_WAIT_V(n) asm volatile("s_waitcnt vmcnt(" #n ")" ::: "memory")
#define PG8_WAIT_L(n) asm volatile("s_waitcnt lgkmcnt(" #n ")" ::: "memory")
#define PG8_BAR __builtin_amdgcn_s_barrier()
#define PG8_SCHED __builtin_amdgcn_sched_barrier(0)
    Unit cur, nxt; int ui = 0;
    if (!S.next(0, cur)) return;
    f32x4 acc[2][2][4][2];
#pragma unroll
    for (int a = 0; a < 2; ++a)
#pragma unroll
        for (int b = 0; b < 2; ++b)
#pragma unroll
            for (int m = 0; m < 4; ++m)
#pragma unroll
                for (int n = 0; n < 2; ++n) acc[a][b][m][n] = (f32x4){0.f, 0.f, 0.f, 0.f};
    bf16x8 At[4][2], B0[2][2], B1[2][2];
    const char* cA = (const char*)g.A + (size_t)cur.pm * tstepA; const char* cB = (const char*)g.Bt + (size_t)cur.e * besB + (size_t)cur.pn * tstepB;
    PG8_STAGE(PG8_SB(0, 0), cB, voffB); PG8_STAGE(PG8_SB(0, 1), cB + hstepB, voffB); PG8_STAGE(PG8_SA(0, 0), cA, voffA); PG8_STAGE(PG8_SA(0, 1), cA + hstepA, voffA);
    if (wr == 1) PG8_BAR;
    PG8_WAIT_V(2); PG8_BAR;
    PG8_STAGE(PG8_SB(1, 0), cB + kstep, voffB); PG8_STAGE(PG8_SA(1, 0), cA + kstep, voffA); PG8_STAGE(PG8_SB(1, 1), cB + hstepB + kstep, voffB);
    PG8_WAIT_V(6); PG8_BAR;
    for (;;) {
        const bool has_next = S.next(ui + 1, nxt);
        const char* nA = has_next ? (const char*)g.A + (size_t)nxt.pm * tstepA : cA; const char* nB = has_next ? (const char*)g.Bt + (size_t)nxt.e * besB + (size_t)nxt.pn * tstepB : cB;
        for (int t = 0; t < nt; t += 2) {
            const bool last = (t == nt - 2);
            const char* a1 = cA + (size_t)(t + 1) * kstep;
            const char* a2 = last ? nA : cA + (size_t)(t + 2) * kstep; const char* b2 = last ? nB : cB + (size_t)(t + 2) * kstep;
            const char* a3 = a2 + kstep; const char* b3 = b2 + kstep;
            PG8_LDB(B0, 0, 0); PG8_LDB(B1, 0, 1); PG8_SCHED; PG8_LDA(At, 0, 0); PG8_STAGE(PG8_SA(1, 1), a1 + hstepA, voffA);
            PG8_WAIT_V(8); PG8_WAIT_L(0); PG8_BAR; PG8_MMA(0, 0, At, B0); PG8_MMA(0, 1, At, B1); PG8_BAR; PG8_SCHED;
            PG8_LDA(At, 0, 1); PG8_STAGE(PG8_SB(0, 0), b2, voffB); PG8_STAGE(PG8_SB(0, 1), b2 + hstepB, voffB); PG8_STAGE(PG8_SA(0, 0), a2, voffA);
            PG8_WAIT_V(8); PG8_WAIT_L(0); PG8_BAR; PG8_MMA(1, 0, At, B0); PG8_MMA(1, 1, At, B1); PG8_BAR; PG8_SCHED;
            PG8_LDB(B0, 1, 0); PG8_LDB(B1, 1, 1); PG8_SCHED; PG8_LDA(At, 1, 0); PG8_STAGE(PG8_SA(0, 1), a2 + hstepA, voffA);
            PG8_WAIT_V(8); PG8_WAIT_L(0); PG8_BAR; PG8_MMA(0, 0, At, B0); PG8_MMA(0, 1, At, B1); PG8_BAR; PG8_SCHED;
            PG8_LDA(At, 1, 1); PG8_STAGE(PG8_SB(1, 0), b3, voffB); PG8_STAGE(PG8_SB(1, 1), b3 + hstepB, voffB); PG8_STAGE(PG8_SA(1, 0), a3, voffA);
            PG8_WAIT_V(8); PG8_WAIT_L(0); PG8_BAR; PG8_MMA(1, 0, At, B0); PG8_MMA(1, 1, At, B1); PG8_BAR; PG8_SCHED;
        }
        if (wr == 0) PG8_BAR;
        E(acc, cur, wr, wc, fr, fq);
        if (!has_next) break;
#pragma unroll
        for (int a = 0; a < 2; ++a)
#pragma unroll
            for (int b = 0; b < 2; ++b)
#pragma unroll
                for (int m = 0; m < 4; ++m)
#pragma unroll
                    for (int n = 0; n < 2; ++n) acc[a][b][m][n] = (f32x4){0.f, 0.f, 0.f, 0.f};
        cur = nxt; cA = nA; cB = nB; ++ui;
        if (wr == 1) PG8_BAR;
    }
    PG8_WAIT_V(0);
    PG8_BAR;
#undef PG8_SA
#undef PG8_SB
#undef PG8_STAGE
#undef PG8_LDA
#undef PG8_LDB
#undef PG8_MMA
#undef PG8_WAIT_V
#undef PG8_WAIT_L
#undef PG8_BAR
#undef PG8_SCHED
}
}
#define XB_TMO      128
#define XB_XCNT(j)  (256  + 64 * (j))
#define XB_XSUB(j)  (1280 + 64 * (j))
#define XB_XGEN(j)  (2304 + 64 * (j))
#define XB_TOP      3328
#define XB_TOPGEN   3392
#define XCD_BAR_WORDS 3456
#define XB_SPIN_CAP (1u << 18)
__device__ __forceinline__ unsigned xb_ld(unsigned* p)              { return __hip_atomic_load(p, __ATOMIC_RELAXED, __HIP_MEMORY_SCOPE_AGENT); }
__device__ __forceinline__ unsigned xb_add(unsigned* p, unsigned v) { return __hip_atomic_fetch_add(p, v, __ATOMIC_RELAXED, __HIP_MEMORY_SCOPE_AGENT); }
__device__ __forceinline__ unsigned xb_xcc_id() { return (unsigned)__builtin_amdgcn_s_getreg((3 << 11) | 20) & 0xFu; }
#define XB_SPIN(cond, bar) do { unsigned _sp = 0; while (cond) { __builtin_amdgcn_s_sleep(1); \
    if ((++_sp & 255u) == 0u) { if (xb_ld(&(bar)[XB_TMO])) break; if (_sp > XB_SPIN_CAP) { atomicAdd(&(bar)[XB_TMO], 1u); break; } } } } while (0)
struct XcdBarrier { unsigned* bar; unsigned x; volatile LAS unsigned* st; };
__device__ __forceinline__ XcdBarrier xcd_barrier_post(unsigned* bar, volatile LAS unsigned* st) {
    XcdBarrier b; b.bar = bar; b.x = xb_xcc_id(); b.st = st;
    if (threadIdx.x == 0) (void)xb_add(&bar[XB_XCNT(b.x)], 1u);
    return b;
}
__device__ __forceinline__ void xcd_barrier_complete(unsigned* bar, unsigned x, unsigned& nloc, unsigned& nx) {
    const unsigned G = gridDim.x * gridDim.y * gridDim.z;
    unsigned sum, cnt, mine, sp = 0u;
    for (;;) {
        sum = 0u; cnt = 0u; mine = 0u;
#pragma unroll
        for (unsigned j = 0; j < 16; ++j) { const unsigned c = xb_ld(&bar[XB_XCNT(j)]); sum += c; cnt += (c > 0u) ? 1u : 0u; mine = (j == x) ? c : mine; }
        if (sum == G) break;
        __builtin_amdgcn_s_sleep(1);
        if ((++sp & 255u) == 0u) { if (xb_ld(&bar[XB_TMO])) break; if (sp > XB_SPIN_CAP) { atomicAdd(&bar[XB_TMO], 1u); break; } }
    }
    nloc = mine > 0u ? mine : 1u; nx = cnt > 0u ? cnt : 1u;
}
__device__ __forceinline__ void xcd_barrier(const XcdBarrier& b) {
    asm volatile("s_waitcnt vmcnt(0)" ::: "memory");
    __syncthreads();
    if (threadIdx.x == 0) {
        unsigned* bar = b.bar;
        __builtin_amdgcn_s_waitcnt(0);
        unsigned nloc = b.st[0], nx = b.st[1];
        if (nloc == 0u) { xcd_barrier_complete(bar, b.x, nloc, nx); b.st[0] = nloc; b.st[1] = nx; }
        const unsigned old = xb_add(&bar[XB_XSUB(b.x)], 1u);
        const unsigned gen = old / nloc;
        if (old + 1u == (gen + 1u) * nloc) {
            __builtin_amdgcn_fence(__ATOMIC_RELEASE, "agent");
            asm volatile("s_waitcnt vmcnt(0)" ::: "memory");
            const unsigned og = xb_add(&bar[XB_TOP], 1u);
            const unsigned tg = og / nx;
            if (og + 1u == (tg + 1u) * nx) xb_add(&bar[XB_TOPGEN], 1u);
            else XB_SPIN(xb_ld(&bar[XB_TOPGEN]) == tg, bar);
            __builtin_amdgcn_fence(__ATOMIC_ACQUIRE, "agent");
            xb_add(&bar[XB_XGEN(b.x)], 1u);
            asm volatile("s_waitcnt vmcnt(0)" ::: "memory");
        } else {
            XB_SPIN(xb_ld(&bar[XB_XGEN(b.x)]) == gen, bar);
            __builtin_amdgcn_fence(__ATOMIC_ACQUIRE, "agent");
            asm volatile("s_waitcnt vmcnt(0)" ::: "memory");
        }
    }
    __syncthreads();
}

struct Frame {
    LAS unsigned char* lds;
    unsigned* ctl;
    unsigned char* ws;
    int tid, lane, wave, G, bid;
};
struct Args { const void* in[34]; float* out; unsigned char* ws; int ph_lo, ph_hi; };

enum { I_X = 0, I_POS, I_A_WIN, I_A_LNG, I_A_LNB, I_A_WS, I_A_BS, I_A_WOUT, I_B_WIN, I_B_WOUT, I_C_WIN, I_C_LB, I_C_NG, I_C_WOUT,
       I_D_WIN, I_D_QNG, I_D_WUQ, I_D_KVNG, I_D_WUKV, I_D_WOUT, I_F0_GU, I_F0_DN, I_M1_R, I_M1_GU, I_M1_DN, I_F2_GU, I_F2_DN, I_M3_R, I_M3_GU, I_M3_DN,
       I_LNM_G, I_LNM_B, I_LNF_G, I_LNF_B };

__device__ __forceinline__ void cvt_load(f32x4 (&r)[8], const float* W, int Kv, int Nv, int k0, int n0, int lane) {
    const int n = n0 + 4 * (lane & 7);
#pragma unroll
    for (int i = 0; i < 8; ++i) { const int k = k0 + 8 * i + (lane >> 3); r[i] = (k < Kv && n < Nv) ? *(const f32x4*)(W + (size_t)k * Nv + n) : (f32x4){0.f, 0.f, 0.f, 0.f}; }
}
__device__ __forceinline__ void cvt_store(const f32x4 (&r)[8], bf16* WT, int Kp, int mode, int k0, int n0, LAS float* scr, int lane) {
#pragma unroll
    for (int i = 0; i < 8; ++i) { LAS float* p = scr + (8 * i + (lane >> 3)) * 33 + 4 * (lane & 7); p[0] = r[i].x; p[1] = r[i].y; p[2] = r[i].z; p[3] = r[i].w; }
    LDS_WAIT(); asm volatile("" ::: "memory");
    int drow0;
    if (mode == 0) drow0 = n0; else { const int j = (n0 < FF) ? n0 : n0 - FF; drow0 = 256 * (j >> 7) + (j & 127) + ((n0 < FF) ? 0 : 128); }
    const int c = lane & 7;
#pragma unroll
    for (int j = 0; j < 4; ++j) { const int n = (lane >> 3) + 8 * j; const LAS float* s = scr + (8 * c) * 33 + n;
        u32x4 o; o.x = cvt_pk_bf16(s[0 * 33], s[1 * 33]); o.y = cvt_pk_bf16(s[2 * 33], s[3 * 33]); o.z = cvt_pk_bf16(s[4 * 33], s[5 * 33]); o.w = cvt_pk_bf16(s[6 * 33], s[7 * 33]);
        *(u32x4*)(WT + (size_t)(drow0 + n) * Kp + k0 + 8 * c) = o; }
    LDS_WAIT(); asm volatile("" ::: "memory");
}
__device__ __forceinline__ void convert_matrix(const Frame& F, const float* W, int Kv, int Nv, bf16* WT, int Kp, int Np, int mode, int nmat) {
    LAS float* scr = (LAS float*)(F.lds + F.wave * 16384);
    const int gw = F.bid * NWAVES + F.wave, NGW = F.G * NWAVES;
    const int nkb = Kp / 64, nnb = Np / 32, per = nkb * nnb;
    const long total = (long)per * nmat;
#define CVT_DEC(it_, mat_, k0_, n0_) const int mat_ = (int)((it_) / per), r_##mat_ = (int)((it_) % per); const int k0_ = 64 * (r_##mat_ / nnb), n0_ = 32 * (r_##mat_ % nnb)
    f32x4 ra[8], rb[8];
    long it = gw;
    if (it < total) { CVT_DEC(it, m0, k0, n0); cvt_load(ra, W + (size_t)m0 * Kv * Nv, Kv, Nv, k0, n0, F.lane); }
    while (it < total) {
        { const long nx = it + NGW; if (nx < total) { CVT_DEC(nx, m1, k1, n1); cvt_load(rb, W + (size_t)m1 * Kv * Nv, Kv, Nv, k1, n1, F.lane); }
          CVT_DEC(it, m0, k0, n0); cvt_store(ra, WT + (size_t)m0 * Kp * Np, Kp, mode, k0, n0, scr, F.lane); it = nx; }
        if (it >= total) break;
        { const long nx = it + NGW; if (nx < total) { CVT_DEC(nx, m1, k1, n1); cvt_load(ra, W + (size_t)m1 * Kv * Nv, Kv, Nv, k1, n1, F.lane); }
          CVT_DEC(it, m0, k0, n0); cvt_store(rb, WT + (size_t)m0 * Kp * Np, Kp, mode, k0, n0, scr, F.lane); it = nx; }
    }
#undef CVT_DEC
}

__device__ __forceinline__ void ln_row(f32x4 (&v)[4], const float* g, const float* b, int lane) {
    float s = 0.f;
#pragma unroll
    for (int j = 0; j < 4; ++j) s += (v[j].x + v[j].y) + (v[j].z + v[j].w);
    const float mean = wave_sum(s) * (1.f / D); float s2 = 0.f;
#pragma unroll
    for (int j = 0; j < 4; ++j) { v[j] = v[j] - mean; s2 += (v[j].x * v[j].x + v[j].y * v[j].y) + (v[j].z * v[j].z + v[j].w * v[j].w); }
    const float rstd = __builtin_amdgcn_rsqf(wave_sum(s2) * (1.f / D) + LN_EPS);
#pragma unroll
    for (int j = 0; j < 4; ++j) { const f32x4 gg = *(const f32x4*)(g + 4 * lane + 256 * j), bb = *(const f32x4*)(b + 4 * lane + 256 * j); v[j] = v[j] * rstd * gg + bb; }
}
__device__ __forceinline__ void store_row_bf(const f32x4 (&v)[4], bf16* ob, int lane) {
#pragma unroll
    for (int j = 0; j < 4; ++j) { u32x2 w; w.x = cvt_pk_bf16(v[j].x, v[j].y); w.y = cvt_pk_bf16(v[j].z, v[j].w); *(u32x2*)(ob + 4 * lane + 256 * j) = w; }
}
__device__ __forceinline__ void store_row_f32(const f32x4 (&v)[4], float* of, int lane) {
#pragma unroll
    for (int j = 0; j < 4; ++j) *(f32x4*)(of + 4 * lane + 256 * j) = v[j];
}
__device__ __forceinline__ void ln_phase(const Frame& F, const float* xf, bf16* xb, const float* g, const float* b) {
    const int gw = F.bid * NWAVES + F.wave, NGW = F.G * NWAVES;
    for (int r = gw; r < M; r += NGW) {
        f32x4 v[4];
#pragma unroll
        for (int j = 0; j < 4; ++j) v[j] = *(const f32x4*)(xf + (size_t)r * D + 4 * F.lane + 256 * j);
        ln_row(v, g, b, F.lane);
        store_row_bf(v, xb + (size_t)r * D, F.lane);
    }
}
__device__ __forceinline__ void ln_route_phase(const Frame& F, const float* xf, bf16* xb, const float* g, const float* b, const float* wr, unsigned* cnt  ) {
    LAS float* WR = (LAS float*)F.lds;
    LAS int* EB = (LAS int*)(F.lds + 32768);
    for (int i = F.tid; i < D * NE / 4; i += NTHREADS) ((LAS f32x4*)WR)[i] = ((const f32x4*)wr)[i];
    __syncthreads();
    int* toke = (int*)(F.ws + S_TOKE); float* tokg = (float*)(F.ws + S_TOKG); int* slot = (int*)(F.ws + S_SLOT);
    for (int blk = F.bid; blk < M / 64; blk += F.G) {
        for (int i = 0; i < 8; ++i) {
            const int rl = F.wave * 8 + i, r = blk * 64 + rl;
            f32x4 v[4];
#pragma unroll
            for (int j = 0; j < 4; ++j) v[j] = *(const f32x4*)(xf + (size_t)r * D + 4 * F.lane + 256 * j);
            ln_row(v, g, b, F.lane);
            store_row_bf(v, xb + (size_t)r * D, F.lane);
            float lg[NE];
#pragma unroll
            for (int e = 0; e < NE; ++e) lg[e] = 0.f;
#pragma unroll
            for (int j = 0; j < 4; ++j)
#pragma unroll
                for (int c = 0; c < 4; ++c) { const LAS f32x4* wp = (const LAS f32x4*)(WR + (size_t)(4 * F.lane + 256 * j + c) * NE); const f32x4 w0 = wp[0], w1 = wp[1]; const float xv = v[j][c];
                    lg[0] += xv * w0.x; lg[1] += xv * w0.y; lg[2] += xv * w0.z; lg[3] += xv * w0.w; lg[4] += xv * w1.x; lg[5] += xv * w1.y; lg[6] += xv * w1.z; lg[7] += xv * w1.w; }
#pragma unroll
            for (int e = 0; e < NE; ++e) lg[e] = wave_sum(lg[e]);
            int e0 = 0; float l0 = lg[0];
#pragma unroll
            for (int e = 1; e < NE; ++e) if (lg[e] > l0) { l0 = lg[e]; e0 = e; }
            int e1 = -1; float l1 = -3.0e38f;
#pragma unroll
            for (int e = 0; e < NE; ++e) if (e != e0 && lg[e] > l1) { l1 = lg[e]; e1 = e; }
            const float ex = __expf(l1 - l0), g0 = 1.f / (1.f + ex), g1 = ex * g0;
            if (F.lane == 0) { toke[2 * r] = e0; toke[2 * r + 1] = e1; tokg[2 * r] = g0; tokg[2 * r + 1] = g1; EB[2 * rl] = e0; EB[2 * rl + 1] = e1; }
        }
        __syncthreads();
        if (F.wave == 0) {
            const int lane = F.lane; const int ea = EB[lane], eb = EB[64 + lane];
            const u64 lt = (1ull << lane) - 1ull; int myc = 0, ra = 0, rbk = 0;
#pragma unroll
            for (int e = 0; e < NE; ++e) { const u64 ma = __ballot(ea == e), mb = __ballot(eb == e); const int pa = __builtin_popcountll(ma), c = pa + __builtin_popcountll(mb);
                if (lane == e) myc = c; if (ea == e) ra = __builtin_popcountll(ma & lt); if (eb == e) rbk = pa + __builtin_popcountll(mb & lt); }
            int basev = 0; if (lane < NE) basev = (int)__hip_atomic_fetch_add(cnt + 64 * lane, (unsigned)myc, __ATOMIC_RELAXED, __HIP_MEMORY_SCOPE_AGENT);
            int ba = 0, bb = 0;
#pragma unroll
            for (int e = 0; e < NE; ++e) { const int be = __shfl(basev, e); if (ea == e) ba = be; if (eb == e) bb = be; }
            slot[(size_t)(blk * 64) * 2 + lane] = ba + ra; slot[(size_t)(blk * 64) * 2 + 64 + lane] = bb + rbk;
        }
        __syncthreads();
    }
}
__device__ __forceinline__ int moe_segments(const unsigned* cnt, int (&cntv)[NE], int (&pstart)[NE], int (&pend)[NE]) {
    int acc = 0;
#pragma unroll
    for (int e = 0; e < NE; ++e) { cntv[e] = (int)__hip_atomic_load(cnt + 64 * e, __ATOMIC_RELAXED, __HIP_MEMORY_SCOPE_AGENT); pstart[e] = acc; acc += (cntv[e] + 255) & ~255; pend[e] = acc; }
    return acc;
}
__device__ __forceinline__ void moe_gather_phase(const Frame& F, const bf16* xb, bf16* xr, const unsigned* cnt) {
    int cntv[NE], pstart[NE], pend[NE]; moe_segments(cnt, cntv, pstart, pend);
    const int* toke = (const int*)(F.ws + S_TOKE); const float* tokg = (const float*)(F.ws + S_TOKG); const int* slot = (const int*)(F.ws + S_SLOT);
    int* rowtok = (int*)(F.ws + S_ROWTOK); float* rowgate = (float*)(F.ws + S_ROWGATE);
    const int gw = F.bid * NWAVES + F.wave, NGW = F.G * NWAVES;
    for (int a = gw; a < 2 * M; a += NGW) {
        const int e = toke[a]; int ps = 0;
#pragma unroll
        for (int j = 0; j < NE; ++j) ps = (e == j) ? pstart[j] : ps;
        const int dest = ps + slot[a]; const int t = a >> 1;
        const u32x4* src = (const u32x4*)(xb + (size_t)t * D); u32x4* dst = (u32x4*)(xr + (size_t)dest * D);
        dst[F.lane] = src[F.lane]; dst[F.lane + 64] = src[F.lane + 64];
        if (F.lane == 0) { rowtok[dest] = a; rowgate[dest] = tokg[a]; }
    }
    for (int i = gw; i < NE * 256; i += NGW) {
        const int e = i >> 8, j = i & 255; int ps = 0, cv = 0, pe = 0;
#pragma unroll
        for (int q = 0; q < NE; ++q) { ps = (e == q) ? pstart[q] : ps; cv = (e == q) ? cntv[q] : cv; pe = (e == q) ? pend[q] : pe; }
        const int r = ps + cv + j;
        if (r < pe) { u32x4* dst = (u32x4*)(xr + (size_t)r * D); const u32x4 z = (u32x4){0u, 0u, 0u, 0u}; dst[F.lane] = z; dst[F.lane + 64] = z; if (F.lane == 0) { rowtok[r] = -1; rowgate[r] = 0.f; } }
    }
}
__device__ __forceinline__ void ln_moe_phase(const Frame& F, const bf16* yk, float* outf, bf16* xb, const float* g, const float* b) {
    const int gw = F.bid * NWAVES + F.wave, NGW = F.G * NWAVES;
    for (int r = gw; r < M; r += NGW) {
        f32x4 v[4];
#pragma unroll
        for (int j = 0; j < 4; ++j) { const size_t o = (size_t)r * D + 4 * F.lane + 256 * j; const u32x2 x = *(const u32x2*)(xb + o);
            const u32x2 a = *(const u32x2*)(yk + o), c = *(const u32x2*)(yk + (size_t)M * D + o);
            v[j].x = bflo(x.x) * ALPHA + bflo(a.x) + bflo(c.x); v[j].y = bfhi(x.x) * ALPHA + bfhi(a.x) + bfhi(c.x); v[j].z = bflo(x.y) * ALPHA + bflo(a.y) + bflo(c.y); v[j].w = bfhi(x.y) * ALPHA + bfhi(a.y) + bfhi(c.y); }
        ln_row(v, g, b, F.lane);
        if (outf) store_row_f32(v, outf + (size_t)r * D, F.lane); else store_row_bf(v, xb + (size_t)r * D, F.lane);
    }
}
__device__ __forceinline__ void cvt_rows_phase(const Frame& F, const float* x, bf16* xb) {
    const int gw = F.bid * NWAVES + F.wave, NGW = F.G * NWAVES;
    for (int r = gw; r < M; r += NGW) {
#pragma unroll
        for (int j = 0; j < 4; ++j) { const size_t o = (size_t)r * D + 4 * F.lane + 256 * j; const f32x4 v = *(const f32x4*)(x + o);
            u32x2 w; w.x = cvt_pk_bf16(v.x, v.y); w.y = cvt_pk_bf16(v.z, v.w); *(u32x2*)(xb + o) = w; }
    }
}
__device__ __forceinline__ void gmlp_stats_phase(const Frame& F, const bf16* uv, float* stats) {
    const int gw = F.bid * NWAVES + F.wave, NGW = F.G * NWAVES;
    for (int r = gw; r < M; r += NGW) {
        const u32x4* p = (const u32x4*)(uv + (size_t)r * 4096 + 2048);
        float x[32]; float s = 0.f;
#pragma unroll
        for (int j = 0; j < 4; ++j) { const u32x4 w = p[F.lane + 64 * j];
            x[8 * j + 0] = bflo(w.x); x[8 * j + 1] = bfhi(w.x); x[8 * j + 2] = bflo(w.y); x[8 * j + 3] = bfhi(w.y); x[8 * j + 4] = bflo(w.z); x[8 * j + 5] = bfhi(w.z); x[8 * j + 6] = bflo(w.w); x[8 * j + 7] = bfhi(w.w); }
#pragma unroll
        for (int i = 0; i < 32; ++i) s += x[i];
        const float mean = wave_sum(s) * (1.f / 2048.f); float s2 = 0.f;
#pragma unroll
        for (int i = 0; i < 32; ++i) { const float d = x[i] - mean; s2 += d * d; }
        const float rstd = __builtin_amdgcn_rsqf(wave_sum(s2) * (1.f / 2048.f) + LN_EPS);
        if (F.lane == 0) { stats[2 * r] = mean; stats[2 * r + 1] = rstd; }
    }
}
constexpr int GM_WS = 136, GM_VS = 136;
__device__ __forceinline__ void gmlp_spatial_phase(const Frame& F, const bf16* uv, const float* stats, const float* ws_in  , const float* bs  ,
                                                   const float* lng, const float* lnb, bf16* gated) {
    LAS bf16* Ws = (LAS bf16*)F.lds;
    LAS bf16* Vt = (LAS bf16*)(F.lds + 128 * GM_WS * 2);
    const int tid = F.tid, lane = F.lane, w = F.wave, wr = w >> 2, wc = w & 3, fr = lane & 15, fq = lane >> 4;
    for (int u = F.bid; u < 1024; u += F.G) {
        const int bc = u >> 3, g = u & 7; const size_t rowbase = (size_t)bc * 128;
        { const int t = tid >> 2, c0 = (tid & 3) * 32; const float* wp = ws_in + ((size_t)g * 128 + t) * 128 + c0;
#pragma unroll
            for (int q = 0; q < 4; ++q) { const f32x4 a = *(const f32x4*)(wp + 8 * q), b = *(const f32x4*)(wp + 8 * q + 4); const int s0 = c0 + 8 * q;
                u32x4 o; o.x = cvt_pk_bf16(s0 + 0 <= t ? a.x : 0.f, s0 + 1 <= t ? a.y : 0.f); o.y = cvt_pk_bf16(s0 + 2 <= t ? a.z : 0.f, s0 + 3 <= t ? a.w : 0.f);
                o.z = cvt_pk_bf16(s0 + 4 <= t ? b.x : 0.f, s0 + 5 <= t ? b.y : 0.f); o.w = cvt_pk_bf16(s0 + 6 <= t ? b.z : 0.f, s0 + 7 <= t ? b.w : 0.f);
                *(LAS u32x4*)(Ws + t * GM_WS + s0) = o; } }
        { const int so = tid & 15, dq = tid >> 4; const int col = 256 * g + 8 * dq;
            const f32x4 g0 = *(const f32x4*)(lng + col), g1 = *(const f32x4*)(lng + col + 4), b0 = *(const f32x4*)(lnb + col), b1 = *(const f32x4*)(lnb + col + 4);
            float vv[8][8];
#pragma unroll
            for (int j = 0; j < 8; ++j) { const size_t r = rowbase + 8 * so + j; const u32x4 wv = *(const u32x4*)(uv + r * 4096 + 2048 + col); const float mean = stats[2 * r], rstd = stats[2 * r + 1];
                vv[j][0] = (bflo(wv.x) - mean) * rstd * g0.x + b0.x; vv[j][1] = (bfhi(wv.x) - mean) * rstd * g0.y + b0.y; vv[j][2] = (bflo(wv.y) - mean) * rstd * g0.z + b0.z; vv[j][3] = (bfhi(wv.y) - mean) * rstd * g0.w + b0.w;
                vv[j][4] = (bflo(wv.z) - mean) * rstd * g1.x + b1.x; vv[j][5] = (bfhi(wv.z) - mean) * rstd * g1.y + b1.y; vv[j][6] = (bflo(wv.w) - mean) * rstd * g1.z + b1.z; vv[j][7] = (bfhi(wv.w) - mean) * rstd * g1.w + b1.w; }
#pragma unroll
            for (int dd = 0; dd < 8; ++dd) { u32x4 o; o.x = cvt_pk_bf16(vv[0][dd], vv[1][dd]); o.y = cvt_pk_bf16(vv[2][dd], vv[3][dd]); o.z = cvt_pk_bf16(vv[4][dd], vv[5][dd]); o.w = cvt_pk_bf16(vv[6][dd], vv[7][dd]);
                *(LAS u32x4*)(Vt + (8 * dq + dd) * GM_VS + 8 * so) = o; } }
        __syncthreads();
        f32x4 acc[4][4];
#pragma unroll
        for (int a = 0; a < 4; ++a)
#pragma unroll
            for (int b = 0; b < 4; ++b) acc[a][b] = (f32x4){0.f, 0.f, 0.f, 0.f};
        const int nks = wr ? 4 : 2;
        for (int ks = 0; ks < nks; ++ks) {
            bf16x8 wf[4], vf[4];
#pragma unroll
            for (int mt = 0; mt < 4; ++mt) wf[mt] = *(const LAS bf16x8*)(Ws + (64 * wr + 16 * mt + fr) * GM_WS + 32 * ks + 8 * fq);
#pragma unroll
            for (int nt = 0; nt < 4; ++nt) vf[nt] = *(const LAS bf16x8*)(Vt + (64 * wc + 16 * nt + fr) * GM_VS + 32 * ks + 8 * fq);
#pragma unroll
            for (int mt = 0; mt < 4; ++mt)
#pragma unroll
                for (int nt = 0; nt < 4; ++nt) acc[mt][nt] = __builtin_amdgcn_mfma_f32_16x16x32_bf16(vf[nt], wf[mt], acc[mt][nt], 0, 0, 0);
        }
#pragma unroll
        for (int mt = 0; mt < 4; ++mt) { const int tl = 64 * wr + 16 * mt + fr; const float bias = bs[g * 128 + tl]; const size_t r = rowbase + tl;
#pragma unroll
            for (int nt = 0; nt < 4; ++nt) { const int col = 256 * g + 64 * wc + 16 * nt + 4 * fq; const u32x2 uu = *(const u32x2*)(uv + r * 4096 + col);
                const f32x4 sv = acc[mt][nt] + bias;
                u32x2 o; o.x = cvt_pk_bf16(bflo(uu.x) * sv.x, bfhi(uu.x) * sv.y); o.y = cvt_pk_bf16(bflo(uu.y) * sv.z, bfhi(uu.y) * sv.w);
                *(u32x2*)(gated + r * 2048 + col) = o; } }
        __syncthreads();
    }
}
constexpr int PB_LD = 3584, PB_QI = 3072, PB_KI = 3328, PB_WI = 3392;
__device__ __forceinline__ unsigned sortable(float s) { const unsigned b = __float_as_uint(s + 0.0f); return b ^ ((b >> 31) ? 0xffffffffu : 0x80000000u); }
template <int NJ>
__device__ __forceinline__ void dsa_select(const LAS unsigned* sc, int t, int lane, u64* mrow) {
    unsigned key[NJ];
#pragma unroll
    for (int j = 0; j < NJ; ++j) { const int s = 64 * j + lane; key[j] = (s <= t) ? sc[s] : 0u; }
    unsigned T = 0u; int need = 0;
    if (t >= 256) {
        for (int bit = 31; bit >= 0; --bit) {
            const unsigned cand = T | (1u << bit); int c = 0;
#pragma unroll
            for (int j = 0; j < NJ; ++j) c += __builtin_popcountll(__ballot(key[j] >= cand));
            if (c >= 256) T = cand;
        }
        int ngt = 0;
#pragma unroll
        for (int j = 0; j < NJ; ++j) ngt += __builtin_popcountll(__ballot(key[j] > T));
        need = 256 - ngt;
    }
    int running = 0;
#pragma unroll
    for (int j = 0; j < NJ; ++j) {
        const bool adm = (64 * j + lane) <= t;
        const bool gt = key[j] > T, eq = (key[j] == T);
        const u64 eqm = __ballot(eq && adm);
        const int rank = running + __builtin_popcountll(eqm & ((1ull << lane) - 1ull));
        const bool sel = adm && (gt || (t < 256) || (eq && rank < need));
        const u64 word = __ballot(sel);
        running += __builtin_popcountll(eqm);
        if (lane == 0) mrow[j] = word;
    }
    if (lane == 0) {
#pragma unroll
        for (int j = NJ; j < 32; ++j) mrow[j] = 0ull;
    }
}
__device__ __forceinline__ void dsa_topk_phase(const Frame& F, const bf16* proj, u64* mask) {
    LAS unsigned* SC = (LAS unsigned*)F.lds;
    const int lane = F.lane, w = F.wave, fr = lane & 15, fq = lane >> 4;
    for (int it = 0; it < 1024 / 256 + 1; ++it) {
        const int idx = it * F.G + F.bid; if (idx >= 1024) break;
        const int b = idx >> 7, tq0 = idx & 127; const int tq = ((idx >> 8) & 1) ? 127 - tq0 : tq0;
        const int t0 = 16 * tq; const size_t rb = (size_t)b * SEQ;
        bf16x8 qf[4][2]; float wq[4];
        { const bf16* qp = proj + (rb + t0 + fr) * PB_LD;
#pragma unroll
            for (int h = 0; h < 4; ++h) {
#pragma unroll
                for (int ks = 0; ks < 2; ++ks) qf[h][ks] = *(const bf16x8*)(qp + PB_QI + 64 * h + 32 * ks + 8 * fq);
                wq[h] = bf2f(qp[PB_WI + h]); } }
        for (int kt = w; kt <= tq; kt += NWAVES) {
            const bf16* kp = proj + (rb + 16 * kt + fr) * PB_LD + PB_KI + 8 * fq;
            const bf16x8 kf0 = *(const bf16x8*)kp, kf1 = *(const bf16x8*)(kp + 32);
            f32x4 sc = (f32x4){0.f, 0.f, 0.f, 0.f};
#pragma unroll
            for (int h = 0; h < 4; ++h) { f32x4 d = (f32x4){0.f, 0.f, 0.f, 0.f};
                d = __builtin_amdgcn_mfma_f32_16x16x32_bf16(kf0, qf[h][0], d, 0, 0, 0); d = __builtin_amdgcn_mfma_f32_16x16x32_bf16(kf1, qf[h][1], d, 0, 0, 0);
                sc.x += wq[h] * fmaxf(d.x, 0.f); sc.y += wq[h] * fmaxf(d.y, 0.f); sc.z += wq[h] * fmaxf(d.z, 0.f); sc.w += wq[h] * fmaxf(d.w, 0.f); }
            u32x4 o; o.x = sortable(sc.x); o.y = sortable(sc.y); o.z = sortable(sc.z); o.w = sortable(sc.w);
            *(LAS u32x4*)(SC + fr * 2048 + 16 * kt + 4 * fq) = o;
        }
        __syncthreads();
        for (int qq = 0; qq < 2; ++qq) {
            const int ql = 2 * w + qq, t = t0 + ql;
            u64* mrow = mask + (rb + t) * 32;
            const int nj8 = (t >> 9) + 1;
            if (nj8 == 1) dsa_select<8>(SC + ql * 2048, t, lane, mrow);
            else if (nj8 == 2) dsa_select<16>(SC + ql * 2048, t, lane, mrow);
            else if (nj8 == 3) dsa_select<24>(SC + ql * 2048, t, lane, mrow);
            else dsa_select<32>(SC + ql * 2048, t, lane, mrow);
        }
        __syncthreads();
    }
}
template <int DK> struct AttnCfg { static constexpr int KP = DK + 8, VP = 72, KBYTES = 64 * KP * 2, VBYTES = 64 * VP * 2, BUF = KBYTES + VBYTES; };
struct AttnArgs { const bf16* Q; int ldq, qoff;
                  const bf16* K1; int ldk1, k1off, k1hs;
                  const bf16* K2; int ldk2;
                  const bf16* V; int ldv, voff, vhs;
                  bf16* O;
                  const u64* mask;
                  const float* ang;
                  float scale_log2; };
__device__ __forceinline__ int crow(int r, int hi) { return (r & 3) + 8 * (r >> 2) + 4 * hi; }
template <int DK, bool MASKED>
__device__ __forceinline__ void attn_unit(const Frame& F, const AttnArgs& A, int b, int h, int qb) {
    typedef AttnCfg<DK> C;
    const int tid = F.tid, lane = F.lane, w = F.wave, r32 = lane & 31, hi = lane >> 5;
    const size_t rb = (size_t)b * SEQ; const int q0 = qb * 256, qrow = q0 + 32 * w + r32;
    const int NT = (q0 + 256) / 64;
    constexpr int NKS = DK / 16;
    bf16x8 qf[NKS];
    { const bf16* qp = A.Q + (rb + qrow) * A.ldq + A.qoff + h * DK + 8 * hi;
#pragma unroll
        for (int ks = 0; ks < NKS; ++ks) qf[ks] = *(const bf16x8*)(qp + 16 * ks); }
    if constexpr (DK == 96) {
        const float* ap = A.ang + (rb + qrow) * 32 + 16 * hi;
        const u32x4 w1 = __builtin_bit_cast(u32x4, qf[4]), w2 = __builtin_bit_cast(u32x4, qf[5]); u32x4 o1, o2;
#pragma unroll
        for (int e = 0; e < 4; ++e) { const f32x4 cs = *(const f32x4*)(ap + 4 * e);
            const float a0 = bflo(w1[e]), a1 = bfhi(w1[e]), b0 = bflo(w2[e]), b1 = bfhi(w2[e]);
            o1[e] = cvt_pk_bf16(a0 * cs.x - b0 * cs.y, a1 * cs.z - b1 * cs.w); o2[e] = cvt_pk_bf16(b0 * cs.x + a0 * cs.y, b1 * cs.z + a1 * cs.w); }
        qf[4] = __builtin_bit_cast(bf16x8, o1); qf[5] = __builtin_bit_cast(bf16x8, o2);
    }
    const int skey = tid >> 3, sch = tid & 7;
    const int skey2 = (tid + 512) / 12, sch2 = (tid + 512) % 12;
    const int skey1 = (DK == 96) ? tid / 12 : skey, sch1 = (DK == 96) ? tid % 12 : sch;
    u32x4 kreg0, kreg1 = (u32x4){0u, 0u, 0u, 0u}, vreg; u64 mw = 0ull;
#define ATT_LOAD_TILE(kt_) do { const size_t kr = rb + 64 * (kt_); \
        if (DK == 64) { kreg0 = *(const u32x4*)(A.K1 + (kr + skey) * A.ldk1 + A.k1off + h * A.k1hs + 8 * sch); } \
        else { \
            kreg0 = (sch1 < 8) ? *(const u32x4*)(A.K1 + (kr + skey1) * A.ldk1 + A.k1off + h * A.k1hs + 8 * sch1) : *(const u32x4*)(A.K2 + (kr + skey1) * A.ldk2 + 8 * (sch1 - 8)); \
            if (tid < 256) kreg1 = (sch2 < 8) ? *(const u32x4*)(A.K1 + (kr + skey2) * A.ldk1 + A.k1off + h * A.k1hs + 8 * sch2) : *(const u32x4*)(A.K2 + (kr + skey2) * A.ldk2 + 8 * (sch2 - 8)); \
        } \
        vreg = *(const u32x4*)(A.V + (kr + skey) * A.ldv + A.voff + h * A.vhs + 8 * sch); \
        if (MASKED) mw = A.mask[(rb + qrow) * 32 + (kt_)]; } while (0)
#define ATT_STORE_TILE(buf_) do { LAS unsigned char* base = F.lds + (buf_) * C::BUF; \
        *(LAS u32x4*)(base + (skey1 * C::KP + 8 * sch1) * 2) = kreg0; \
        if (DK == 96) { if (tid < 256) *(LAS u32x4*)(base + (skey2 * C::KP + 8 * sch2) * 2) = kreg1; } \
        *(LAS u32x4*)(base + C::KBYTES + (skey * C::VP + 8 * sch) * 2) = vreg; } while (0)
    float m_run = -1.0e30f, l_run = 0.f; f32x16 o0 = {}, o1 = {};
    ATT_LOAD_TILE(0); u64 mcur = mw; ATT_STORE_TILE(0); __syncthreads();
    const int wq_max = q0 + 32 * w + 31, wq_min = q0 + 32 * w;
    for (int kt = 0; kt < NT; ++kt) {
        if (kt + 1 < NT) ATT_LOAD_TILE(kt + 1);
        if (64 * kt <= wq_max) {
            const LAS unsigned char* kb = F.lds + (kt & 1) * C::BUF; const LAS unsigned char* vb = kb + C::KBYTES;
            f32x16 p0 = {}, p1 = {};
#pragma unroll
            for (int ks = 0; ks < NKS; ++ks) {
                const bf16x8 a0 = *(const LAS bf16x8*)(kb + (r32 * C::KP + 16 * ks + 8 * hi) * 2), a1 = *(const LAS bf16x8*)(kb + ((32 + r32) * C::KP + 16 * ks + 8 * hi) * 2);
                p0 = __builtin_amdgcn_mfma_f32_32x32x16_bf16(a0, qf[ks], p0, 0, 0, 0); p1 = __builtin_amdgcn_mfma_f32_32x32x16_bf16(a1, qf[ks], p1, 0, 0, 0);
            }
            const float NEG = -1.0e30f;
            if (MASKED) { const unsigned lo = (unsigned)mcur >> (4 * hi), hh = (unsigned)(mcur >> 32) >> (4 * hi);
#pragma unroll
                for (int r = 0; r < 16; ++r) { const int bitp = (r & 3) + 8 * (r >> 2); p0[r] = ((lo >> bitp) & 1u) ? p0[r] * A.scale_log2 : NEG; p1[r] = ((hh >> bitp) & 1u) ? p1[r] * A.scale_log2 : NEG; }
            } else if (64 * kt + 63 > wq_min) {
#pragma unroll
                for (int r = 0; r < 16; ++r) { const int kv = 64 * kt + crow(r, hi); p0[r] = (kv <= qrow) ? p0[r] * A.scale_log2 : NEG; p1[r] = (kv + 32 <= qrow) ? p1[r] * A.scale_log2 : NEG; }
            } else {
#pragma unroll
                for (int r = 0; r < 16; ++r) { p0[r] *= A.scale_log2; p1[r] *= A.scale_log2; }
            }
            float mx = p0[0];
#pragma unroll
            for (int r = 1; r < 16; ++r) mx = fmaxf(mx, p0[r]);
#pragma unroll
            for (int r = 0; r < 16; ++r) mx = fmaxf(mx, p1[r]);
            { auto rr = __builtin_amdgcn_permlane32_swap(__float_as_uint(mx), __float_as_uint(mx), false, false); mx = fmaxf(__uint_as_float(rr[0]), __uint_as_float(rr[1])); }
            const float m_new = fmaxf(m_run, mx), alpha = fast_exp2(m_run - m_new); m_run = m_new;
            float ps = 0.f;
#pragma unroll
            for (int r = 0; r < 16; ++r) { p0[r] = fast_exp2(p0[r] - m_new); p1[r] = fast_exp2(p1[r] - m_new); ps += p0[r] + p1[r]; }
            l_run = l_run * alpha + ps;
#pragma unroll
            for (int r = 0; r < 16; ++r) { o0[r] *= alpha; o1[r] *= alpha; }
            bf16x8 pk[4];
#pragma unroll
            for (int s = 0; s < 2; ++s) {
                u32x4 a; a.x = cvt_pk_bf16(p0[8 * s + 0], p0[8 * s + 1]); a.y = cvt_pk_bf16(p0[8 * s + 2], p0[8 * s + 3]); a.z = cvt_pk_bf16(p0[8 * s + 4], p0[8 * s + 5]); a.w = cvt_pk_bf16(p0[8 * s + 6], p0[8 * s + 7]);
                u32x4 c; c.x = cvt_pk_bf16(p1[8 * s + 0], p1[8 * s + 1]); c.y = cvt_pk_bf16(p1[8 * s + 2], p1[8 * s + 3]); c.z = cvt_pk_bf16(p1[8 * s + 4], p1[8 * s + 5]); c.w = cvt_pk_bf16(p1[8 * s + 6], p1[8 * s + 7]);
                pk[s] = __builtin_bit_cast(bf16x8, a); pk[2 + s] = __builtin_bit_cast(bf16x8, c); }
            const int gi = (lane >> 4) & 1, q4 = (lane & 15) >> 2, p4 = lane & 3;
            const LAS unsigned char* vlane = vb + ((4 * hi + q4) * C::VP + 16 * gi + 4 * p4) * 2;
#pragma unroll
            for (int s4 = 0; s4 < 4; ++s4) {
#pragma unroll
                for (int db = 0; db < 2; ++db) {
                    const s16x4 lo4 = __builtin_bit_cast(s16x4, __builtin_amdgcn_ds_read_tr16_b64_v4i16((LAS s16x4*)(vlane + ((16 * s4) * C::VP + 32 * db) * 2)));
                    const s16x4 hi4 = __builtin_bit_cast(s16x4, __builtin_amdgcn_ds_read_tr16_b64_v4i16((LAS s16x4*)(vlane + ((16 * s4 + 8) * C::VP + 32 * db) * 2)));
                    const bf16x8 vf = (bf16x8){lo4[0], lo4[1], lo4[2], lo4[3], hi4[0], hi4[1], hi4[2], hi4[3]};
                    if (db == 0) o0 = __builtin_amdgcn_mfma_f32_32x32x16_bf16(vf, pk[s4], o0, 0, 0, 0); else o1 = __builtin_amdgcn_mfma_f32_32x32x16_bf16(vf, pk[s4], o1, 0, 0, 0);
                }
            }
        }
        if (kt + 1 < NT) { ATT_STORE_TILE((kt + 1) & 1); mcur = mw; }
        __syncthreads();
    }
    { auto rr = __builtin_amdgcn_permlane32_swap(__float_as_uint(l_run), __float_as_uint(l_run), false, false); l_run = __uint_as_float(rr[0]) + __uint_as_float(rr[1]); }
    const float inv = 1.0f / l_run;
    bf16* op = A.O + (rb + qrow) * D + h * 64 + 4 * hi;
#pragma unroll
    for (int g4 = 0; g4 < 4; ++g4) {
        u32x2 a; a.x = cvt_pk_bf16(o0[4 * g4 + 0] * inv, o0[4 * g4 + 1] * inv); a.y = cvt_pk_bf16(o0[4 * g4 + 2] * inv, o0[4 * g4 + 3] * inv);
        u32x2 c; c.x = cvt_pk_bf16(o1[4 * g4 + 0] * inv, o1[4 * g4 + 1] * inv); c.y = cvt_pk_bf16(o1[4 * g4 + 2] * inv, o1[4 * g4 + 3] * inv);
        *(u32x2*)(op + 8 * g4) = a; *(u32x2*)(op + 32 + 8 * g4) = c;
    }
}
#undef ATT_LOAD_TILE
#undef ATT_STORE_TILE
template <int DK, bool MASKED>
__device__ __forceinline__ void attn_phase(const Frame& F, const AttnArgs& A) {
    for (int i = 0; i < 4; ++i) {
        const int u = i * F.G + F.bid; if (u >= 1024) break;
        const int bh = u >> 3, qp = u & 7, qb = ((u >> 8) & 1) ? 7 - qp : qp;
        attn_unit<DK, MASKED>(F, A, bh >> 4, bh & 15, qb);
    }
}
constexpr int HG_QS = 136, HG_HS = 72, HG_VS = 72, HG_SS = 136;
constexpr int HG_QT = 0, HG_KT = HG_QT + 64 * HG_QS * 2, HG_KH = HG_KT + 64 * HG_QS * 2, HG_VT = HG_KH + 128 * HG_HS * 2, HG_SB = HG_VT + 32 * HG_VS * 2,
              HG_GL = HG_SB + 2 * 32 * HG_SS * 2, HG_SEG = HG_GL + 512, HG_END = HG_SEG + 4 * 128 * 4;
static_assert(HG_END <= RING_BYTES, "hgrn2 LDS");
__device__ __forceinline__ void hgrn2_scan_phase(const Frame& F, const bf16* proj, const float* lb_logits  , float* opre  ) {
    LAS bf16* Qt = (LAS bf16*)(F.lds + HG_QT); LAS bf16* Kt = (LAS bf16*)(F.lds + HG_KT); LAS bf16* Kh = (LAS bf16*)(F.lds + HG_KH); LAS bf16* Vt = (LAS bf16*)(F.lds + HG_VT);
    LAS bf16* Sb = (LAS bf16*)(F.lds + HG_SB); LAS float* GL = (LAS float*)(F.lds + HG_GL); LAS float* SEG = (LAS float*)(F.lds + HG_SEG);
    const int tid = F.tid, lane = F.lane, w = F.wave, fr = lane & 15, fq = lane >> 4;
    for (int u = F.bid; u < 256; u += F.G) {
        const int b = u >> 5, h = (u >> 2) & 7, vq = u & 3;
        const size_t rb = (size_t)b * SEQ;
        const int k = tid & 127, tseg = tid >> 7;
        float lbv; { const int c = 128 * h + k; const float a0 = lb_logits[c], a1 = lb_logits[1024 + c], a2 = lb_logits[2048 + c], a3 = lb_logits[3072 + c];
            const float mx = fmaxf(fmaxf(a0, a1), fmaxf(a2, a3)); const float e0 = __expf(a0 - mx), e1 = __expf(a1 - mx), e2 = __expf(a2 - mx), e3 = __expf(a3 - mx);
            lbv = (e1 + e2) / (e0 + e1 + e2 + e3); }
        f32x4 sacc[2]; sacc[0] = (f32x4){0.f, 0.f, 0.f, 0.f}; sacc[1] = sacc[0];
        for (int i = tid; i < 2 * 32 * HG_SS / 2; i += NTHREADS) ((LAS unsigned*)Sb)[i] = 0u;
        const int vt = w & 1, tt = w >> 1;
        unsigned short rq[16], rf[16], rv[8];
#define HG_FETCH(cc) do { const size_t r0_ = rb + 64 * (cc); const bf16* pp_ = proj + (r0_ + 16 * tseg) * 4096 + 128 * h + k; \
            _Pragma("unroll") for (int j = 0; j < 16; ++j) { rq[j] = pp_[(size_t)j * 4096]; rf[j] = pp_[(size_t)j * 4096 + 1024]; } \
            if (tid < 256) { const bf16* vp_ = proj + (r0_ + 8 * (tid & 7)) * 4096 + 2048 + 128 * h + 32 * vq + (tid >> 3); \
                _Pragma("unroll") for (int j = 0; j < 8; ++j) rv[j] = vp_[(size_t)j * 4096]; } } while (0)
        HG_FETCH(0);
        for (int c = 0; c < 32; ++c) {
            const size_t r0 = rb + 64 * c;
            float gl[16], kk[16], qv[16];
            { float run = 0.f;
#pragma unroll
                for (int j = 0; j < 16; ++j) { const float fp = bf2f(rf[j]); qv[j] = bf2f(rq[j]);
                    const float sg = sigmoidf_(fp); const float f = lbv + (1.f - lbv) * sg; kk[j] = (1.f - lbv) * (1.f - sg); run += __logf(f); gl[j] = run; }
                SEG[tseg * 128 + k] = run; }
            if (tid < 256) { const int so = tid & 7, v = tid >> 3;
                u32x4 o; o.x = (unsigned)rv[0] | ((unsigned)rv[1] << 16); o.y = (unsigned)rv[2] | ((unsigned)rv[3] << 16);
                o.z = (unsigned)rv[4] | ((unsigned)rv[5] << 16); o.w = (unsigned)rv[6] | ((unsigned)rv[7] << 16);
                *(LAS u32x4*)(Vt + v * HG_VS + 8 * so) = o; }
            if (c + 1 < 32) HG_FETCH(c + 1);
            LDS_BARRIER();
            { float off = 0.f, tot = 0.f;
#pragma unroll
                for (int s = 0; s < 4; ++s) { const float sv = SEG[s * 128 + k]; off += (s < tseg) ? sv : 0.f; tot += sv; }
                if (tseg == 0) GL[k] = tot;
                unsigned kh[8];
#pragma unroll
                for (int j = 0; j < 16; ++j) { const float G = off + gl[j]; const float eg = __expf(G);
                    const float qs = qv[j] * eg, ks = kk[j] * __expf(-G), khv = kk[j] * __expf(tot - G);
                    Qt[(16 * tseg + j) * HG_QS + k] = (bf16)(cvt_pk_bf16(qs, 0.f) & 0xffffu); Kt[(16 * tseg + j) * HG_QS + k] = (bf16)(cvt_pk_bf16(ks, 0.f) & 0xffffu);
                    if (j & 1) kh[j >> 1] = (kh[j >> 1] & 0xffffu) | (cvt_pk_bf16(0.f, khv) & 0xffff0000u); else kh[j >> 1] = cvt_pk_bf16(khv, 0.f) & 0xffffu; }
                *(LAS u32x4*)(Kh + k * HG_HS + 16 * tseg) = (u32x4){kh[0], kh[1], kh[2], kh[3]}; *(LAS u32x4*)(Kh + k * HG_HS + 16 * tseg + 8) = (u32x4){kh[4], kh[5], kh[6], kh[7]}; }
            LDS_BARRIER();
            const LAS bf16* Sbc = Sb + (c & 1) * 32 * HG_SS; LAS bf16* Sbn = Sb + ((c + 1) & 1) * 32 * HG_SS;
            bf16x8 bq[4];
#pragma unroll
            for (int ks = 0; ks < 4; ++ks) bq[ks] = *(const LAS bf16x8*)(Qt + (16 * tt + fr) * HG_QS + 32 * ks + 8 * fq);
            f32x4 sc[4];
#pragma unroll
            for (int st = 0; st < 4; ++st) { sc[st] = (f32x4){0.f, 0.f, 0.f, 0.f};
                if (st <= tt) {
#pragma unroll
                    for (int ks = 0; ks < 4; ++ks) { const bf16x8 ka = *(const LAS bf16x8*)(Kt + (16 * st + fr) * HG_QS + 32 * ks + 8 * fq); sc[st] = __builtin_amdgcn_mfma_f32_16x16x32_bf16(ka, bq[ks], sc[st], 0, 0, 0); }
                    if (st == tt) {
#pragma unroll
                        for (int i = 0; i < 4; ++i) if (4 * fq + i > fr) sc[st][i] = 0.f; } } }
            f32x4 oacc = (f32x4){0.f, 0.f, 0.f, 0.f};
#pragma unroll
            for (int m = 0; m < 2; ++m) {
                u32x4 pw; pw.x = cvt_pk_bf16(sc[2 * m][0], sc[2 * m][1]); pw.y = cvt_pk_bf16(sc[2 * m][2], sc[2 * m][3]); pw.z = cvt_pk_bf16(sc[2 * m + 1][0], sc[2 * m + 1][1]); pw.w = cvt_pk_bf16(sc[2 * m + 1][2], sc[2 * m + 1][3]);
                const LAS bf16* vp = Vt + (16 * vt + fr) * HG_VS + 32 * m + 4 * fq;
                const u32x2 va = *(const LAS u32x2*)vp, vb = *(const LAS u32x2*)(vp + 16);
                const bf16x8 vf = __builtin_bit_cast(bf16x8, (u32x4){va.x, va.y, vb.x, vb.y});
                oacc = __builtin_amdgcn_mfma_f32_16x16x32_bf16(vf, __builtin_bit_cast(bf16x8, pw), oacc, 0, 0, 0);
            }
#pragma unroll
            for (int ks = 0; ks < 4; ++ks) { const bf16x8 sa = *(const LAS bf16x8*)(Sbc + (16 * vt + fr) * HG_SS + 32 * ks + 8 * fq); oacc = __builtin_amdgcn_mfma_f32_16x16x32_bf16(sa, bq[ks], oacc, 0, 0, 0); }
            *(f32x4*)(opre + (r0 + 16 * tt + fr) * D + 128 * h + 32 * vq + 16 * vt + 4 * fq) = oacc;
#pragma unroll
            for (int x = 0; x < 2; ++x) { const int kt = tt + 4 * x;
                const f32x4 dec = *(const LAS f32x4*)(GL + 16 * kt + 4 * fq);
                f32x4 a = sacc[x]; a.x *= __expf(dec.x); a.y *= __expf(dec.y); a.z *= __expf(dec.z); a.w *= __expf(dec.w);
#pragma unroll
                for (int m = 0; m < 2; ++m) { const bf16x8 ka = *(const LAS bf16x8*)(Kh + (16 * kt + fr) * HG_HS + 32 * m + 8 * fq), vbf = *(const LAS bf16x8*)(Vt + (16 * vt + fr) * HG_VS + 32 * m + 8 * fq);
                    a = __builtin_amdgcn_mfma_f32_16x16x32_bf16(ka, vbf, a, 0, 0, 0); }
                sacc[x] = a;
                u32x2 o; o.x = cvt_pk_bf16(a.x, a.y); o.y = cvt_pk_bf16(a.z, a.w);
                *(LAS u32x2*)(Sbn + (16 * vt + fr) * HG_SS + 16 * kt + 4 * fq) = o; }
            LDS_BARRIER();
        }
#undef HG_FETCH
    }
}
__device__ __forceinline__ void hgrn2_norm_phase(const Frame& F, const float* opre, const bf16* proj, const float* ng, bf16* ob) {
    const int gw = F.bid * NWAVES + F.wave, NGW = F.G * NWAVES, lane = F.lane;
    for (int r = gw; r < M; r += NGW) {
#pragma unroll
        for (int j = 0; j < 4; ++j) { const int col = 4 * lane + 256 * j; const f32x4 v = *(const f32x4*)(opre + (size_t)r * D + col);
            float ss = (v.x * v.x + v.y * v.y) + (v.z * v.z + v.w * v.w);
#pragma unroll
            for (int o = 1; o < 32; o <<= 1) ss += __shfl_xor(ss, o);
            const float rs = __builtin_amdgcn_rsqf(ss * (1.f / 128.f) + RMS_EPS);
            const f32x4 g4 = *(const f32x4*)(ng + (col & 127)); const u32x2 gt = *(const u32x2*)(proj + (size_t)r * 4096 + 3072 + col);
            u32x2 o; o.x = cvt_pk_bf16(v.x * rs * g4.x * siluf_(bflo(gt.x)), v.y * rs * g4.y * siluf_(bfhi(gt.x))); o.y = cvt_pk_bf16(v.z * rs * g4.z * siluf_(bflo(gt.y)), v.w * rs * g4.w * siluf_(bfhi(gt.y)));
            *(u32x2*)(ob + (size_t)r * D + col) = o; }
    }
}
__device__ __forceinline__ void mla_norm_phase(const Frame& F, const float* projd, const int* positions, const float* qg, const float* kvg, bf16* cq, bf16* ckv, bf16* kr, float* ang) {
    const int gw = F.bid * NWAVES + F.wave, NGW = F.G * NWAVES, lane = F.lane;
    for (int r = gw; r < M; r += NGW) {
        const f32x4 a = *(const f32x4*)(projd + (size_t)r * 512 + 8 * lane), c = *(const f32x4*)(projd + (size_t)r * 512 + 8 * lane + 4);
        float x[8] = {a.x, a.y, a.z, a.w, c.x, c.y, c.z, c.w};
        float ss = 0.f;
#pragma unroll
        for (int i = 0; i < 8; ++i) ss += x[i] * x[i];
        float s16 = ss;
#pragma unroll
        for (int o = 1; o < 16; o <<= 1) s16 += __shfl_xor(s16, o);
        const float s32 = s16 + __shfl_xor(s16, 16);
        float px[8];
#pragma unroll
        for (int i = 0; i < 8; ++i) px[i] = __shfl_xor(x[i], 2);
        if (lane < 32) {
            const float rs = __builtin_amdgcn_rsqf(s32 * (1.f / 256.f) + RMS_EPS);
            const f32x4 g0 = *(const f32x4*)(qg + 8 * lane), g1 = *(const f32x4*)(qg + 8 * lane + 4);
            u32x4 o; o.x = cvt_pk_bf16(x[0] * rs * g0.x, x[1] * rs * g0.y); o.y = cvt_pk_bf16(x[2] * rs * g0.z, x[3] * rs * g0.w); o.z = cvt_pk_bf16(x[4] * rs * g1.x, x[5] * rs * g1.y); o.w = cvt_pk_bf16(x[6] * rs * g1.z, x[7] * rs * g1.w);
            *(u32x4*)(cq + (size_t)r * 256 + 8 * lane) = o;
        } else if (lane < 48) {
            const int l2 = lane - 32; const float rs = __builtin_amdgcn_rsqf(s16 * (1.f / 128.f) + RMS_EPS);
            const f32x4 g0 = *(const f32x4*)(kvg + 8 * l2), g1 = *(const f32x4*)(kvg + 8 * l2 + 4);
            u32x4 o; o.x = cvt_pk_bf16(x[0] * rs * g0.x, x[1] * rs * g0.y); o.y = cvt_pk_bf16(x[2] * rs * g0.z, x[3] * rs * g0.w); o.z = cvt_pk_bf16(x[4] * rs * g1.x, x[5] * rs * g1.y); o.w = cvt_pk_bf16(x[6] * rs * g1.z, x[7] * rs * g1.w);
            *(u32x4*)(ckv + (size_t)r * 256 + 8 * l2) = o;
        } else {
            *(u32x4*)(ckv + (size_t)r * 256 + 128 + 8 * (lane - 48)) = (u32x4){0u, 0u, 0u, 0u};
            if (lane < 52) {
                const int l3 = lane - 48, i0 = 8 * (l3 & 1); const bool second = l3 >= 2; const float pos = (float)positions[r];
                float outv[8];
#pragma unroll
                for (int i = 0; i < 8; ++i) { const float invf = fast_exp2(-(float)(i0 + i) * (13.287712379549449f / 16.f)); const float an = pos * invf; float rev = an * 0.15915494309189535f; rev = rev - floorf(rev); const float cs = __builtin_amdgcn_cosf(rev), sn = __builtin_amdgcn_sinf(rev);
                    outv[i] = second ? (x[i] * cs + px[i] * sn) : (x[i] * cs - px[i] * sn);
                    if (!second) { ang[(size_t)r * 32 + 2 * (i0 + i)] = cs; ang[(size_t)r * 32 + 2 * (i0 + i) + 1] = sn; } }
                u32x4 o; o.x = cvt_pk_bf16(outv[0], outv[1]); o.y = cvt_pk_bf16(outv[2], outv[3]); o.z = cvt_pk_bf16(outv[4], outv[5]); o.w = cvt_pk_bf16(outv[6], outv[7]);
                *(u32x4*)(kr + (size_t)r * 32 + 8 * l3) = o;
            }
        }
    }
}
__device__ __forceinline__ void mla_qrope_phase(const Frame& F, bf16* q, const float* ang) {
    const int gw = F.bid * NWAVES + F.wave, NGW = F.G * NWAVES, lane = F.lane;
    const int hh = lane >> 2, part = lane & 3, i0 = 8 * (part & 1); const bool second = part >= 2;
    for (int r = gw; r < M; r += NGW) {
        bf16* p = q + (size_t)r * 1536 + 96 * hh + 64 + 8 * part;
        const u32x4 wv = *(const u32x4*)p;
        float x[8] = {bflo(wv.x), bfhi(wv.x), bflo(wv.y), bfhi(wv.y), bflo(wv.z), bfhi(wv.z), bflo(wv.w), bfhi(wv.w)};
        float outv[8];
#pragma unroll
        for (int i = 0; i < 8; ++i) { const float px = __shfl_xor(x[i], 2); const f32x2 cssn = *(const f32x2*)(ang + (size_t)r * 32 + 2 * (i0 + i));
            outv[i] = second ? (x[i] * cssn.x + px * cssn.y) : (x[i] * cssn.x - px * cssn.y); }
        u32x4 o; o.x = cvt_pk_bf16(outv[0], outv[1]); o.y = cvt_pk_bf16(outv[2], outv[3]); o.z = cvt_pk_bf16(outv[4], outv[5]); o.w = cvt_pk_bf16(outv[6], outv[7]);
        *(u32x4*)p = o;
    }
}
constexpr int NPHASE = 36;
#ifndef MK_ONE_LAUNCH
#define MK_ONE_LAUNCH 1
#endif
#ifndef MK_DUP
#define MK_DUP 0ull
#endif
#ifndef MK_NRUN
#define MK_NRUN NPHASE
#endif
__device__ __forceinline__ void prologue_phase(const Frame& F, const Args& args, unsigned char* ws, bf16* XB) {
#define INP(i) ((const float*)args.in[i])

        convert_matrix(F, INP(I_A_WIN), 1024, 4096, (bf16*)(ws + W_A_IN), 1024, 4096, 0, 1);
        convert_matrix(F, INP(I_A_WOUT), 2048, 1024, (bf16*)(ws + W_A_OUT), 2048, 1024, 0, 1);
        convert_matrix(F, INP(I_B_WIN), 1024, 3396, (bf16*)(ws + W_B_IN), 1024, 3584, 0, 1);
        convert_matrix(F, INP(I_B_WOUT), 1024, 1024, (bf16*)(ws + W_B_OUT), 1024, 1024, 0, 1);
        convert_matrix(F, INP(I_C_WIN), 1024, 4096, (bf16*)(ws + W_C_IN), 1024, 4096, 0, 1);
        convert_matrix(F, INP(I_C_WOUT), 1024, 1024, (bf16*)(ws + W_C_OUT), 1024, 1024, 0, 1);
        convert_matrix(F, INP(I_D_WIN), 1024, 416, (bf16*)(ws + W_D_IN), 1024, 512, 0, 1);
        convert_matrix(F, INP(I_D_WUQ), 256, 1536, (bf16*)(ws + W_D_UQ), 256, 1536, 0, 1);
        convert_matrix(F, INP(I_D_WUKV), 128, 2048, (bf16*)(ws + W_D_UKV), 256, 2048, 0, 1);
        convert_matrix(F, INP(I_D_WOUT), 1024, 1024, (bf16*)(ws + W_D_OUT), 1024, 1024, 0, 1);
        convert_matrix(F, INP(I_F0_GU), 1024, 2 * FF, (bf16*)(ws + W_F0_GU), 1024, 2 * FF, 1, 1);
        convert_matrix(F, INP(I_F0_DN), FF, 1024, (bf16*)(ws + W_F0_DN), FF, 1024, 0, 1);
        convert_matrix(F, INP(I_F2_GU), 1024, 2 * FF, (bf16*)(ws + W_F2_GU), 1024, 2 * FF, 1, 1);
        convert_matrix(F, INP(I_F2_DN), FF, 1024, (bf16*)(ws + W_F2_DN), FF, 1024, 0, 1);
        convert_matrix(F, INP(I_M1_GU), 1024, 2 * FF, (bf16*)(ws + W_M1_GU), 1024, 2 * FF, 1, NE);
        convert_matrix(F, INP(I_M1_DN), FF, 1024, (bf16*)(ws + W_M1_DN), FF, 1024, 0, NE);
        convert_matrix(F, INP(I_M3_GU), 1024, 2 * FF, (bf16*)(ws + W_M3_GU), 1024, 2 * FF, 1, NE);
        convert_matrix(F, INP(I_M3_DN), FF, 1024, (bf16*)(ws + W_M3_DN), FF, 1024, 0, NE);
        cvt_rows_phase(F, INP(I_X), XB);
    #undef INP
}
__global__ void __launch_bounds__(NTHREADS, 2) fwd_kernel(Args args) {
    extern __shared__ __attribute__((aligned(16))) unsigned char lds_raw[];
    Frame F;
    F.lds = (LAS unsigned char*)lds_raw;
    F.tid = threadIdx.x; F.lane = F.tid & 63; F.wave = __builtin_amdgcn_readfirstlane(F.tid >> 6);
    F.G = gridDim.x; F.bid = blockIdx.x;
    F.ws = args.ws; F.ctl = (unsigned*)(args.ws + WS_CTL);
    unsigned char* ws = args.ws;
    const int lo = args.ph_lo, hi = args.ph_hi;
    for (int u = F.tid; u < (LDS_BYTES - LDSCTL_OFF) / 4; u += NTHREADS) ((LAS unsigned*)(F.lds + LDSCTL_OFF))[u] = 0u;
    __syncthreads();
    XcdBarrier bar; bar.bar = F.ctl + CW_BAR; bar.x = 0; bar.st = nullptr;
    const bool multi = (hi - lo) > 1;
    if (multi) bar = xcd_barrier_post(F.ctl + CW_BAR, (volatile LAS unsigned*)(F.lds + LDSCTL_OFF + 64));
#define IN(k) (lo <= (k) && (k) < hi)
#define SEAM(k) do { if (IN(k) && IN((k) + 1)) xcd_barrier(bar); } while (0)
#define DUPP(k) (((unsigned long long)(MK_DUP) >> (k)) & 1ull)
#define PHASE(k, ...) do { if (IN(k)) { __VA_ARGS__; if (DUPP(k)) { xcd_barrier(bar); __VA_ARGS__; } } SEAM(k); } while (0)
#define INP(i) ((const float*)args.in[i])
    float* XF = args.out;
    bf16* XB = (bf16*)(ws + WS_XB);
    bf16* H = (bf16*)(ws + B_H);
    bf16* OB = (bf16*)(ws + B_OB);
    bf16* XR = (bf16*)(ws + WS_R2); bf16* YK = (bf16*)(ws + WS_R2);
    LAS unsigned char* ring = F.lds;

#define GEMM(EpiT, Aptr, lda_, Bptr, Nn, Kk, epi) do { pg8::Gemm g_{(Aptr), (Bptr), M, (Nn), (Kk), (lda_), 0}; pg8::StaticOrder S_; S_.init(M, (Nn), F.G, F.bid); \
        pg8::gemm_phase<EpiT, pg8::StaticOrder>(ring, g_, S_, (epi)); } while (0)
#define FFN_DENSE(p0, WGU, WDN, lg, lb) do { \
        PHASE(p0, GEMM(pg8::EpiSwiGLU, XB, D, (const bf16*)(ws + (WGU)), 2 * FF, D, (pg8::EpiSwiGLU{H, FF}));); \
        PHASE((p0) + 1, GEMM(pg8::EpiResid, H, FF, (const bf16*)(ws + (WDN)), D, FF, (pg8::EpiResid{XB, XF, ALPHA}));); \
        PHASE((p0) + 2, ln_phase(F, XF, XB, (lg), (lb));); } while (0)
#define FFN_MOE(p0, slot_, WR, WGU, WDN, lmg, lmb, lfg, lfb, OUTF) do { \
        unsigned* cnt_ = F.ctl + CW_CNT + (slot_) * 512; \
        PHASE(p0, ln_route_phase(F, XF, XB, (lmg), (lmb), (WR), cnt_);); \
        PHASE((p0) + 1, moe_gather_phase(F, XB, XR, cnt_);); \
        PHASE((p0) + 2, int cv_[NE], ps_[NE]; pg8::MoeOrder S_; const int rows_ = moe_segments(cnt_, cv_, ps_, S_.pend); S_.so.init(rows_, 2 * FF, F.G, F.bid); \
            pg8::Gemm g_{XR, (const bf16*)(ws + (WGU)), rows_, 2 * FF, D, D, (size_t)2 * FF * D}; pg8::gemm_phase<pg8::EpiSwiGLU, pg8::MoeOrder>(ring, g_, S_, pg8::EpiSwiGLU{H, FF});); \
        PHASE((p0) + 3, int cv_[NE], ps_[NE]; pg8::MoeOrder S_; const int rows_ = moe_segments(cnt_, cv_, ps_, S_.pend); S_.so.init(rows_, D, F.G, F.bid); \
            pg8::Gemm g_{H, (const bf16*)(ws + (WDN)), rows_, D, FF, FF, (size_t)D * FF}; \
            pg8::gemm_phase<pg8::EpiMoeDown, pg8::MoeOrder>(ring, g_, S_, pg8::EpiMoeDown{YK, (const int*)(ws + S_ROWTOK), (const float*)(ws + S_ROWGATE)});); \
        PHASE((p0) + 4, ln_moe_phase(F, YK, (OUTF), XB, (lfg), (lfb));); } while (0)

    PHASE(0, prologue_phase(F, args, ws, XB););
    { bf16* UV = (bf16*)(ws + B_UV); bf16* GATED = (bf16*)(ws + B_GATED); float* STATS = (float*)(ws + S_STATS);
      PHASE(1, GEMM(pg8::EpiBf16<1>, XB, D, (const bf16*)(ws + W_A_IN), 4096, D, (pg8::EpiBf16<1>{UV, 4096})););
      PHASE(2, gmlp_stats_phase(F, UV, STATS););
      PHASE(3, gmlp_spatial_phase(F, UV, STATS, INP(I_A_WS), INP(I_A_BS), INP(I_A_LNG), INP(I_A_LNB), GATED););
      PHASE(4, GEMM(pg8::EpiResid, GATED, 2048, (const bf16*)(ws + W_A_OUT), D, 2048, (pg8::EpiResid{XB, XF, ALPHA})););
      PHASE(5, ln_phase(F, XF, XB, INP(I_LNM_G), INP(I_LNM_B));); }
    FFN_DENSE(6, W_F0_GU, W_F0_DN, INP(I_LNF_G), INP(I_LNF_B));
    { bf16* PROJ = (bf16*)(ws + B_PROJB); u64* MASK = (u64*)(ws + S_MASK);
      PHASE(9, GEMM(pg8::EpiBf16<0>, XB, D, (const bf16*)(ws + W_B_IN), 3584, D, (pg8::EpiBf16<0>{PROJ, 3584})););
      PHASE(10, dsa_topk_phase(F, PROJ, MASK););
      PHASE(11, AttnArgs A; A.Q = PROJ; A.ldq = PB_LD; A.qoff = 0; A.K1 = PROJ; A.ldk1 = PB_LD; A.k1off = 1024; A.k1hs = 64; A.K2 = nullptr; A.ldk2 = 0; A.V = PROJ; A.ldv = PB_LD; A.voff = 2048; A.vhs = 64;
          A.O = OB; A.mask = MASK; A.ang = nullptr; A.scale_log2 = 0.125f * 1.4426950408889634f; attn_phase<64, true>(F, A););
      PHASE(12, GEMM(pg8::EpiResid, OB, D, (const bf16*)(ws + W_B_OUT), D, D, (pg8::EpiResid{XB, XF, ALPHA}));); }
    FFN_MOE(13, 0, INP(I_M1_R), W_M1_GU, W_M1_DN, INP(I_LNM_G) + D, INP(I_LNM_B) + D, INP(I_LNF_G) + D, INP(I_LNF_B) + D, (float*)nullptr);
    { bf16* PROJ = (bf16*)(ws + B_PROJC); float* OPRE = (float*)(ws + B_OPRE);
      PHASE(18, GEMM(pg8::EpiBf16<0>, XB, D, (const bf16*)(ws + W_C_IN), 4096, D, (pg8::EpiBf16<0>{PROJ, 4096})););
      PHASE(19, hgrn2_scan_phase(F, PROJ, INP(I_C_LB), OPRE););
      PHASE(20, hgrn2_norm_phase(F, OPRE, PROJ, INP(I_C_NG), OB););
      PHASE(21, GEMM(pg8::EpiResid, OB, D, (const bf16*)(ws + W_C_OUT), D, D, (pg8::EpiResid{XB, XF, ALPHA})););
      PHASE(22, ln_phase(F, XF, XB, INP(I_LNM_G) + 2 * D, INP(I_LNM_B) + 2 * D);); }
    FFN_DENSE(23, W_F2_GU, W_F2_DN, INP(I_LNF_G) + 2 * D, INP(I_LNF_B) + 2 * D);
    { float* PROJD = (float*)(ws + B_PROJD); bf16* CQ = (bf16*)(ws + B_CQ); bf16* CKV = (bf16*)(ws + B_CKV); bf16* Q = (bf16*)(ws + B_Q); bf16* KV = (bf16*)(ws + B_KV);
      bf16* KR = (bf16*)(ws + S_KR); float* ANG = (float*)(ws + S_ANG);
      PHASE(26, GEMM(pg8::EpiF32, XB, D, (const bf16*)(ws + W_D_IN), 512, D, (pg8::EpiF32{PROJD, 512})););
      PHASE(27, mla_norm_phase(F, PROJD, (const int*)args.in[I_POS], INP(I_D_QNG), INP(I_D_KVNG), CQ, CKV, KR, ANG););
      PHASE(28, GEMM(pg8::EpiBf16<0>, CQ, 256, (const bf16*)(ws + W_D_UQ), 1536, 256, (pg8::EpiBf16<0>{Q, 1536}));
                    GEMM(pg8::EpiBf16<0>, CKV, 256, (const bf16*)(ws + W_D_UKV), 2048, 256, (pg8::EpiBf16<0>{KV, 2048})););
      PHASE(29, AttnArgs A; A.Q = Q; A.ldq = 1536; A.qoff = 0; A.K1 = KV; A.ldk1 = 2048; A.k1off = 0; A.k1hs = 128; A.K2 = KR; A.ldk2 = 32; A.V = KV; A.ldv = 2048; A.voff = 64; A.vhs = 128;
          A.O = OB; A.mask = nullptr; A.ang = ANG; A.scale_log2 = 0.10206207261596577f * 1.4426950408889634f; attn_phase<96, false>(F, A););
      PHASE(30, GEMM(pg8::EpiResid, OB, D, (const bf16*)(ws + W_D_OUT), D, D, (pg8::EpiResid{XB, XF, ALPHA}));); }
    FFN_MOE(31, 1, INP(I_M3_R), W_M3_GU, W_M3_DN, INP(I_LNM_G) + 3 * D, INP(I_LNM_B) + 3 * D, INP(I_LNF_G) + 3 * D, INP(I_LNF_B) + 3 * D, args.out);
#undef IN
#undef SEAM
}

extern "C" void kernel_launch(void* const* d_in, const int* in_sizes, int n_in, void* d_out, int out_size, void* d_ws, size_t ws_size, hipStream_t stream) {
    static int grid = 0;
    if (grid == 0) {
        if (n_in != 34 || out_size != M * D || ws_size < WS_END) { fprintf(stderr, "kernel_launch: unexpected problem (n_in %d, out %d, ws %zu < %zu)\n", n_in, out_size, ws_size, (size_t)WS_END); grid = -1; return; }
        int dev = 0, cus = 0;
        if (hipGetDevice(&dev) != hipSuccess || hipDeviceGetAttribute(&cus, hipDeviceAttributeMultiprocessorCount, dev) != hipSuccess) { grid = -1; return; }
        if (hipFuncSetAttribute((const void*)fwd_kernel, hipFuncAttributeMaxDynamicSharedMemorySize, LDS_BYTES) != hipSuccess) { fprintf(stderr, "kernel_launch: hipFuncSetAttribute failed\n"); grid = -1; return; }
        int per_cu = 0;
        if (hipOccupancyMaxActiveBlocksPerMultiprocessor(&per_cu, (const void*)fwd_kernel, NTHREADS, LDS_BYTES) != hipSuccess || per_cu < 1) fprintf(stderr, "kernel_launch: occupancy query reports %d\n", per_cu);
        (void)hipGetLastError();
        grid = cus;
    }
    if (grid < 0) return;
    if (hipMemsetAsync((char*)d_ws + WS_CTL, 0, CTL_ZERO_BYTES, stream) != hipSuccess) return;
    Args a{};
    for (int i = 0; i < 34; ++i) a.in[i] = d_in[i];
    a.out = (float*)d_out; a.ws = (unsigned char*)d_ws;
#if MK_ONE_LAUNCH
    a.ph_lo = 0; a.ph_hi = MK_NRUN;
    hipLaunchKernelGGL(fwd_kernel, dim3(grid), dim3(NTHREADS), LDS_BYTES, stream, a);
#else
    for (int p = 0; p < MK_NRUN; ++p) { a.ph_lo = p; a.ph_hi = p + 1; hipLaunchKernelGGL(fwd_kernel, dim3(grid), dim3(NTHREADS), LDS_BYTES, stream, a); }
#endif
}
```

```cpp
#include <hip/hip_runtime.h>
#include <cstdio>
#include <cstdint>

#define LAS __attribute__((address_space(3)))
#define GAS __attribute__((address_space(1)))
typedef unsigned short bf16;
typedef short bf16x8 __attribute__((ext_vector_type(8)));
typedef short s16x4 __attribute__((ext_vector_type(4)));
typedef float f32x2 __attribute__((ext_vector_type(2)));
typedef float f32x4 __attribute__((ext_vector_type(4)));
typedef float f32x16 __attribute__((ext_vector_type(16)));
typedef unsigned u32x2 __attribute__((ext_vector_type(2)));
typedef unsigned u32x4 __attribute__((ext_vector_type(4)));
typedef unsigned long long u64;

constexpr int NB = 8, SEQ = 2048, D = 1024, M = NB * SEQ;
constexpr int FF = 3584, NE = 8;
constexpr int MOE_ROWS = 34816;
constexpr float ALPHA = 1.6817928305074290f;
constexpr float LN_EPS = 1e-5f, RMS_EPS = 1e-6f;
constexpr int NWAVES = 8, NTHREADS = 512;

constexpr size_t MiB = 1u << 20;
constexpr size_t WS_CTL = 0, CTL_ZERO_BYTES = 1 * MiB;
constexpr size_t WS_W0 = 1 * MiB;
constexpr size_t W_A_IN = WS_W0;
constexpr size_t W_A_OUT = W_A_IN + 8 * MiB;
constexpr size_t W_B_IN = W_A_OUT + 4 * MiB;
constexpr size_t W_B_OUT = W_B_IN + 7 * MiB;
constexpr size_t W_C_IN = W_B_OUT + 2 * MiB;
constexpr size_t W_C_OUT = W_C_IN + 8 * MiB;
constexpr size_t W_D_IN = W_C_OUT + 2 * MiB;
constexpr size_t W_D_UQ = W_D_IN + 1 * MiB;
constexpr size_t W_D_UKV = W_D_UQ + 1 * MiB;
constexpr size_t W_D_OUT = W_D_UKV + 1 * MiB;
constexpr size_t W_F0_GU = W_D_OUT + 2 * MiB;
constexpr size_t W_F0_DN = W_F0_GU + 14 * MiB;
constexpr size_t W_F2_GU = W_F0_DN + 7 * MiB;
constexpr size_t W_F2_DN = W_F2_GU + 14 * MiB;
constexpr size_t W_M1_GU = W_F2_DN + 7 * MiB;
constexpr size_t W_M1_DN = W_M1_GU + 112 * MiB;
constexpr size_t W_M3_GU = W_M1_DN + 56 * MiB;
constexpr size_t W_M3_DN = W_M3_GU + 112 * MiB;
constexpr size_t WS_WEND = W_M3_DN + 56 * MiB;
constexpr size_t WS_XB = WS_WEND;
constexpr size_t WS_SMALL = WS_XB + 32 * MiB;
constexpr size_t S_STATS = WS_SMALL;
constexpr size_t S_TOKE = WS_SMALL + 128 * 1024;
constexpr size_t S_TOKG = WS_SMALL + 256 * 1024;
constexpr size_t S_SLOT = WS_SMALL + 384 * 1024;
constexpr size_t S_ROWTOK = WS_SMALL + 512 * 1024;
constexpr size_t S_ROWGATE = WS_SMALL + 768 * 1024;
constexpr size_t S_ANG = WS_SMALL + 1 * MiB;
constexpr size_t S_KR = WS_SMALL + 3 * MiB;
constexpr size_t S_MASK = WS_SMALL + 4 * MiB;
constexpr size_t WS_BIG = WS_SMALL + 8 * MiB;
constexpr size_t WS_R2 = WS_BIG + 238 * MiB;
constexpr size_t WS_END = WS_R2 + 68 * MiB;
static_assert(WS_WEND == 415 * MiB, "weight map");
static_assert(WS_END <= 880 * MiB, "workspace budget");
constexpr size_t B_UV = WS_BIG, B_GATED = WS_BIG + 128 * MiB;
constexpr size_t B_PROJB = WS_BIG, B_OB = WS_BIG + 192 * MiB;
constexpr size_t B_PROJC = WS_BIG, B_OPRE = WS_BIG + 128 * MiB;
constexpr size_t B_PROJD = WS_BIG, B_CQ = WS_BIG + 32 * MiB, B_CKV = WS_BIG + 40 * MiB, B_Q = WS_BIG + 48 * MiB, B_KV = WS_BIG + 96 * MiB;
constexpr size_t B_H = WS_BIG;
constexpr int CW_BAR = 4096;
constexpr int CW_CNT = 16384;

constexpr int RING_BYTES = 131072;
constexpr int LDSCTL_OFF = RING_BYTES;
constexpr int LDS_BYTES = 147456;

typedef __bf16 bf16x2_t __attribute__((ext_vector_type(2)));
__device__ __forceinline__ unsigned cvt_pk_bf16(float lo, float hi) { const f32x2 v = {lo, hi}; const bf16x2_t b = __builtin_convertvector(v, bf16x2_t); return __builtin_bit_cast(unsigned, b); }
__device__ __forceinline__ float bf2f(unsigned short b) { return __uint_as_float((unsigned)b << 16); }
__device__ __forceinline__ float bflo(unsigned w) { return __uint_as_float(w << 16); }
__device__ __forceinline__ float bfhi(unsigned w) { return __uint_as_float(w & 0xffff0000u); }
__device__ __forceinline__ float fast_exp2(float x) { return __builtin_amdgcn_exp2f(x); }
__device__ __forceinline__ float fast_rcp(float x) { return __builtin_amdgcn_rcpf(x); }
__device__ __forceinline__ float sigmoidf_(float x) { return fast_rcp(1.0f + fast_exp2(-1.4426950408889634f * x)); }
__device__ __forceinline__ float siluf_(float x) { return x * sigmoidf_(x); }
__device__ __forceinline__ float gelu_tanh(float x) { const float u = x + 0.044715f * x * x * x; return x * fast_rcp(1.0f + fast_exp2(-2.302208198f * u)); }
template <int CTRL> __device__ __forceinline__ float dppmov(float v) { return __int_as_float(__builtin_amdgcn_update_dpp(0, __float_as_int(v), CTRL, 0xF, 0xF, true)); }
__device__ __forceinline__ float row_sum16(float v) { v += dppmov<0xB1>(v); v += dppmov<0x4E>(v); v += dppmov<0x124>(v); v += dppmov<0x128>(v); return v; }
__device__ __forceinline__ float rdlane(float v, int l) { return __int_as_float(__builtin_amdgcn_readlane(__float_as_int(v), l)); }
__device__ __forceinline__ float wave_sum(float v) { v = row_sum16(v); return (rdlane(v, 0) + rdlane(v, 16)) + (rdlane(v, 32) + rdlane(v, 48)); }
__device__ __forceinline__ float half_sum32(float v, int lane) { v = row_sum16(v); const float lo = rdlane(v, 0) + rdlane(v, 16), hi = rdlane(v, 32) + rdlane(v, 48); return lane < 32 ? lo : hi; }
#define LDS_WAIT() asm volatile("s_waitcnt lgkmcnt(0)" ::: "memory")
#define VM_WAIT() asm volatile("s_waitcnt vmcnt(0)" ::: "memory")
#define LDS_BARRIER() asm volatile("s_waitcnt lgkmcnt(0)\n\ts_barrier" ::: "memory")
namespace pg8 {
constexpr int BM = 256, BK = 64, HALF = 128, HTB = HALF * BK * 2  , STAGE_BYTES = 8 * HTB, NXCD = 8, WGM = 8;
__host__ __device__ __forceinline__ int lds_byte(int r, int c) { const int st = (r >> 4) * 2 + (c >> 5), rr = r & 15, cc = c & 31, ob = rr * 64 + cc * 2; return st * 1024 + (ob ^ (((ob >> 9) & 1) << 5)); }
__host__ __device__ __forceinline__ void stage_rc(int b, int& R, int& C) { const int st = b / 1024, sb = b % 1024, swz = sb ^ (((sb >> 9) & 1) << 5); R = (st >> 1) * 16 + swz / 64; C = (st & 1) * 32 + (swz % 64) / 2; }
__host__ __device__ __forceinline__ int perm32(int rho) { const int n = rho >> 4, i = rho & 15; return 8 * (i >> 2) + 4 * n + (i & 3); }

struct Unit { int pm, pn, e; };
struct Gemm { const bf16* A; const bf16* Bt; int M, N, K, lda; size_t bes; };

struct StaticOrder {
    int nM, nN, nwg, G, c;
    __device__ void init(int M_, int N_, int G_, int c_) { nM = M_ / BM; nN = N_ / BM; nwg = nM * nN; G = G_; c = c_; }
    __device__ bool next(int i, Unit& u) const {
        const long L = (long)i * G + c; if (L >= nwg) return false;
        int wgid = (int)L; { const int q = nwg / NXCD, r = nwg % NXCD, xcd = wgid % NXCD, off = wgid / NXCD; wgid = (xcd < r ? xcd * (q + 1) : r * (q + 1) + (xcd - r) * q) + off; }
        const int nig = WGM * nN, gid = wgid / nig, fm = gid * WGM, gsz = (nM - fm) < WGM ? (nM - fm) : WGM;
        u.pm = fm + ((wgid % nig) % gsz); u.pn = (wgid % nig) / gsz; u.e = 0; return true;
    }
};
struct MoeOrder {
    StaticOrder so; int pend[NE];
    __device__ bool next(int i, Unit& u) const {
        if (!so.next(i, u)) return false;
        const int r0 = u.pm * BM; int e = 0;
#pragma unroll
        for (int j = 0; j < NE - 1; ++j) e += (r0 >= pend[j]) ? 1 : 0;
        u.e = e; return true;
    }
};

template <int ACT  > struct EpiBf16 {
    static constexpr bool PERM = true;
    bf16* O; int ldc; float sc; int sc_pn;
    __device__ __forceinline__ void operator()(const f32x4 (&acc)[2][2][4][2], const Unit& u, int wr, int wc, int fr, int fq) const {
        const int row0 = u.pm * BM + wr * 64 + fr, col0 = u.pn * BM + wc * 32 + 8 * fq;
        const float s = (u.pn < sc_pn) ? sc : 1.0f;
#pragma unroll
        for (int ai = 0; ai < 2; ++ai)
#pragma unroll
            for (int m = 0; m < 4; ++m) { bf16* rowp = O + (size_t)(row0 + ai * HALF + m * 16) * ldc + col0;
#pragma unroll
                for (int bj = 0; bj < 2; ++bj) { f32x4 v0 = acc[ai][bj][m][0], v1 = acc[ai][bj][m][1];
                    if (ACT == 1) { v0 = (f32x4){gelu_tanh(v0[0]), gelu_tanh(v0[1]), gelu_tanh(v0[2]), gelu_tanh(v0[3])}; v1 = (f32x4){gelu_tanh(v1[0]), gelu_tanh(v1[1]), gelu_tanh(v1[2]), gelu_tanh(v1[3])}; }
                    else { v0 = v0 * s; v1 = v1 * s; }
                    u32x4 w; w.x = cvt_pk_bf16(v0[0], v0[1]); w.y = cvt_pk_bf16(v0[2], v0[3]); w.z = cvt_pk_bf16(v1[0], v1[1]); w.w = cvt_pk_bf16(v1[2], v1[3]);
                    *(u32x4*)(rowp + bj * HALF) = w; } }
    }
};
struct EpiSwiGLU {
    static constexpr bool PERM = true;
    bf16* H; int ldh;
    __device__ __forceinline__ void operator()(const f32x4 (&acc)[2][2][4][2], const Unit& u, int wr, int wc, int fr, int fq) const {
        const int row0 = u.pm * BM + wr * 64 + fr, col0 = u.pn * HALF + wc * 32 + 8 * fq;
#pragma unroll
        for (int ai = 0; ai < 2; ++ai)
#pragma unroll
            for (int m = 0; m < 4; ++m) { bf16* rowp = H + (size_t)(row0 + ai * HALF + m * 16) * ldh + col0;
                const f32x4 g0 = acc[ai][0][m][0], g1 = acc[ai][0][m][1], u0 = acc[ai][1][m][0], u1 = acc[ai][1][m][1];
                u32x4 w; w.x = cvt_pk_bf16(siluf_(g0[0]) * u0[0], siluf_(g0[1]) * u0[1]); w.y = cvt_pk_bf16(siluf_(g0[2]) * u0[2], siluf_(g0[3]) * u0[3]);
                w.z = cvt_pk_bf16(siluf_(g1[0]) * u1[0], siluf_(g1[1]) * u1[1]); w.w = cvt_pk_bf16(siluf_(g1[2]) * u1[2], siluf_(g1[3]) * u1[3]);
                *(u32x4*)rowp = w; }
    }
};
struct EpiResid {
    static constexpr bool PERM = false;
    const bf16* X; float* Y; float alpha;
    __device__ __forceinline__ void operator()(const f32x4 (&acc)[2][2][4][2], const Unit& u, int wr, int wc, int fr, int fq) const {
        const int row0 = u.pm * BM + wr * 64 + fr, col0 = u.pn * BM + wc * 32 + 4 * fq;
#pragma unroll
        for (int ai = 0; ai < 2; ++ai)
#pragma unroll
            for (int m = 0; m < 4; ++m) { const size_t off = (size_t)(row0 + ai * HALF + m * 16) * D + col0;
#pragma unroll
                for (int bj = 0; bj < 2; ++bj)
#pragma unroll
                    for (int n = 0; n < 2; ++n) { const u32x2 xw = *(const u32x2*)(X + off + bj * HALF + n * 16); const f32x4 xv = (f32x4){bflo(xw.x), bfhi(xw.x), bflo(xw.y), bfhi(xw.y)};
                        *(f32x4*)(Y + off + bj * HALF + n * 16) = xv * alpha + acc[ai][bj][m][n]; } }
    }
};
struct EpiF32 {
    static constexpr bool PERM = false;
    float* C; int ldc;
    __device__ __forceinline__ void operator()(const f32x4 (&acc)[2][2][4][2], const Unit& u, int wr, int wc, int fr, int fq) const {
        const int row0 = u.pm * BM + wr * 64 + fr, col0 = u.pn * BM + wc * 32 + 4 * fq;
#pragma unroll
        for (int ai = 0; ai < 2; ++ai)
#pragma unroll
            for (int m = 0; m < 4; ++m) { float* rowp = C + (size_t)(row0 + ai * HALF + m * 16) * ldc + col0;
#pragma unroll
                for (int bj = 0; bj < 2; ++bj)
#pragma unroll
                    for (int n = 0; n < 2; ++n) *(f32x4*)(rowp + bj * HALF + n * 16) = acc[ai][bj][m][n]; }
    }
};
struct EpiMoeDown {
    static constexpr bool PERM = true;
    bf16* YK; const int* rowtok; const float* rowgate;
    __device__ __forceinline__ void operator()(const f32x4 (&acc)[2][2][4][2], const Unit& u, int wr, int wc, int fr, int fq) const {
        const int row0 = u.pm * BM + wr * 64 + fr, col0 = u.pn * BM + wc * 32 + 8 * fq;
#pragma unroll
        for (int ai = 0; ai < 2; ++ai)
#pragma unroll
            for (int m = 0; m < 4; ++m) { const int r = row0 + ai * HALF + m * 16; const int rt = rowtok[r]; const float gt = rowgate[r];
                if (rt >= 0) { bf16* rowp = YK + (size_t)(rt & 1) * ((size_t)M * D) + (size_t)(rt >> 1) * D + col0;
#pragma unroll
                    for (int bj = 0; bj < 2; ++bj) { const f32x4 v0 = acc[ai][bj][m][0] * gt, v1 = acc[ai][bj][m][1] * gt;
                        u32x4 w; w.x = cvt_pk_bf16(v0[0], v0[1]); w.y = cvt_pk_bf16(v0[2], v0[3]); w.z = cvt_pk_bf16(v1[0], v1[1]); w.w = cvt_pk_bf16(v1[2], v1[3]);
                        *(u32x4*)(rowp + bj * HALF) = w; } } }
    }
};

template <class Epi, class Sched>
__device__ __forceinline__ void gemm_phase(LAS unsigned char* lds, const Gemm g, const Sched& S, const Epi& E) {
    const int tid = threadIdx.x, wid = __builtin_amdgcn_readfirstlane(tid >> 6), lane = tid & 63, wr = wid >> 2, wc = wid & 3, fr = lane & 15, fq = lane >> 4;
    const int K = g.K, nt = K / BK;
    unsigned voffA[2], voffB[2];
#pragma unroll
    for (int i = 0; i < 2; ++i) { int R, C; stage_rc(tid * 16 + i * 8192, R, C); const int Rb = Epi::PERM ? ((R & ~31) + perm32(R & 31)) : R;
        voffA[i] = (unsigned)(R * g.lda + C) * 2u; voffB[i] = (unsigned)(Rb * K + C) * 2u; }
    const size_t kstep = (size_t)(BK * 2);
    const size_t hstepA = (size_t)HALF * g.lda * 2, tstepA = 2 * hstepA;
    const size_t hstepB = (size_t)HALF * K * 2, tstepB = 2 * hstepB;
    const size_t besB = g.bes * 2;
    const unsigned ldsw = (unsigned)wid * 1024u;
    const int aoff = lds_byte(wr * 64 + fr, fq * 8), boff = lds_byte(wc * 32 + fr, fq * 8);
#define PG8_SA(b, h) (((b) * 2 + (h)) * HTB)
#define PG8_SB(b, h) ((4 + (b) * 2 + (h)) * HTB)
#define PG8_STAGE(bufoff, gbase, voff) do { _Pragma("unroll") for (int _i = 0; _i < 2; ++_i) \
        __builtin_amdgcn_global_load_lds((const unsigned*)((const char*)(gbase) + (voff)[_i]), (LAS unsigned*)(lds + (bufoff) + ldsw + _i * 8192), 16, 0, 0); } while (0)
#define PG8_LDA(dst, b, h) do { _Pragma("unroll") for (int m = 0; m < 4; ++m) _Pragma("unroll") for (int k = 0; k < 2; ++k) dst[m][k] = *(const LAS bf16x8*)(lds + PG8_SA(b, h) + aoff + m * 2048 + k * 1024); } while (0)
#define PG8_LDB(dst, b, h) do { _Pragma("unroll") for (int n = 0; n < 2; ++n) _Pragma("unroll") for (int k = 0; k < 2; ++k) dst[n][k] = *(const LAS bf16x8*)(lds + PG8_SB(b, h) + boff + n * 2048 + k * 1024); } while (0)
#define PG8_MMA(ai, bj, At, Bt) do { __builtin_amdgcn_s_setprio(1); _Pragma("unroll") for (int m = 0; m < 4; ++m) _Pragma("unroll") for (int n = 0; n < 2; ++n) _Pragma("unroll") for (int k = 0; k < 2; ++k) \
        acc[ai][bj][m][n] = __builtin_amdgcn_mfma_f32_16x16x32_bf16(Bt[n][k], At[m][k], acc[ai][bj][m][n], 0, 0, 0); __builtin_amdgcn_s_setprio(0); } while (0)
#define PG8_WAIT_V(n) asm volatile("s_waitcnt vmcnt(" #n ")" ::: "memory")
#define PG8_WAIT_L(n) asm volatile("s_waitcnt lgkmcnt(" #n ")" ::: "memory")
#define PG8_BAR __builtin_amdgcn_s_barrier()
#define PG8_SCHED __builtin_amdgcn_sched_barrier(0)
    Unit cur, nxt; int ui = 0;
    if (!S.next(0, cur)) return;
    f32x4 acc[2][2][4][2];
#pragma unroll
    for (int a = 0; a < 2; ++a)
#pragma unroll
        for (int b = 0; b < 2; ++b)
#pragma unroll
            for (int m = 0; m < 4; ++m)
#pragma unroll
                for (int n = 0; n < 2; ++n) acc[a][b][m][n] = (f32x4){0.f, 0.f, 0.f, 0.f};
    bf16x8 At[4][2], B0[2][2], B1[2][2];
    const char* cA = (const char*)g.A + (size_t)cur.pm * tstepA; const char* cB = (const char*)g.Bt + (size_t)cur.e * besB + (size_t)cur.pn * tstepB;
    PG8_STAGE(PG8_SB(0, 0), cB, voffB); PG8_STAGE(PG8_SB(0, 1), cB + hstepB, voffB); PG8_STAGE(PG8_SA(0, 0), cA, voffA); PG8_STAGE(PG8_SA(0, 1), cA + hstepA, voffA);
    if (wr == 1) PG8_BAR;
    PG8_WAIT_V(2); PG8_BAR;
    PG8_STAGE(PG8_SB(1, 0), cB + kstep, voffB); PG8_STAGE(PG8_SA(1, 0), cA + kstep, voffA); PG8_STAGE(PG8_SB(1, 1), cB + hstepB + kstep, voffB);
    PG8_WAIT_V(6); PG8_BAR;
    for (;;) {
        const bool has_next = S.next(ui + 1, nxt);
        const char* nA = has_next ? (const char*)g.A + (size_t)nxt.pm * tstepA : cA; const char* nB = has_next ? (const char*)g.Bt + (size_t)nxt.e * besB + (size_t)nxt.pn * tstepB : cB;
        for (int t = 0; t < nt; t += 2) {
            const bool last = (t == nt - 2);
            const char* a1 = cA + (size_t)(t + 1) * kstep;
            const char* a2 = last ? nA : cA + (size_t)(t + 2) * kstep; const char* b2 = last ? nB : cB + (size_t)(t + 2) * kstep;
            const char* a3 = a2 + kstep; const char* b3 = b2 + kstep;
            PG8_LDB(B0, 0, 0); PG8_LDB(B1, 0, 1); PG8_SCHED; PG8_LDA(At, 0, 0); PG8_STAGE(PG8_SA(1, 1), a1 + hstepA, voffA);
            PG8_WAIT_V(8); PG8_WAIT_L(0); PG8_BAR; PG8_MMA(0, 0, At, B0); PG8_MMA(0, 1, At, B1); PG8_BAR; PG8_SCHED;
            PG8_LDA(At, 0, 1); PG8_STAGE(PG8_SB(0, 0), b2, voffB); PG8_STAGE(PG8_SB(0, 1), b2 + hstepB, voffB); PG8_STAGE(PG8_SA(0, 0), a2, voffA);
            PG8_WAIT_V(8); PG8_WAIT_L(0); PG8_BAR; PG8_MMA(1, 0, At, B0); PG8_MMA(1, 1, At, B1); PG8_BAR; PG8_SCHED;
            PG8_LDB(B0, 1, 0); PG8_LDB(B1, 1, 1); PG8_SCHED; PG8_LDA(At, 1, 0); PG8_STAGE(PG8_SA(0, 1), a2 + hstepA, voffA);
            PG8_WAIT_V(8); PG8_WAIT_L(0); PG8_BAR; PG8_MMA(0, 0, At, B0); PG8_MMA(0, 1, At, B1); PG8_BAR; PG8_SCHED;
            PG8_LDA(At, 1, 1); PG8_STAGE(PG8_SB(1, 0), b3, voffB); PG8_STAGE(PG8_SB(1, 1), b3 + hstepB, voffB); PG8_STAGE(PG8_SA(1, 0), a3, voffA);
            PG8_WAIT_V(8); PG8_WAIT_L(0); PG8_BAR; PG8_MMA(1, 0, At, B0); PG8_MMA(1, 1, At, B1); PG8_BAR; PG8_SCHED;
        }
        if (wr == 0) PG8_BAR;
        E(acc, cur, wr, wc, fr, fq);
        if (!has_next) break;
#pragma unroll
        for (int a = 0; a < 2; ++a)
#pragma unroll
            for (int b = 0; b < 2; ++b)
#pragma unroll
                for (int m = 0; m < 4; ++m)
#pragma unroll
                    for (int n = 0; n < 2; ++n) acc[a][b][m][n] = (f32x4){0.f, 0.f, 0.f, 0.f};
        cur = nxt; cA = nA; cB = nB; ++ui;
        if (wr == 1) PG8_BAR;
    }
    PG8_WAIT_V(0);
    PG8_BAR;
#undef PG8_SA
#undef PG8_SB
#undef PG8_STAGE
#undef PG8_LDA
#undef PG8_LDB
#undef PG8_MMA
#undef PG8_WAIT_V
#undef PG8_WAIT_L
#undef PG8_BAR
#undef PG8_SCHED
}
}
#define XB_TMO      128
#define XB_XCNT(j)  (256  + 64 * (j))
#define XB_XSUB(j)  (1280 + 64 * (j))
#define XB_XGEN(j)  (2304 + 64 * (j))
#define XB_TOP      3328
#define XB_TOPGEN   3392
#define XCD_BAR_WORDS 3456
#define XB_SPIN_CAP (1u << 18)
__device__ __forceinline__ unsigned xb_ld(unsigned* p)              { return __hip_atomic_load(p, __ATOMIC_RELAXED, __HIP_MEMORY_SCOPE_AGENT); }
__device__ __forceinline__ unsigned xb_add(unsigned* p, unsigned v) { return __hip_atomic_fetch_add(p, v, __ATOMIC_RELAXED, __HIP_MEMORY_SCOPE_AGENT); }
__device__ __forceinline__ unsigned xb_xcc_id() { return (unsigned)__builtin_amdgcn_s_getreg((3 << 11) | 20) & 0xFu; }
#define XB_SPIN(cond, bar) do { unsigned _sp = 0; while (cond) { __builtin_amdgcn_s_sleep(1); \
    if ((++_sp & 255u) == 0u) { if (xb_ld(&(bar)[XB_TMO])) break; if (_sp > XB_SPIN_CAP) { atomicAdd(&(bar)[XB_TMO], 1u); break; } } } } while (0)
struct XcdBarrier { unsigned* bar; unsigned x; volatile LAS unsigned* st; };
__device__ __forceinline__ XcdBarrier xcd_barrier_post(unsigned* bar, volatile LAS unsigned* st) {
    XcdBarrier b; b.bar = bar; b.x = xb_xcc_id(); b.st = st;
    if (threadIdx.x == 0) (void)xb_add(&bar[XB_XCNT(b.x)], 1u);
    return b;
}
__device__ __forceinline__ void xcd_barrier_complete(unsigned* bar, unsigned x, unsigned& nloc, unsigned& nx) {
    const unsigned G = gridDim.x * gridDim.y * gridDim.z;
    unsigned sum, cnt, mine, sp = 0u;
    for (;;) {
        sum = 0u; cnt = 0u; mine = 0u;
#pragma unroll
        for (unsigned j = 0; j < 16; ++j) { const unsigned c = xb_ld(&bar[XB_XCNT(j)]); sum += c; cnt += (c > 0u) ? 1u : 0u; mine = (j == x) ? c : mine; }
        if (sum == G) break;
        __builtin_amdgcn_s_sleep(1);
        if ((++sp & 255u) == 0u) { if (xb_ld(&bar[XB_TMO])) break; if (sp > XB_SPIN_CAP) { atomicAdd(&bar[XB_TMO], 1u); break; } }
    }
    nloc = mine > 0u ? mine : 1u; nx = cnt > 0u ? cnt : 1u;
}
__device__ __forceinline__ void xcd_barrier(const XcdBarrier& b) {
    asm volatile("s_waitcnt vmcnt(0)" ::: "memory");
    __syncthreads();
    if (threadIdx.x == 0) {
        unsigned* bar = b.bar;
        __builtin_amdgcn_s_waitcnt(0);
        unsigned nloc = b.st[0], nx = b.st[1];
        if (nloc == 0u) { xcd_barrier_complete(bar, b.x, nloc, nx); b.st[0] = nloc; b.st[1] = nx; }
        const unsigned old = xb_add(&bar[XB_XSUB(b.x)], 1u);
        const unsigned gen = old / nloc;
        if (old + 1u == (gen + 1u) * nloc) {
            __builtin_amdgcn_fence(__ATOMIC_RELEASE, "agent");
            asm volatile("s_waitcnt vmcnt(0)" ::: "memory");
            const unsigned og = xb_add(&bar[XB_TOP], 1u);
            const unsigned tg = og / nx;
            if (og + 1u == (tg + 1u) * nx) xb_add(&bar[XB_TOPGEN], 1u);
            else XB_SPIN(xb_ld(&bar[XB_TOPGEN]) == tg, bar);
            __builtin_amdgcn_fence(__ATOMIC_ACQUIRE, "agent");
            xb_add(&bar[XB_XGEN(b.x)], 1u);
            asm volatile("s_waitcnt vmcnt(0)" ::: "memory");
        } else {
            XB_SPIN(xb_ld(&bar[XB_XGEN(b.x)]) == gen, bar);
            __builtin_amdgcn_fence(__ATOMIC_ACQUIRE, "agent");
            asm volatile("s_waitcnt vmcnt(0)" ::: "memory");
        }
    }
    __syncthreads();
}

struct Frame {
    LAS unsigned char* lds;
    unsigned* ctl;
    unsigned char* ws;
    int tid, lane, wave, G, bid;
};
struct Args { const void* in[34]; float* out; unsigned char* ws; int ph_lo, ph_hi; };

enum { I_X = 0, I_POS, I_A_WIN, I_A_LNG, I_A_LNB, I_A_WS, I_A_BS, I_A_WOUT, I_B_WIN, I_B_WOUT, I_C_WIN, I_C_LB, I_C_NG, I_C_WOUT,
       I_D_WIN, I_D_QNG, I_D_WUQ, I_D_KVNG, I_D_WUKV, I_D_WOUT, I_F0_GU, I_F0_DN, I_M1_R, I_M1_GU, I_M1_DN, I_F2_GU, I_F2_DN, I_M3_R, I_M3_GU, I_M3_DN,
       I_LNM_G, I_LNM_B, I_LNF_G, I_LNF_B };

__device__ __forceinline__ void cvt_load(f32x4 (&r)[8], const float* W, int Kv, int Nv, int k0, int n0, int lane) {
    const int n = n0 + 4 * (lane & 7);
#pragma unroll
    for (int i = 0; i < 8; ++i) { const int k = k0 + 8 * i + (lane >> 3); r[i] = (k < Kv && n < Nv) ? *(const f32x4*)(W + (size_t)k * Nv + n) : (f32x4){0.f, 0.f, 0.f, 0.f}; }
}
__device__ __forceinline__ void cvt_store(const f32x4 (&r)[8], bf16* WT, int Kp, int mode, int k0, int n0, LAS float* scr, int lane) {
#pragma unroll
    for (int i = 0; i < 8; ++i) { LAS float* p = scr + (8 * i + (lane >> 3)) * 33 + 4 * (lane & 7); p[0] = r[i].x; p[1] = r[i].y; p[2] = r[i].z; p[3] = r[i].w; }
    LDS_WAIT(); asm volatile("" ::: "memory");
    int drow0;
    if (mode == 0) drow0 = n0; else { const int j = (n0 < FF) ? n0 : n0 - FF; drow0 = 256 * (j >> 7) + (j & 127) + ((n0 < FF) ? 0 : 128); }
    const int c = lane & 7;
#pragma unroll
    for (int j = 0; j < 4; ++j) { const int n = (lane >> 3) + 8 * j; const LAS float* s = scr + (8 * c) * 33 + n;
        u32x4 o; o.x = cvt_pk_bf16(s[0 * 33], s[1 * 33]); o.y = cvt_pk_bf16(s[2 * 33], s[3 * 33]); o.z = cvt_pk_bf16(s[4 * 33], s[5 * 33]); o.w = cvt_pk_bf16(s[6 * 33], s[7 * 33]);
        *(u32x4*)(WT + (size_t)(drow0 + n) * Kp + k0 + 8 * c) = o; }
    LDS_WAIT(); asm volatile("" ::: "memory");
}
__device__ __forceinline__ void convert_matrix(const Frame& F, const float* W, int Kv, int Nv, bf16* WT, int Kp, int Np, int mode, int nmat) {
    LAS float* scr = (LAS float*)(F.lds + F.wave * 16384);
    const int gw = F.bid * NWAVES + F.wave, NGW = F.G * NWAVES;
    const int nkb = Kp / 64, nnb = Np / 32, per = nkb * nnb;
    const long total = (long)per * nmat;
#define CVT_DEC(it_, mat_, k0_, n0_) const int mat_ = (int)((it_) / per), r_##mat_ = (int)((it_) % per); const int k0_ = 64 * (r_##mat_ / nnb), n0_ = 32 * (r_##mat_ % nnb)
    f32x4 ra[8], rb[8];
    long it = gw;
    if (it < total) { CVT_DEC(it, m0, k0, n0); cvt_load(ra, W + (size_t)m0 * Kv * Nv, Kv, Nv, k0, n0, F.lane); }
    while (it < total) {
        { const long nx = it + NGW; if (nx < total) { CVT_DEC(nx, m1, k1, n1); cvt_load(rb, W + (size_t)m1 * Kv * Nv, Kv, Nv, k1, n1, F.lane); }
          CVT_DEC(it, m0, k0, n0); cvt_store(ra, WT + (size_t)m0 * Kp * Np, Kp, mode, k0, n0, scr, F.lane); it = nx; }
        if (it >= total) break;
        { const long nx = it + NGW; if (nx < total) { CVT_DEC(nx, m1, k1, n1); cvt_load(ra, W + (size_t)m1 * Kv * Nv, Kv, Nv, k1, n1, F.lane); }
          CVT_DEC(it, m0, k0, n0); cvt_store(rb, WT + (size_t)m0 * Kp * Np, Kp, mode, k0, n0, scr, F.lane); it = nx; }
    }
#undef CVT_DEC
}

__device__ __forceinline__ void ln_row(f32x4 (&v)[4], const float* g, const float* b, int lane) {
    float s = 0.f;
#pragma unroll
    for (int j = 0; j < 4; ++j) s += (v[j].x + v[j].y) + (v[j].z + v[j].w);
    const float mean = wave_sum(s) * (1.f / D); float s2 = 0.f;
#pragma unroll
    for (int j = 0; j < 4; ++j) { v[j] = v[j] - mean; s2 += (v[j].x * v[j].x + v[j].y * v[j].y) + (v[j].z * v[j].z + v[j].w * v[j].w); }
    const float rstd = __builtin_amdgcn_rsqf(wave_sum(s2) * (1.f / D) + LN_EPS);
#pragma unroll
    for (int j = 0; j < 4; ++j) { const f32x4 gg = *(const f32x4*)(g + 4 * lane + 256 * j), bb = *(const f32x4*)(b + 4 * lane + 256 * j); v[j] = v[j] * rstd * gg + bb; }
}
__device__ __forceinline__ void store_row_bf(const f32x4 (&v)[4], bf16* ob, int lane) {
#pragma unroll
    for (int j = 0; j < 4; ++j) { u32x2 w; w.x = cvt_pk_bf16(v[j].x, v[j].y); w.y = cvt_pk_bf16(v[j].z, v[j].w); *(u32x2*)(ob + 4 * lane + 256 * j) = w; }
}
__device__ __forceinline__ void store_row_f32(const f32x4 (&v)[4], float* of, int lane) {
#pragma unroll
    for (int j = 0; j < 4; ++j) *(f32x4*)(of + 4 * lane + 256 * j) = v[j];
}
__device__ __forceinline__ void ln_phase(const Frame& F, const float* xf, bf16* xb, const float* g, const float* b) {
    const int gw = F.bid * NWAVES + F.wave, NGW = F.G * NWAVES;
    for (int r = gw; r < M; r += 2 * NGW) {
        const int r2 = r + NGW; const bool has2 = r2 < M; const int rr2 = has2 ? r2 : r;
        f32x4 v[4], w[4];
#pragma unroll
        for (int j = 0; j < 4; ++j) { v[j] = *(const f32x4*)(xf + (size_t)r * D + 4 * F.lane + 256 * j); w[j] = *(const f32x4*)(xf + (size_t)rr2 * D + 4 * F.lane + 256 * j); }
        ln_row(v, g, b, F.lane); ln_row(w, g, b, F.lane);
        store_row_bf(v, xb + (size_t)r * D, F.lane);
        if (has2) store_row_bf(w, xb + (size_t)r2 * D, F.lane);
    }
}
__device__ __forceinline__ void ln_route_phase(const Frame& F, const float* xf, bf16* xb, const float* g, const float* b, const float* wr, unsigned* cnt  ) {
    LAS float* WR = (LAS float*)F.lds;
    LAS int* EB = (LAS int*)(F.lds + 32768);
    for (int i = F.tid; i < D * NE / 4; i += NTHREADS) ((LAS f32x4*)WR)[i] = ((const f32x4*)wr)[i];
    __syncthreads();
    int* toke = (int*)(F.ws + S_TOKE); float* tokg = (float*)(F.ws + S_TOKG); int* slot = (int*)(F.ws + S_SLOT);
    for (int blk = F.bid; blk < M / 64; blk += F.G) {
        for (int i = 0; i < 8; ++i) {
            const int rl = F.wave * 8 + i, r = blk * 64 + rl;
            f32x4 v[4];
#pragma unroll
            for (int j = 0; j < 4; ++j) v[j] = *(const f32x4*)(xf + (size_t)r * D + 4 * F.lane + 256 * j);
            ln_row(v, g, b, F.lane);
            store_row_bf(v, xb + (size_t)r * D, F.lane);
            float lg[NE];
#pragma unroll
            for (int e = 0; e < NE; ++e) lg[e] = 0.f;
#pragma unroll
            for (int j = 0; j < 4; ++j)
#pragma unroll
                for (int c = 0; c < 4; ++c) { const LAS f32x4* wp = (const LAS f32x4*)(WR + (size_t)(4 * F.lane + 256 * j + c) * NE); const f32x4 w0 = wp[0], w1 = wp[1]; const float xv = v[j][c];
                    lg[0] += xv * w0.x; lg[1] += xv * w0.y; lg[2] += xv * w0.z; lg[3] += xv * w0.w; lg[4] += xv * w1.x; lg[5] += xv * w1.y; lg[6] += xv * w1.z; lg[7] += xv * w1.w; }
#pragma unroll
            for (int e = 0; e < NE; ++e) lg[e] = wave_sum(lg[e]);
            int e0 = 0; float l0 = lg[0];
#pragma unroll
            for (int e = 1; e < NE; ++e) if (lg[e] > l0) { l0 = lg[e]; e0 = e; }
            int e1 = -1; float l1 = -3.0e38f;
#pragma unroll
            for (int e = 0; e < NE; ++e) if (e != e0 && lg[e] > l1) { l1 = lg[e]; e1 = e; }
            const float ex = __expf(l1 - l0), g0 = 1.f / (1.f + ex), g1 = ex * g0;
            if (F.lane == 0) { toke[2 * r] = e0; toke[2 * r + 1] = e1; tokg[2 * r] = g0; tokg[2 * r + 1] = g1; EB[2 * rl] = e0; EB[2 * rl + 1] = e1; }
        }
        __syncthreads();
        if (F.wave == 0) {
            const int lane = F.lane; const int ea = EB[lane], eb = EB[64 + lane];
            const u64 lt = (1ull << lane) - 1ull; int myc = 0, ra = 0, rbk = 0;
#pragma unroll
            for (int e = 0; e < NE; ++e) { const u64 ma = __ballot(ea == e), mb = __ballot(eb == e); const int pa = __builtin_popcountll(ma), c = pa + __builtin_popcountll(mb);
                if (lane == e) myc = c; if (ea == e) ra = __builtin_popcountll(ma & lt); if (eb == e) rbk = pa + __builtin_popcountll(mb & lt); }
            int basev = 0; if (lane < NE) basev = (int)__hip_atomic_fetch_add(cnt + 64 * lane, (unsigned)myc, __ATOMIC_RELAXED, __HIP_MEMORY_SCOPE_AGENT);
            int ba = 0, bb = 0;
#pragma unroll
            for (int e = 0; e < NE; ++e) { const int be = __builtin_amdgcn_readlane(basev, e); if (ea == e) ba = be; if (eb == e) bb = be; }
            slot[(size_t)(blk * 64) * 2 + lane] = ba + ra; slot[(size_t)(blk * 64) * 2 + 64 + lane] = bb + rbk;
        }
        __syncthreads();
    }
}
__device__ __forceinline__ int moe_segments(const unsigned* cnt, int (&cntv)[NE], int (&pstart)[NE], int (&pend)[NE]) {
    int acc = 0;
#pragma unroll
    for (int e = 0; e < NE; ++e) { cntv[e] = (int)__hip_atomic_load(cnt + 64 * e, __ATOMIC_RELAXED, __HIP_MEMORY_SCOPE_AGENT); pstart[e] = acc; acc += (cntv[e] + 255) & ~255; pend[e] = acc; }
    return acc;
}
__device__ __forceinline__ void moe_gather_phase(const Frame& F, const bf16* xb, bf16* xr, const unsigned* cnt) {
    int cntv[NE], pstart[NE], pend[NE]; moe_segments(cnt, cntv, pstart, pend);
    const int* toke = (const int*)(F.ws + S_TOKE); const float* tokg = (const float*)(F.ws + S_TOKG); const int* slot = (const int*)(F.ws + S_SLOT);
    int* rowtok = (int*)(F.ws + S_ROWTOK); float* rowgate = (float*)(F.ws + S_ROWGATE);
    const int gw = F.bid * NWAVES + F.wave, NGW = F.G * NWAVES;
    for (int a = gw; a < 2 * M; a += NGW) {
        const int e = toke[a]; int ps = 0;
#pragma unroll
        for (int j = 0; j < NE; ++j) ps = (e == j) ? pstart[j] : ps;
        const int dest = ps + slot[a]; const int t = a >> 1;
        const u32x4* src = (const u32x4*)(xb + (size_t)t * D); u32x4* dst = (u32x4*)(xr + (size_t)dest * D);
        dst[F.lane] = src[F.lane]; dst[F.lane + 64] = src[F.lane + 64];
        if (F.lane == 0) { rowtok[dest] = a; rowgate[dest] = tokg[a]; }
    }
    for (int i = gw; i < NE * 256; i += NGW) {
        const int e = i >> 8, j = i & 255; int ps = 0, cv = 0, pe = 0;
#pragma unroll
        for (int q = 0; q < NE; ++q) { ps = (e == q) ? pstart[q] : ps; cv = (e == q) ? cntv[q] : cv; pe = (e == q) ? pend[q] : pe; }
        const int r = ps + cv + j;
        if (r < pe) { u32x4* dst = (u32x4*)(xr + (size_t)r * D); const u32x4 z = (u32x4){0u, 0u, 0u, 0u}; dst[F.lane] = z; dst[F.lane + 64] = z; if (F.lane == 0) { rowtok[r] = -1; rowgate[r] = 0.f; } }
    }
}
__device__ __forceinline__ void ln_moe_load(f32x4 (&v)[4], const bf16* xb, const bf16* yk, int r, int lane) {
#pragma unroll
    for (int j = 0; j < 4; ++j) { const size_t o = (size_t)r * D + 4 * lane + 256 * j; const u32x2 x = *(const u32x2*)(xb + o);
        const u32x2 a = *(const u32x2*)(yk + o), c = *(const u32x2*)(yk + (size_t)M * D + o);
        v[j].x = bflo(x.x) * ALPHA + bflo(a.x) + bflo(c.x); v[j].y = bfhi(x.x) * ALPHA + bfhi(a.x) + bfhi(c.x); v[j].z = bflo(x.y) * ALPHA + bflo(a.y) + bflo(c.y); v[j].w = bfhi(x.y) * ALPHA + bfhi(a.y) + bfhi(c.y); }
}
__device__ __forceinline__ void ln_moe_phase(const Frame& F, const bf16* yk, float* outf, bf16* xb, const float* g, const float* b) {
    const int gw = F.bid * NWAVES + F.wave, NGW = F.G * NWAVES;
    for (int r = gw; r < M; r += 2 * NGW) {
        const int r2 = r + NGW; const bool has2 = r2 < M; const int rr2 = has2 ? r2 : r;
        f32x4 v[4], w[4];
        ln_moe_load(v, xb, yk, r, F.lane); ln_moe_load(w, xb, yk, rr2, F.lane);
        ln_row(v, g, b, F.lane); ln_row(w, g, b, F.lane);
        if (outf) { store_row_f32(v, outf + (size_t)r * D, F.lane); if (has2) store_row_f32(w, outf + (size_t)r2 * D, F.lane); }
        else { store_row_bf(v, xb + (size_t)r * D, F.lane); if (has2) store_row_bf(w, xb + (size_t)r2 * D, F.lane); }
    }
}
__device__ __forceinline__ void cvt_rows_phase(const Frame& F, const float* x, bf16* xb) {
    const int gw = F.bid * NWAVES + F.wave, NGW = F.G * NWAVES;
    for (int r = gw; r < M; r += NGW) {
#pragma unroll
        for (int j = 0; j < 4; ++j) { const size_t o = (size_t)r * D + 4 * F.lane + 256 * j; const f32x4 v = *(const f32x4*)(x + o);
            u32x2 w; w.x = cvt_pk_bf16(v.x, v.y); w.y = cvt_pk_bf16(v.z, v.w); *(u32x2*)(xb + o) = w; }
    }
}
__device__ __forceinline__ void gmlp_stats_phase(const Frame& F, const bf16* uv, float* stats) {
    const int gw = F.bid * NWAVES + F.wave, NGW = F.G * NWAVES;
    for (int r = gw; r < M; r += NGW) {
        const u32x4* p = (const u32x4*)(uv + (size_t)r * 4096 + 2048);
        float x[32]; float s = 0.f;
#pragma unroll
        for (int j = 0; j < 4; ++j) { const u32x4 w = p[F.lane + 64 * j];
            x[8 * j + 0] = bflo(w.x); x[8 * j + 1] = bfhi(w.x); x[8 * j + 2] = bflo(w.y); x[8 * j + 3] = bfhi(w.y); x[8 * j + 4] = bflo(w.z); x[8 * j + 5] = bfhi(w.z); x[8 * j + 6] = bflo(w.w); x[8 * j + 7] = bfhi(w.w); }
#pragma unroll
        for (int i = 0; i < 32; ++i) s += x[i];
        const float mean = wave_sum(s) * (1.f / 2048.f); float s2 = 0.f;
#pragma unroll
        for (int i = 0; i < 32; ++i) { const float d = x[i] - mean; s2 += d * d; }
        const float rstd = __builtin_amdgcn_rsqf(wave_sum(s2) * (1.f / 2048.f) + LN_EPS);
        if (F.lane == 0) { stats[2 * r] = mean; stats[2 * r + 1] = rstd; }
    }
}
constexpr int GM_WS = 136, GM_VS = 136;
__device__ __forceinline__ void gmlp_spatial_phase(const Frame& F, const bf16* uv, const float* stats, const float* ws_in  , const float* bs  ,
                                                   const float* lng, const float* lnb, bf16* gated) {
    LAS bf16* Ws = (LAS bf16*)F.lds;
    LAS bf16* Vt = (LAS bf16*)(F.lds + 128 * GM_WS * 2);
    const int tid = F.tid, lane = F.lane, w = F.wave, wr = w >> 2, wc = w & 3, fr = lane & 15, fq = lane >> 4;
    for (int u = F.bid; u < 1024; u += F.G) {
        const int bc = u >> 3, g = u & 7; const size_t rowbase = (size_t)bc * 128;
        { const int t = tid >> 2, c0 = (tid & 3) * 32; const float* wp = ws_in + ((size_t)g * 128 + t) * 128 + c0;
#pragma unroll
            for (int q = 0; q < 4; ++q) { const f32x4 a = *(const f32x4*)(wp + 8 * q), b = *(const f32x4*)(wp + 8 * q + 4); const int s0 = c0 + 8 * q;
                u32x4 o; o.x = cvt_pk_bf16(s0 + 0 <= t ? a.x : 0.f, s0 + 1 <= t ? a.y : 0.f); o.y = cvt_pk_bf16(s0 + 2 <= t ? a.z : 0.f, s0 + 3 <= t ? a.w : 0.f);
                o.z = cvt_pk_bf16(s0 + 4 <= t ? b.x : 0.f, s0 + 5 <= t ? b.y : 0.f); o.w = cvt_pk_bf16(s0 + 6 <= t ? b.z : 0.f, s0 + 7 <= t ? b.w : 0.f);
                *(LAS u32x4*)(Ws + t * GM_WS + s0) = o; } }
        { const int so = tid & 15, dq = tid >> 4; const int col = 256 * g + 8 * dq;
            const f32x4 g0 = *(const f32x4*)(lng + col), g1 = *(const f32x4*)(lng + col + 4), b0 = *(const f32x4*)(lnb + col), b1 = *(const f32x4*)(lnb + col + 4);
            float vv[8][8];
#pragma unroll
            for (int j = 0; j < 8; ++j) { const size_t r = rowbase + 8 * so + j; const u32x4 wv = *(const u32x4*)(uv + r * 4096 + 2048 + col); const float mean = stats[2 * r], rstd = stats[2 * r + 1];
                vv[j][0] = (bflo(wv.x) - mean) * rstd * g0.x + b0.x; vv[j][1] = (bfhi(wv.x) - mean) * rstd * g0.y + b0.y; vv[j][2] = (bflo(wv.y) - mean) * rstd * g0.z + b0.z; vv[j][3] = (bfhi(wv.y) - mean) * rstd * g0.w + b0.w;
                vv[j][4] = (bflo(wv.z) - mean) * rstd * g1.x + b1.x; vv[j][5] = (bfhi(wv.z) - mean) * rstd * g1.y + b1.y; vv[j][6] = (bflo(wv.w) - mean) * rstd * g1.z + b1.z; vv[j][7] = (bfhi(wv.w) - mean) * rstd * g1.w + b1.w; }
#pragma unroll
            for (int dd = 0; dd < 8; ++dd) { u32x4 o; o.x = cvt_pk_bf16(vv[0][dd], vv[1][dd]); o.y = cvt_pk_bf16(vv[2][dd], vv[3][dd]); o.z = cvt_pk_bf16(vv[4][dd], vv[5][dd]); o.w = cvt_pk_bf16(vv[6][dd], vv[7][dd]);
                *(LAS u32x4*)(Vt + (8 * dq + dd) * GM_VS + 8 * so) = o; } }
        __syncthreads();
        f32x4 acc[4][4];
#pragma unroll
        for (int a = 0; a < 4; ++a)
#pragma unroll
            for (int b = 0; b < 4; ++b) acc[a][b] = (f32x4){0.f, 0.f, 0.f, 0.f};
        const int nks = wr ? 4 : 2;
        for (int ks = 0; ks < nks; ++ks) {
            bf16x8 wf[4], vf[4];
#pragma unroll
            for (int mt = 0; mt < 4; ++mt) wf[mt] = *(const LAS bf16x8*)(Ws + (64 * wr + 16 * mt + fr) * GM_WS + 32 * ks + 8 * fq);
#pragma unroll
            for (int nt = 0; nt < 4; ++nt) vf[nt] = *(const LAS bf16x8*)(Vt + (64 * wc + 16 * nt + fr) * GM_VS + 32 * ks + 8 * fq);
#pragma unroll
            for (int mt = 0; mt < 4; ++mt)
#pragma unroll
                for (int nt = 0; nt < 4; ++nt) acc[mt][nt] = __builtin_amdgcn_mfma_f32_16x16x32_bf16(vf[nt], wf[mt], acc[mt][nt], 0, 0, 0);
        }
#pragma unroll
        for (int mt = 0; mt < 4; ++mt) { const int tl = 64 * wr + 16 * mt + fr; const float bias = bs[g * 128 + tl]; const size_t r = rowbase + tl;
#pragma unroll
            for (int nt = 0; nt < 4; ++nt) { const int col = 256 * g + 64 * wc + 16 * nt + 4 * fq; const u32x2 uu = *(const u32x2*)(uv + r * 4096 + col);
                const f32x4 sv = acc[mt][nt] + bias;
                u32x2 o; o.x = cvt_pk_bf16(bflo(uu.x) * sv.x, bfhi(uu.x) * sv.y); o.y = cvt_pk_bf16(bflo(uu.y) * sv.z, bfhi(uu.y) * sv.w);
                *(u32x2*)(gated + r * 2048 + col) = o; } }
        __syncthreads();
    }
}
constexpr int PB_LD = 3584, PB_QI = 3072, PB_KI = 3328, PB_WI = 3392;
__device__ __forceinline__ unsigned sortable(float s) { const unsigned b = __float_as_uint(s + 0.0f); return b ^ ((b >> 31) ? 0xffffffffu : 0x80000000u); }
template <int NJ>
__device__ __forceinline__ void dsa_select(const LAS unsigned* sc, int t, int lane, u64* mrow) {
    unsigned key[NJ];
#pragma unroll
    for (int j = 0; j < NJ; ++j) { const int s = 64 * j + lane; key[j] = (s <= t) ? sc[s] : 0u; }
    unsigned T = 0u; int need = 0;
    if (t >= 256) {
        for (int bit = 31; bit >= 0; --bit) {
            const unsigned cand = T | (1u << bit); int c = 0;
#pragma unroll
            for (int j = 0; j < NJ; ++j) c += __builtin_popcountll(__ballot(key[j] >= cand));
            if (c >= 256) T = cand;
        }
        int ngt = 0;
#pragma unroll
        for (int j = 0; j < NJ; ++j) ngt += __builtin_popcountll(__ballot(key[j] > T));
        need = 256 - ngt;
    }
    int running = 0;
#pragma unroll
    for (int j = 0; j < NJ; ++j) {
        const bool adm = (64 * j + lane) <= t;
        const bool gt = key[j] > T, eq = (key[j] == T);
        const u64 eqm = __ballot(eq && adm);
        const int rank = running + __builtin_popcountll(eqm & ((1ull << lane) - 1ull));
        const bool sel = adm && (gt || (t < 256) || (eq && rank < need));
        const u64 word = __ballot(sel);
        running += __builtin_popcountll(eqm);
        if (lane == 0) mrow[j] = word;
    }
    if (lane == 0) {
#pragma unroll
        for (int j = NJ; j < 32; ++j) mrow[j] = 0ull;
    }
}
__device__ __forceinline__ void dsa_topk_phase(const Frame& F, const bf16* proj, u64* mask) {
    LAS unsigned* SC = (LAS unsigned*)F.lds;
    const int lane = F.lane, w = F.wave, fr = lane & 15, fq = lane >> 4;
    for (int it = 0; it < 1024 / 256 + 1; ++it) {
        const int idx = it * F.G + F.bid; if (idx >= 1024) break;
        const int b = idx >> 7, tq0 = idx & 127; const int tq = ((idx >> 8) & 1) ? 127 - tq0 : tq0;
        const int t0 = 16 * tq; const size_t rb = (size_t)b * SEQ;
        bf16x8 qf[4][2]; float wq[4];
        { const bf16* qp = proj + (rb + t0 + fr) * PB_LD;
#pragma unroll
            for (int h = 0; h < 4; ++h) {
#pragma unroll
                for (int ks = 0; ks < 2; ++ks) qf[h][ks] = *(const bf16x8*)(qp + PB_QI + 64 * h + 32 * ks + 8 * fq);
                wq[h] = bf2f(qp[PB_WI + h]); } }
        for (int kt = w; kt <= tq; kt += NWAVES) {
            const bf16* kp = proj + (rb + 16 * kt + fr) * PB_LD + PB_KI + 8 * fq;
            const bf16x8 kf0 = *(const bf16x8*)kp, kf1 = *(const bf16x8*)(kp + 32);
            f32x4 sc = (f32x4){0.f, 0.f, 0.f, 0.f};
#pragma unroll
            for (int h = 0; h < 4; ++h) { f32x4 d = (f32x4){0.f, 0.f, 0.f, 0.f};
                d = __builtin_amdgcn_mfma_f32_16x16x32_bf16(kf0, qf[h][0], d, 0, 0, 0); d = __builtin_amdgcn_mfma_f32_16x16x32_bf16(kf1, qf[h][1], d, 0, 0, 0);
                sc.x += wq[h] * fmaxf(d.x, 0.f); sc.y += wq[h] * fmaxf(d.y, 0.f); sc.z += wq[h] * fmaxf(d.z, 0.f); sc.w += wq[h] * fmaxf(d.w, 0.f); }
            u32x4 o; o.x = sortable(sc.x); o.y = sortable(sc.y); o.z = sortable(sc.z); o.w = sortable(sc.w);
            *(LAS u32x4*)(SC + fr * 2048 + 16 * kt + 4 * fq) = o;
        }
        __syncthreads();
        for (int qq = 0; qq < 2; ++qq) {
            const int ql = 2 * w + qq, t = t0 + ql;
            u64* mrow = mask + (rb + t) * 32;
            const int nj8 = (t >> 9) + 1;
            if (nj8 == 1) dsa_select<8>(SC + ql * 2048, t, lane, mrow);
            else if (nj8 == 2) dsa_select<16>(SC + ql * 2048, t, lane, mrow);
            else if (nj8 == 3) dsa_select<24>(SC + ql * 2048, t, lane, mrow);
            else dsa_select<32>(SC + ql * 2048, t, lane, mrow);
        }
        __syncthreads();
    }
}
template <int DK> struct AttnCfg { static constexpr int KP = DK + 8, VP = 96  , KBYTES = 64 * KP * 2, VBYTES = 64 * VP * 2, BUF = KBYTES + VBYTES; };
struct AttnArgs { const bf16* Q; int ldq, qoff;
                  const bf16* K1; int ldk1, k1off, k1hs;
                  const bf16* K2; int ldk2;
                  const bf16* V; int ldv, voff, vhs;
                  bf16* O;
                  const u64* mask;
                  const float* ang; };
__device__ __forceinline__ int crow(int r, int hi) { return (r & 3) + 8 * (r >> 2) + 4 * hi; }
template <int DK, bool MASKED>
__device__ __forceinline__ void attn_unit(const Frame& F, const AttnArgs& A, int b, int h, int qb) {
    typedef AttnCfg<DK> C;
    const int tid = F.tid, lane = F.lane, w = F.wave, r32 = lane & 31, hi = lane >> 5;
    const size_t rb = (size_t)b * SEQ; const int q0 = qb * 256, qrow = q0 + 32 * w + r32;
    const int NT = (q0 + 256) / 64;
    constexpr int NKS = DK / 16;
    bf16x8 qf[NKS];
    { const bf16* qp = A.Q + (rb + qrow) * A.ldq + A.qoff + h * DK + 8 * hi;
#pragma unroll
        for (int ks = 0; ks < NKS; ++ks) qf[ks] = *(const bf16x8*)(qp + 16 * ks); }
    if constexpr (DK == 96) {
        const float* ap = A.ang + (rb + qrow) * 32 + 16 * hi;
        const u32x4 w1 = __builtin_bit_cast(u32x4, qf[4]), w2 = __builtin_bit_cast(u32x4, qf[5]); u32x4 o1, o2;
#pragma unroll
        for (int e = 0; e < 4; ++e) { const f32x4 cs = *(const f32x4*)(ap + 4 * e);
            const float a0 = bflo(w1[e]), a1 = bfhi(w1[e]), b0 = bflo(w2[e]), b1 = bfhi(w2[e]);
            o1[e] = cvt_pk_bf16(a0 * cs.x - b0 * cs.y, a1 * cs.z - b1 * cs.w); o2[e] = cvt_pk_bf16(b0 * cs.x + a0 * cs.y, b1 * cs.z + a1 * cs.w); }
        qf[4] = __builtin_bit_cast(bf16x8, o1); qf[5] = __builtin_bit_cast(bf16x8, o2);
    }
    const int skey = tid >> 3, sch = tid & 7;
    const int skey2 = (tid + 512) / 12, sch2 = (tid + 512) % 12;
    const int skey1 = (DK == 96) ? tid / 12 : skey, sch1 = (DK == 96) ? tid % 12 : sch;
    u32x4 kreg0, kreg1 = (u32x4){0u, 0u, 0u, 0u}, vreg; u64 mw = 0ull;
#define ATT_LOAD_TILE(kt_) do { const size_t kr = rb + 64 * (kt_); \
        if (DK == 64) { kreg0 = *(const u32x4*)(A.K1 + (kr + skey) * A.ldk1 + A.k1off + h * A.k1hs + 8 * sch); } \
        else { \
            kreg0 = (sch1 < 8) ? *(const u32x4*)(A.K1 + (kr + skey1) * A.ldk1 + A.k1off + h * A.k1hs + 8 * sch1) : *(const u32x4*)(A.K2 + (kr + skey1) * A.ldk2 + 8 * (sch1 - 8)); \
            if (tid < 256) kreg1 = (sch2 < 8) ? *(const u32x4*)(A.K1 + (kr + skey2) * A.ldk1 + A.k1off + h * A.k1hs + 8 * sch2) : *(const u32x4*)(A.K2 + (kr + skey2) * A.ldk2 + 8 * (sch2 - 8)); \
        } \
        vreg = *(const u32x4*)(A.V + (kr + skey) * A.ldv + A.voff + h * A.vhs + 8 * sch); \
        if (MASKED) mw = A.mask[(rb + qrow) * 32 + (kt_)]; } while (0)
#define ATT_STORE_TILE(buf_) do { LAS unsigned char* base = F.lds + (buf_) * C::BUF; \
        *(LAS u32x4*)(base + (skey1 * C::KP + 8 * sch1) * 2) = kreg0; \
        if (DK == 96) { if (tid < 256) *(LAS u32x4*)(base + (skey2 * C::KP + 8 * sch2) * 2) = kreg1; } \
        *(LAS u32x4*)(base + C::KBYTES + (skey * C::VP + 8 * sch) * 2) = vreg; } while (0)
    float m_run = -1.0e30f, l_run = 0.f; f32x16 o0 = {}, o1 = {};
    ATT_LOAD_TILE(0); u64 mcur = mw; ATT_STORE_TILE(0); __syncthreads();
    const int wq_max = q0 + 32 * w + 31, wq_min = q0 + 32 * w;
    for (int kt = 0; kt < NT; ++kt) {
        if (kt + 1 < NT) ATT_LOAD_TILE(kt + 1);
        if (64 * kt <= wq_max) {
            const LAS unsigned char* kb = F.lds + (kt & 1) * C::BUF; const LAS unsigned char* vb = kb + C::KBYTES;
            const float NEG = -1.0e30f;
            f32x16 p0 = {}, p1 = {};
            if (MASKED) { const int nlo = (int)~((unsigned)mcur >> (4 * hi)), nhh = (int)~((unsigned)(mcur >> 32) >> (4 * hi));
#pragma unroll
                for (int r = 0; r < 16; ++r) { const unsigned bitp = (r & 3) + 8 * (r >> 2);
                    p0[r] = __int_as_float(__builtin_amdgcn_sbfe(nlo, bitp, 1u) & (int)0xF149F2CA); p1[r] = __int_as_float(__builtin_amdgcn_sbfe(nhh, bitp, 1u) & (int)0xF149F2CA); }
            } else if (64 * kt + 63 > wq_min) {
#pragma unroll
                for (int r = 0; r < 16; ++r) { const int kv = 64 * kt + crow(r, hi); p0[r] = (kv <= qrow) ? 0.f : NEG; p1[r] = (kv + 32 <= qrow) ? 0.f : NEG; }
            }
#pragma unroll
            for (int ks = 0; ks < NKS; ++ks) {
                const bf16x8 a0 = *(const LAS bf16x8*)(kb + (r32 * C::KP + 16 * ks + 8 * hi) * 2), a1 = *(const LAS bf16x8*)(kb + ((32 + r32) * C::KP + 16 * ks + 8 * hi) * 2);
                p0 = __builtin_amdgcn_mfma_f32_32x32x16_bf16(a0, qf[ks], p0, 0, 0, 0); p1 = __builtin_amdgcn_mfma_f32_32x32x16_bf16(a1, qf[ks], p1, 0, 0, 0);
            }
            f32x16 pm = __builtin_elementwise_max(p0, p1);
            float mx = fmaxf(fmaxf(fmaxf(pm[0], pm[1]), fmaxf(pm[2], pm[3])), fmaxf(fmaxf(pm[4], pm[5]), fmaxf(pm[6], pm[7])));
            mx = fmaxf(mx, fmaxf(fmaxf(fmaxf(pm[8], pm[9]), fmaxf(pm[10], pm[11])), fmaxf(fmaxf(pm[12], pm[13]), fmaxf(pm[14], pm[15]))));
            { auto rr = __builtin_amdgcn_permlane32_swap(__float_as_uint(mx), __float_as_uint(mx), false, false); mx = fmaxf(__uint_as_float(rr[0]), __uint_as_float(rr[1])); }
            const float m_new = fmaxf(m_run, mx);
            if (__any(m_new != m_run)) { const float alpha = fast_exp2(m_run - m_new); l_run *= alpha; o0 = o0 * alpha; o1 = o1 * alpha; }
            m_run = m_new;
            p0 = p0 - m_new; p1 = p1 - m_new;
#pragma unroll
            for (int r = 0; r < 16; ++r) { p0[r] = fast_exp2(p0[r]); p1[r] = fast_exp2(p1[r]); }
            { const f32x16 ps = p0 + p1; l_run += ((ps[0] + ps[1]) + (ps[2] + ps[3])) + ((ps[4] + ps[5]) + (ps[6] + ps[7])) + (((ps[8] + ps[9]) + (ps[10] + ps[11])) + ((ps[12] + ps[13]) + (ps[14] + ps[15]))); }
            bf16x8 pk[4];
#pragma unroll
            for (int s = 0; s < 2; ++s) {
                u32x4 a; a.x = cvt_pk_bf16(p0[8 * s + 0], p0[8 * s + 1]); a.y = cvt_pk_bf16(p0[8 * s + 2], p0[8 * s + 3]); a.z = cvt_pk_bf16(p0[8 * s + 4], p0[8 * s + 5]); a.w = cvt_pk_bf16(p0[8 * s + 6], p0[8 * s + 7]);
                u32x4 c; c.x = cvt_pk_bf16(p1[8 * s + 0], p1[8 * s + 1]); c.y = cvt_pk_bf16(p1[8 * s + 2], p1[8 * s + 3]); c.z = cvt_pk_bf16(p1[8 * s + 4], p1[8 * s + 5]); c.w = cvt_pk_bf16(p1[8 * s + 6], p1[8 * s + 7]);
                pk[s] = __builtin_bit_cast(bf16x8, a); pk[2 + s] = __builtin_bit_cast(bf16x8, c); }
            const int gi = (lane >> 4) & 1, q4 = (lane & 15) >> 2, p4 = lane & 3;
            const LAS unsigned char* vlane = vb + ((4 * hi + q4) * C::VP + 16 * gi + 4 * p4) * 2;
#pragma unroll
            for (int s4 = 0; s4 < 4; ++s4) {
#pragma unroll
                for (int db = 0; db < 2; ++db) {
                    const s16x4 lo4 = __builtin_bit_cast(s16x4, __builtin_amdgcn_ds_read_tr16_b64_v4i16((LAS s16x4*)(vlane + ((16 * s4) * C::VP + 32 * db) * 2)));
                    const s16x4 hi4 = __builtin_bit_cast(s16x4, __builtin_amdgcn_ds_read_tr16_b64_v4i16((LAS s16x4*)(vlane + ((16 * s4 + 8) * C::VP + 32 * db) * 2)));
                    const bf16x8 vf = (bf16x8){lo4[0], lo4[1], lo4[2], lo4[3], hi4[0], hi4[1], hi4[2], hi4[3]};
                    if (db == 0) o0 = __builtin_amdgcn_mfma_f32_32x32x16_bf16(vf, pk[s4], o0, 0, 0, 0); else o1 = __builtin_amdgcn_mfma_f32_32x32x16_bf16(vf, pk[s4], o1, 0, 0, 0);
                }
            }
        }
        if (kt + 1 < NT) { ATT_STORE_TILE((kt + 1) & 1); mcur = mw; }
        __syncthreads();
    }
    { auto rr = __builtin_amdgcn_permlane32_swap(__float_as_uint(l_run), __float_as_uint(l_run), false, false); l_run = __uint_as_float(rr[0]) + __uint_as_float(rr[1]); }
    const float inv = 1.0f / l_run;
    bf16* op = A.O + (rb + qrow) * D + h * 64 + 4 * hi;
#pragma unroll
    for (int g4 = 0; g4 < 4; ++g4) {
        u32x2 a; a.x = cvt_pk_bf16(o0[4 * g4 + 0] * inv, o0[4 * g4 + 1] * inv); a.y = cvt_pk_bf16(o0[4 * g4 + 2] * inv, o0[4 * g4 + 3] * inv);
        u32x2 c; c.x = cvt_pk_bf16(o1[4 * g4 + 0] * inv, o1[4 * g4 + 1] * inv); c.y = cvt_pk_bf16(o1[4 * g4 + 2] * inv, o1[4 * g4 + 3] * inv);
        *(u32x2*)(op + 8 * g4) = a; *(u32x2*)(op + 32 + 8 * g4) = c;
    }
}
#undef ATT_LOAD_TILE
#undef ATT_STORE_TILE
template <int DK, bool MASKED>
__device__ __forceinline__ void attn_phase(const Frame& F, const AttnArgs& A) {
    for (int i = 0; i < 4; ++i) {
        const int u = i * F.G + F.bid; if (u >= 1024) break;
        const int bh = u >> 3, qp = u & 7, qb = ((u >> 8) & 1) ? 7 - qp : qp;
        attn_unit<DK, MASKED>(F, A, bh >> 4, bh & 15, qb);
    }
}
constexpr int HG_QS = 136, HG_HS = 72, HG_VS = 72, HG_SS = 136;
constexpr int HG_QT = 0, HG_KT = HG_QT + 64 * HG_QS * 2, HG_KH = HG_KT + 64 * HG_QS * 2, HG_VT = HG_KH + 128 * HG_HS * 2, HG_SB = HG_VT + 32 * HG_VS * 2,
              HG_GL = HG_SB + 2 * 32 * HG_SS * 2, HG_SEG = HG_GL + 512, HG_END = HG_SEG + 4 * 128 * 4;
static_assert(HG_END <= RING_BYTES, "hgrn2 LDS");
__device__ __forceinline__ void hgrn2_scan_phase(const Frame& F, const bf16* proj, const float* lb_logits  , float* opre  ) {
    LAS bf16* Qt = (LAS bf16*)(F.lds + HG_QT); LAS bf16* Kt = (LAS bf16*)(F.lds + HG_KT); LAS bf16* Kh = (LAS bf16*)(F.lds + HG_KH); LAS bf16* Vt = (LAS bf16*)(F.lds + HG_VT);
    LAS bf16* Sb = (LAS bf16*)(F.lds + HG_SB); LAS float* GL = (LAS float*)(F.lds + HG_GL); LAS float* SEG = (LAS float*)(F.lds + HG_SEG);
    const int tid = F.tid, lane = F.lane, w = F.wave, fr = lane & 15, fq = lane >> 4;
    for (int u = F.bid; u < 256; u += F.G) {
        const int b = u >> 5, h = (u >> 2) & 7, vq = u & 3;
        const size_t rb = (size_t)b * SEQ;
        const int k = tid & 127, tseg = tid >> 7;
        float lbv; { const int c = 128 * h + k; const float a0 = lb_logits[c], a1 = lb_logits[1024 + c], a2 = lb_logits[2048 + c], a3 = lb_logits[3072 + c];
            const float mx = fmaxf(fmaxf(a0, a1), fmaxf(a2, a3)); const float e0 = __expf(a0 - mx), e1 = __expf(a1 - mx), e2 = __expf(a2 - mx), e3 = __expf(a3 - mx);
            lbv = (e1 + e2) / (e0 + e1 + e2 + e3); }
        f32x4 sacc[2]; sacc[0] = (f32x4){0.f, 0.f, 0.f, 0.f}; sacc[1] = sacc[0];
        for (int i = tid; i < 2 * 32 * HG_SS / 2; i += NTHREADS) ((LAS unsigned*)Sb)[i] = 0u;
        const int vt = w & 1, tt = w >> 1;
        unsigned short rq[16], rf[16], rv[8];
#define HG_FETCH(cc) do { const size_t r0_ = rb + 64 * (cc); const bf16* pp_ = proj + (r0_ + 16 * tseg) * 4096 + 128 * h + k; \
            _Pragma("unroll") for (int j = 0; j < 16; ++j) { rq[j] = pp_[(size_t)j * 4096]; rf[j] = pp_[(size_t)j * 4096 + 1024]; } \
            if (tid < 256) { const bf16* vp_ = proj + (r0_ + 8 * (tid & 7)) * 4096 + 2048 + 128 * h + 32 * vq + (tid >> 3); \
                _Pragma("unroll") for (int j = 0; j < 8; ++j) rv[j] = vp_[(size_t)j * 4096]; } } while (0)
        HG_FETCH(0);
        for (int c = 0; c < 32; ++c) {
            const size_t r0 = rb + 64 * c;
            float gl[16], kk[16], qv[16];
            { float run = 0.f;
#pragma unroll
                for (int j = 0; j < 16; ++j) { const float fp = bf2f(rf[j]); qv[j] = bf2f(rq[j]);
                    const float sg = sigmoidf_(fp); const float f = lbv + (1.f - lbv) * sg; kk[j] = (1.f - lbv) * (1.f - sg); run += __logf(f); gl[j] = run; }
                SEG[tseg * 128 + k] = run; }
            if (tid < 256) { const int so = tid & 7, v = tid >> 3;
                u32x4 o; o.x = (unsigned)rv[0] | ((unsigned)rv[1] << 16); o.y = (unsigned)rv[2] | ((unsigned)rv[3] << 16);
                o.z = (unsigned)rv[4] | ((unsigned)rv[5] << 16); o.w = (unsigned)rv[6] | ((unsigned)rv[7] << 16);
                *(LAS u32x4*)(Vt + v * HG_VS + 8 * so) = o; }
            if (c + 1 < 32) HG_FETCH(c + 1);
            LDS_BARRIER();
            { float off = 0.f, tot = 0.f;
#pragma unroll
                for (int s = 0; s < 4; ++s) { const float sv = SEG[s * 128 + k]; off += (s < tseg) ? sv : 0.f; tot += sv; }
                if (tseg == 0) GL[k] = tot;
                unsigned kh[8];
#pragma unroll
                for (int j = 0; j < 16; ++j) { const float G = off + gl[j]; const float eg = __expf(G);
                    const float qs = qv[j] * eg, ks = kk[j] * __expf(-G), khv = kk[j] * __expf(tot - G);
                    Qt[(16 * tseg + j) * HG_QS + k] = (bf16)(cvt_pk_bf16(qs, 0.f) & 0xffffu); Kt[(16 * tseg + j) * HG_QS + k] = (bf16)(cvt_pk_bf16(ks, 0.f) & 0xffffu);
                    if (j & 1) kh[j >> 1] = (kh[j >> 1] & 0xffffu) | (cvt_pk_bf16(0.f, khv) & 0xffff0000u); else kh[j >> 1] = cvt_pk_bf16(khv, 0.f) & 0xffffu; }
                *(LAS u32x4*)(Kh + k * HG_HS + 16 * tseg) = (u32x4){kh[0], kh[1], kh[2], kh[3]}; *(LAS u32x4*)(Kh + k * HG_HS + 16 * tseg + 8) = (u32x4){kh[4], kh[5], kh[6], kh[7]}; }
            LDS_BARRIER();
            const LAS bf16* Sbc = Sb + (c & 1) * 32 * HG_SS; LAS bf16* Sbn = Sb + ((c + 1) & 1) * 32 * HG_SS;
            bf16x8 bq[4];
#pragma unroll
            for (int ks = 0; ks < 4; ++ks) bq[ks] = *(const LAS bf16x8*)(Qt + (16 * tt + fr) * HG_QS + 32 * ks + 8 * fq);
            f32x4 sc[4];
#pragma unroll
            for (int st = 0; st < 4; ++st) { sc[st] = (f32x4){0.f, 0.f, 0.f, 0.f};
                if (st <= tt) {
#pragma unroll
                    for (int ks = 0; ks < 4; ++ks) { const bf16x8 ka = *(const LAS bf16x8*)(Kt + (16 * st + fr) * HG_QS + 32 * ks + 8 * fq); sc[st] = __builtin_amdgcn_mfma_f32_16x16x32_bf16(ka, bq[ks], sc[st], 0, 0, 0); }
                    if (st == tt) {
#pragma unroll
                        for (int i = 0; i < 4; ++i) if (4 * fq + i > fr) sc[st][i] = 0.f; } } }
            f32x4 oacc = (f32x4){0.f, 0.f, 0.f, 0.f};
#pragma unroll
            for (int m = 0; m < 2; ++m) {
                u32x4 pw; pw.x = cvt_pk_bf16(sc[2 * m][0], sc[2 * m][1]); pw.y = cvt_pk_bf16(sc[2 * m][2], sc[2 * m][3]); pw.z = cvt_pk_bf16(sc[2 * m + 1][0], sc[2 * m + 1][1]); pw.w = cvt_pk_bf16(sc[2 * m + 1][2], sc[2 * m + 1][3]);
                const LAS bf16* vp = Vt + (16 * vt + fr) * HG_VS + 32 * m + 4 * fq;
                const u32x2 va = *(const LAS u32x2*)vp, vb = *(const LAS u32x2*)(vp + 16);
                const bf16x8 vf = __builtin_bit_cast(bf16x8, (u32x4){va.x, va.y, vb.x, vb.y});
                oacc = __builtin_amdgcn_mfma_f32_16x16x32_bf16(vf, __builtin_bit_cast(bf16x8, pw), oacc, 0, 0, 0);
            }
#pragma unroll
            for (int ks = 0; ks < 4; ++ks) { const bf16x8 sa = *(const LAS bf16x8*)(Sbc + (16 * vt + fr) * HG_SS + 32 * ks + 8 * fq); oacc = __builtin_amdgcn_mfma_f32_16x16x32_bf16(sa, bq[ks], oacc, 0, 0, 0); }
            *(f32x4*)(opre + (r0 + 16 * tt + fr) * D + 128 * h + 32 * vq + 16 * vt + 4 * fq) = oacc;
#pragma unroll
            for (int x = 0; x < 2; ++x) { const int kt = tt + 4 * x;
                const f32x4 dec = *(const LAS f32x4*)(GL + 16 * kt + 4 * fq);
                f32x4 a = sacc[x]; a.x *= __expf(dec.x); a.y *= __expf(dec.y); a.z *= __expf(dec.z); a.w *= __expf(dec.w);
#pragma unroll
                for (int m = 0; m < 2; ++m) { const bf16x8 ka = *(const LAS bf16x8*)(Kh + (16 * kt + fr) * HG_HS + 32 * m + 8 * fq), vbf = *(const LAS bf16x8*)(Vt + (16 * vt + fr) * HG_VS + 32 * m + 8 * fq);
                    a = __builtin_amdgcn_mfma_f32_16x16x32_bf16(ka, vbf, a, 0, 0, 0); }
                sacc[x] = a;
                u32x2 o; o.x = cvt_pk_bf16(a.x, a.y); o.y = cvt_pk_bf16(a.z, a.w);
                *(LAS u32x2*)(Sbn + (16 * vt + fr) * HG_SS + 16 * kt + 4 * fq) = o; }
            LDS_BARRIER();
        }
#undef HG_FETCH
    }
}
__device__ __forceinline__ void hgrn2_norm_phase(const Frame& F, const float* opre, const bf16* proj, const float* ng, bf16* ob) {
    const int gw = F.bid * NWAVES + F.wave, NGW = F.G * NWAVES, lane = F.lane;
    for (int r = gw; r < M; r += NGW) {
#pragma unroll
        for (int j = 0; j < 4; ++j) { const int col = 4 * lane + 256 * j; const f32x4 v = *(const f32x4*)(opre + (size_t)r * D + col);
            float ss = (v.x * v.x + v.y * v.y) + (v.z * v.z + v.w * v.w);
            ss = half_sum32(ss, lane);
            const float rs = __builtin_amdgcn_rsqf(ss * (1.f / 128.f) + RMS_EPS);
            const f32x4 g4 = *(const f32x4*)(ng + (col & 127)); const u32x2 gt = *(const u32x2*)(proj + (size_t)r * 4096 + 3072 + col);
            u32x2 o; o.x = cvt_pk_bf16(v.x * rs * g4.x * siluf_(bflo(gt.x)), v.y * rs * g4.y * siluf_(bfhi(gt.x))); o.y = cvt_pk_bf16(v.z * rs * g4.z * siluf_(bflo(gt.y)), v.w * rs * g4.w * siluf_(bfhi(gt.y)));
            *(u32x2*)(ob + (size_t)r * D + col) = o; }
    }
}
__device__ __forceinline__ void mla_norm_phase(const Frame& F, const float* projd, const int* positions, const float* qg, const float* kvg, bf16* cq, bf16* ckv, bf16* kr, float* ang) {
    const int gw = F.bid * NWAVES + F.wave, NGW = F.G * NWAVES, lane = F.lane;
    for (int r = gw; r < M; r += NGW) {
        const f32x4 a = *(const f32x4*)(projd + (size_t)r * 512 + 8 * lane), c = *(const f32x4*)(projd + (size_t)r * 512 + 8 * lane + 4);
        float x[8] = {a.x, a.y, a.z, a.w, c.x, c.y, c.z, c.w};
        float ss = 0.f;
#pragma unroll
        for (int i = 0; i < 8; ++i) ss += x[i] * x[i];
        const float s16 = row_sum16(ss);
        const float s32 = rdlane(s16, 0) + rdlane(s16, 16);
        float px[8];
#pragma unroll
        for (int i = 0; i < 8; ++i) px[i] = dppmov<0x4E>(x[i]);
        if (lane < 32) {
            const float rs = __builtin_amdgcn_rsqf(s32 * (1.f / 256.f) + RMS_EPS);
            const f32x4 g0 = *(const f32x4*)(qg + 8 * lane), g1 = *(const f32x4*)(qg + 8 * lane + 4);
            u32x4 o; o.x = cvt_pk_bf16(x[0] * rs * g0.x, x[1] * rs * g0.y); o.y = cvt_pk_bf16(x[2] * rs * g0.z, x[3] * rs * g0.w); o.z = cvt_pk_bf16(x[4] * rs * g1.x, x[5] * rs * g1.y); o.w = cvt_pk_bf16(x[6] * rs * g1.z, x[7] * rs * g1.w);
            *(u32x4*)(cq + (size_t)r * 256 + 8 * lane) = o;
        } else if (lane < 48) {
            const int l2 = lane - 32; const float rs = __builtin_amdgcn_rsqf(s16 * (1.f / 128.f) + RMS_EPS);
            const f32x4 g0 = *(const f32x4*)(kvg + 8 * l2), g1 = *(const f32x4*)(kvg + 8 * l2 + 4);
            u32x4 o; o.x = cvt_pk_bf16(x[0] * rs * g0.x, x[1] * rs * g0.y); o.y = cvt_pk_bf16(x[2] * rs * g0.z, x[3] * rs * g0.w); o.z = cvt_pk_bf16(x[4] * rs * g1.x, x[5] * rs * g1.y); o.w = cvt_pk_bf16(x[6] * rs * g1.z, x[7] * rs * g1.w);
            *(u32x4*)(ckv + (size_t)r * 256 + 8 * l2) = o;
        } else {
            *(u32x4*)(ckv + (size_t)r * 256 + 128 + 8 * (lane - 48)) = (u32x4){0u, 0u, 0u, 0u};
            if (lane < 52) {
                const int l3 = lane - 48, i0 = 8 * (l3 & 1); const bool second = l3 >= 2; const float pos = (float)positions[r];
                float outv[8];
#pragma unroll
                for (int i = 0; i < 8; ++i) { const float invf = fast_exp2(-(float)(i0 + i) * (13.287712379549449f / 16.f)); const float an = pos * invf; float rev = an * 0.15915494309189535f; rev = rev - floorf(rev); const float cs = __builtin_amdgcn_cosf(rev), sn = __builtin_amdgcn_sinf(rev);
                    outv[i] = second ? (x[i] * cs + px[i] * sn) : (x[i] * cs - px[i] * sn);
                    if (!second) { ang[(size_t)r * 32 + 2 * (i0 + i)] = cs; ang[(size_t)r * 32 + 2 * (i0 + i) + 1] = sn; } }
                u32x4 o; o.x = cvt_pk_bf16(outv[0], outv[1]); o.y = cvt_pk_bf16(outv[2], outv[3]); o.z = cvt_pk_bf16(outv[4], outv[5]); o.w = cvt_pk_bf16(outv[6], outv[7]);
                *(u32x4*)(kr + (size_t)r * 32 + 8 * l3) = o;
            }
        }
    }
}
__device__ __forceinline__ void mla_qrope_phase(const Frame& F, bf16* q, const float* ang) {
    const int gw = F.bid * NWAVES + F.wave, NGW = F.G * NWAVES, lane = F.lane;
    const int hh = lane >> 2, part = lane & 3, i0 = 8 * (part & 1); const bool second = part >= 2;
    for (int r = gw; r < M; r += NGW) {
        bf16* p = q + (size_t)r * 1536 + 96 * hh + 64 + 8 * part;
        const u32x4 wv = *(const u32x4*)p;
        float x[8] = {bflo(wv.x), bfhi(wv.x), bflo(wv.y), bfhi(wv.y), bflo(wv.z), bfhi(wv.z), bflo(wv.w), bfhi(wv.w)};
        float outv[8];
#pragma unroll
        for (int i = 0; i < 8; ++i) { const float px = __shfl_xor(x[i], 2); const f32x2 cssn = *(const f32x2*)(ang + (size_t)r * 32 + 2 * (i0 + i));
            outv[i] = second ? (x[i] * cssn.x + px * cssn.y) : (x[i] * cssn.x - px * cssn.y); }
        u32x4 o; o.x = cvt_pk_bf16(outv[0], outv[1]); o.y = cvt_pk_bf16(outv[2], outv[3]); o.z = cvt_pk_bf16(outv[4], outv[5]); o.w = cvt_pk_bf16(outv[6], outv[7]);
        *(u32x4*)p = o;
    }
}
constexpr int NPHASE = 36;
#ifndef MK_ONE_LAUNCH
#define MK_ONE_LAUNCH 1
#endif
#ifndef MK_DUP
#define MK_DUP 0ull
#endif
#ifndef MK_NRUN
#define MK_NRUN NPHASE
#endif
__device__ __forceinline__ void prologue_phase(const Frame& F, const Args& args, unsigned char* ws, bf16* XB) {
#define INP(i) ((const float*)args.in[i])

        convert_matrix(F, INP(I_A_WIN), 1024, 4096, (bf16*)(ws + W_A_IN), 1024, 4096, 0, 1);
        convert_matrix(F, INP(I_A_WOUT), 2048, 1024, (bf16*)(ws + W_A_OUT), 2048, 1024, 0, 1);
        convert_matrix(F, INP(I_B_WIN), 1024, 3396, (bf16*)(ws + W_B_IN), 1024, 3584, 0, 1);
        convert_matrix(F, INP(I_B_WOUT), 1024, 1024, (bf16*)(ws + W_B_OUT), 1024, 1024, 0, 1);
        convert_matrix(F, INP(I_C_WIN), 1024, 4096, (bf16*)(ws + W_C_IN), 1024, 4096, 0, 1);
        convert_matrix(F, INP(I_C_WOUT), 1024, 1024, (bf16*)(ws + W_C_OUT), 1024, 1024, 0, 1);
        convert_matrix(F, INP(I_D_WIN), 1024, 416, (bf16*)(ws + W_D_IN), 1024, 512, 0, 1);
        convert_matrix(F, INP(I_D_WUQ), 256, 1536, (bf16*)(ws + W_D_UQ), 256, 1536, 0, 1);
        convert_matrix(F, INP(I_D_WUKV), 128, 2048, (bf16*)(ws + W_D_UKV), 256, 2048, 0, 1);
        convert_matrix(F, INP(I_D_WOUT), 1024, 1024, (bf16*)(ws + W_D_OUT), 1024, 1024, 0, 1);
        convert_matrix(F, INP(I_F0_GU), 1024, 2 * FF, (bf16*)(ws + W_F0_GU), 1024, 2 * FF, 1, 1);
        convert_matrix(F, INP(I_F0_DN), FF, 1024, (bf16*)(ws + W_F0_DN), FF, 1024, 0, 1);
        convert_matrix(F, INP(I_F2_GU), 1024, 2 * FF, (bf16*)(ws + W_F2_GU), 1024, 2 * FF, 1, 1);
        convert_matrix(F, INP(I_F2_DN), FF, 1024, (bf16*)(ws + W_F2_DN), FF, 1024, 0, 1);
        convert_matrix(F, INP(I_M1_GU), 1024, 2 * FF, (bf16*)(ws + W_M1_GU), 1024, 2 * FF, 1, NE);
        convert_matrix(F, INP(I_M1_DN), FF, 1024, (bf16*)(ws + W_M1_DN), FF, 1024, 0, NE);
        convert_matrix(F, INP(I_M3_GU), 1024, 2 * FF, (bf16*)(ws + W_M3_GU), 1024, 2 * FF, 1, NE);
        convert_matrix(F, INP(I_M3_DN), FF, 1024, (bf16*)(ws + W_M3_DN), FF, 1024, 0, NE);
        cvt_rows_phase(F, INP(I_X), XB);
    #undef INP
}
__global__ void __launch_bounds__(NTHREADS, 2) fwd_kernel(Args args) {
    extern __shared__ __attribute__((aligned(16))) unsigned char lds_raw[];
    Frame F;
    F.lds = (LAS unsigned char*)lds_raw;
    F.tid = threadIdx.x; F.lane = F.tid & 63; F.wave = __builtin_amdgcn_readfirstlane(F.tid >> 6);
    F.G = gridDim.x; F.bid = blockIdx.x;
    F.ws = args.ws; F.ctl = (unsigned*)(args.ws + WS_CTL);
    unsigned char* ws = args.ws;
    const int lo = args.ph_lo, hi = args.ph_hi;
    for (int u = F.tid; u < (LDS_BYTES - LDSCTL_OFF) / 4; u += NTHREADS) ((LAS unsigned*)(F.lds + LDSCTL_OFF))[u] = 0u;
    __syncthreads();
    XcdBarrier bar; bar.bar = F.ctl + CW_BAR; bar.x = 0; bar.st = nullptr;
    const bool multi = (hi - lo) > 1;
    if (multi) bar = xcd_barrier_post(F.ctl + CW_BAR, (volatile LAS unsigned*)(F.lds + LDSCTL_OFF + 64));
#define IN(k) (lo <= (k) && (k) < hi)
#define SEAM(k) do { if (IN(k) && IN((k) + 1)) xcd_barrier(bar); } while (0)
#define DUPP(k) (((unsigned long long)(MK_DUP) >> (k)) & 1ull)
#define PHASE(k, ...) do { if (IN(k)) { __VA_ARGS__; if (DUPP(k)) { xcd_barrier(bar); __VA_ARGS__; } } SEAM(k); } while (0)
#define INP(i) ((const float*)args.in[i])
    float* XF = args.out;
    bf16* XB = (bf16*)(ws + WS_XB);
    bf16* H = (bf16*)(ws + B_H);
    bf16* OB = (bf16*)(ws + B_OB);
    bf16* XR = (bf16*)(ws + WS_R2); bf16* YK = (bf16*)(ws + WS_R2);
    LAS unsigned char* ring = F.lds;

#define GEMM(EpiT, Aptr, lda_, Bptr, Nn, Kk, epi) do { pg8::Gemm g_{(Aptr), (Bptr), M, (Nn), (Kk), (lda_), 0}; pg8::StaticOrder S_; S_.init(M, (Nn), F.G, F.bid); \
        pg8::gemm_phase<EpiT, pg8::StaticOrder>(ring, g_, S_, (epi)); } while (0)
#define FFN_DENSE(p0, WGU, WDN, lg, lb) do { \
        PHASE(p0, GEMM(pg8::EpiSwiGLU, XB, D, (const bf16*)(ws + (WGU)), 2 * FF, D, (pg8::EpiSwiGLU{H, FF}));); \
        PHASE((p0) + 1, GEMM(pg8::EpiResid, H, FF, (const bf16*)(ws + (WDN)), D, FF, (pg8::EpiResid{XB, XF, ALPHA}));); \
        PHASE((p0) + 2, ln_phase(F, XF, XB, (lg), (lb));); } while (0)
#define FFN_MOE(p0, slot_, WR, WGU, WDN, lmg, lmb, lfg, lfb, OUTF) do { \
        unsigned* cnt_ = F.ctl + CW_CNT + (slot_) * 512; \
        PHASE(p0, ln_route_phase(F, XF, XB, (lmg), (lmb), (WR), cnt_);); \
        PHASE((p0) + 1, moe_gather_phase(F, XB, XR, cnt_);); \
        PHASE((p0) + 2, int cv_[NE], ps_[NE]; pg8::MoeOrder S_; const int rows_ = moe_segments(cnt_, cv_, ps_, S_.pend); S_.so.init(rows_, 2 * FF, F.G, F.bid); \
            pg8::Gemm g_{XR, (const bf16*)(ws + (WGU)), rows_, 2 * FF, D, D, (size_t)2 * FF * D}; pg8::gemm_phase<pg8::EpiSwiGLU, pg8::MoeOrder>(ring, g_, S_, pg8::EpiSwiGLU{H, FF});); \
        PHASE((p0) + 3, int cv_[NE], ps_[NE]; pg8::MoeOrder S_; const int rows_ = moe_segments(cnt_, cv_, ps_, S_.pend); S_.so.init(rows_, D, F.G, F.bid); \
            pg8::Gemm g_{H, (const bf16*)(ws + (WDN)), rows_, D, FF, FF, (size_t)D * FF}; \
            pg8::gemm_phase<pg8::EpiMoeDown, pg8::MoeOrder>(ring, g_, S_, pg8::EpiMoeDown{YK, (const int*)(ws + S_ROWTOK), (const float*)(ws + S_ROWGATE)});); \
        PHASE((p0) + 4, ln_moe_phase(F, YK, (OUTF), XB, (lfg), (lfb));); } while (0)

    PHASE(0, prologue_phase(F, args, ws, XB););
    { bf16* UV = (bf16*)(ws + B_UV); bf16* GATED = (bf16*)(ws + B_GATED); float* STATS = (float*)(ws + S_STATS);
      PHASE(1, GEMM(pg8::EpiBf16<1>, XB, D, (const bf16*)(ws + W_A_IN), 4096, D, (pg8::EpiBf16<1>{UV, 4096, 1.f, 0})););
      PHASE(2, gmlp_stats_phase(F, UV, STATS););
      PHASE(3, gmlp_spatial_phase(F, UV, STATS, INP(I_A_WS), INP(I_A_BS), INP(I_A_LNG), INP(I_A_LNB), GATED););
      PHASE(4, GEMM(pg8::EpiResid, GATED, 2048, (const bf16*)(ws + W_A_OUT), D, 2048, (pg8::EpiResid{XB, XF, ALPHA})););
      PHASE(5, ln_phase(F, XF, XB, INP(I_LNM_G), INP(I_LNM_B));); }
    FFN_DENSE(6, W_F0_GU, W_F0_DN, INP(I_LNF_G), INP(I_LNF_B));
    { bf16* PROJ = (bf16*)(ws + B_PROJB); u64* MASK = (u64*)(ws + S_MASK);
      PHASE(9, GEMM(pg8::EpiBf16<0>, XB, D, (const bf16*)(ws + W_B_IN), 3584, D, (pg8::EpiBf16<0>{PROJ, 3584, 0.125f * 1.4426950408889634f, 4})););
      PHASE(10, dsa_topk_phase(F, PROJ, MASK););
      PHASE(11, AttnArgs A; A.Q = PROJ; A.ldq = PB_LD; A.qoff = 0; A.K1 = PROJ; A.ldk1 = PB_LD; A.k1off = 1024; A.k1hs = 64; A.K2 = nullptr; A.ldk2 = 0; A.V = PROJ; A.ldv = PB_LD; A.voff = 2048; A.vhs = 64;
          A.O = OB; A.mask = MASK; A.ang = nullptr; attn_phase<64, true>(F, A););
      PHASE(12, GEMM(pg8::EpiResid, OB, D, (const bf16*)(ws + W_B_OUT), D, D, (pg8::EpiResid{XB, XF, ALPHA}));); }
    FFN_MOE(13, 0, INP(I_M1_R), W_M1_GU, W_M1_DN, INP(I_LNM_G) + D, INP(I_LNM_B) + D, INP(I_LNF_G) + D, INP(I_LNF_B) + D, (float*)nullptr);
    { bf16* PROJ = (bf16*)(ws + B_PROJC); float* OPRE = (float*)(ws + B_OPRE);
      PHASE(18, GEMM(pg8::EpiBf16<0>, XB, D, (const bf16*)(ws + W_C_IN), 4096, D, (pg8::EpiBf16<0>{PROJ, 4096, 1.f, 0})););
      PHASE(19, hgrn2_scan_phase(F, PROJ, INP(I_C_LB), OPRE););
      PHASE(20, hgrn2_norm_phase(F, OPRE, PROJ, INP(I_C_NG), OB););
      PHASE(21, GEMM(pg8::EpiResid, OB, D, (const bf16*)(ws + W_C_OUT), D, D, (pg8::EpiResid{XB, XF, ALPHA})););
      PHASE(22, ln_phase(F, XF, XB, INP(I_LNM_G) + 2 * D, INP(I_LNM_B) + 2 * D);); }
    FFN_DENSE(23, W_F2_GU, W_F2_DN, INP(I_LNF_G) + 2 * D, INP(I_LNF_B) + 2 * D);
    { float* PROJD = (float*)(ws + B_PROJD); bf16* CQ = (bf16*)(ws + B_CQ); bf16* CKV = (bf16*)(ws + B_CKV); bf16* Q = (bf16*)(ws + B_Q); bf16* KV = (bf16*)(ws + B_KV);
      bf16* KR = (bf16*)(ws + S_KR); float* ANG = (float*)(ws + S_ANG);
      PHASE(26, GEMM(pg8::EpiF32, XB, D, (const bf16*)(ws + W_D_IN), 512, D, (pg8::EpiF32{PROJD, 512})););
      PHASE(27, mla_norm_phase(F, PROJD, (const int*)args.in[I_POS], INP(I_D_QNG), INP(I_D_KVNG), CQ, CKV, KR, ANG););
      PHASE(28, GEMM(pg8::EpiBf16<0>, CQ, 256, (const bf16*)(ws + W_D_UQ), 1536, 256, (pg8::EpiBf16<0>{Q, 1536, 0.10206207261596577f * 1.4426950408889634f, 6}));
                    GEMM(pg8::EpiBf16<0>, CKV, 256, (const bf16*)(ws + W_D_UKV), 2048, 256, (pg8::EpiBf16<0>{KV, 2048, 1.f, 0})););
      PHASE(29, AttnArgs A; A.Q = Q; A.ldq = 1536; A.qoff = 0; A.K1 = KV; A.ldk1 = 2048; A.k1off = 0; A.k1hs = 128; A.K2 = KR; A.ldk2 = 32; A.V = KV; A.ldv = 2048; A.voff = 64; A.vhs = 128;
          A.O = OB; A.mask = nullptr; A.ang = ANG; attn_phase<96, false>(F, A););
      PHASE(30, GEMM(pg8::EpiResid, OB, D, (const bf16*)(ws + W_D_OUT), D, D, (pg8::EpiResid{XB, XF, ALPHA}));); }
    FFN_MOE(31, 1, INP(I_M3_R), W_M3_GU, W_M3_DN, INP(I_LNM_G) + 3 * D, INP(I_LNM_B) + 3 * D, INP(I_LNF_G) + 3 * D, INP(I_LNF_B) + 3 * D, args.out);
#undef IN
#undef SEAM
}

extern "C" void kernel_launch(void* const* d_in, const int* in_sizes, int n_in, void* d_out, int out_size, void* d_ws, size_t ws_size, hipStream_t stream) {
    static int grid = 0;
    if (grid == 0) {
        if (n_in != 34 || out_size != M * D || ws_size < WS_END) { fprintf(stderr, "kernel_launch: unexpected problem (n_in %d, out %d, ws %zu < %zu)\n", n_in, out_size, ws_size, (size_t)WS_END); grid = -1; return; }
        int dev = 0, cus = 0;
        if (hipGetDevice(&dev) != hipSuccess || hipDeviceGetAttribute(&cus, hipDeviceAttributeMultiprocessorCount, dev) != hipSuccess) { grid = -1; return; }
        if (hipFuncSetAttribute((const void*)fwd_kernel, hipFuncAttributeMaxDynamicSharedMemorySize, LDS_BYTES) != hipSuccess) { fprintf(stderr, "kernel_launch: hipFuncSetAttribute failed\n"); grid = -1; return; }
        int per_cu = 0;
        if (hipOccupancyMaxActiveBlocksPerMultiprocessor(&per_cu, (const void*)fwd_kernel, NTHREADS, LDS_BYTES) != hipSuccess || per_cu < 1) fprintf(stderr, "kernel_launch: occupancy query reports %d\n", per_cu);
        (void)hipGetLastError();
        grid = cus;
    }
    if (grid < 0) return;
    if (hipMemsetAsync((char*)d_ws + WS_CTL, 0, CTL_ZERO_BYTES, stream) != hipSuccess) return;
    Args a{};
    for (int i = 0; i < 34; ++i) a.in[i] = d_in[i];
    a.out = (float*)d_out; a.ws = (unsigned char*)d_ws;
#if MK_ONE_LAUNCH
    a.ph_lo = 0; a.ph_hi = MK_NRUN;
    hipLaunchKernelGGL(fwd_kernel, dim3(grid), dim3(NTHREADS), LDS_BYTES, stream, a);
#else
    for (int p = 0; p < MK_NRUN; ++p) { a.ph_lo = p; a.ph_hi = p + 1; hipLaunchKernelGGL(fwd_kernel, dim3(grid), dim3(NTHREADS), LDS_BYTES, stream, a); }
#endif
}
```

```cpp
#include <hip/hip_runtime.h>
#include <cstdio>
#include <cstdint>

#define LAS __attribute__((address_space(3)))
#define GAS __attribute__((address_space(1)))
typedef unsigned short bf16;
typedef short bf16x8 __attribute__((ext_vector_type(8)));
typedef short s16x4 __attribute__((ext_vector_type(4)));
typedef float f32x2 __attribute__((ext_vector_type(2)));
typedef float f32x4 __attribute__((ext_vector_type(4)));
typedef float f32x16 __attribute__((ext_vector_type(16)));
typedef unsigned u32x2 __attribute__((ext_vector_type(2)));
typedef unsigned u32x4 __attribute__((ext_vector_type(4)));
typedef unsigned long long u64;

constexpr int NB = 8, SEQ = 2048, D = 1024, M = NB * SEQ;
constexpr int FF = 3584, NE = 8;
constexpr int MOE_ROWS = 34816;
constexpr float ALPHA = 1.6817928305074290f;
constexpr float LN_EPS = 1e-5f, RMS_EPS = 1e-6f;
constexpr int NWAVES = 8, NTHREADS = 512;

constexpr size_t MiB = 1u << 20;
constexpr size_t WS_CTL = 0, CTL_ZERO_BYTES = 1 * MiB;
constexpr size_t WS_W0 = 1 * MiB;
constexpr size_t W_A_IN = WS_W0;
constexpr size_t W_A_OUT = W_A_IN + 8 * MiB;
constexpr size_t W_B_IN = W_A_OUT + 4 * MiB;
constexpr size_t W_B_OUT = W_B_IN + 7 * MiB;
constexpr size_t W_C_IN = W_B_OUT + 2 * MiB;
constexpr size_t W_C_OUT = W_C_IN + 8 * MiB;
constexpr size_t W_D_IN = W_C_OUT + 2 * MiB;
constexpr size_t W_D_UQ = W_D_IN + 1 * MiB;
constexpr size_t W_D_UKV = W_D_UQ + 1 * MiB;
constexpr size_t W_D_OUT = W_D_UKV + 1 * MiB;
constexpr size_t W_F0_GU = W_D_OUT + 2 * MiB;
constexpr size_t W_F0_DN = W_F0_GU + 14 * MiB;
constexpr size_t W_F2_GU = W_F0_DN + 7 * MiB;
constexpr size_t W_F2_DN = W_F2_GU + 14 * MiB;
constexpr size_t W_M1_GU = W_F2_DN + 7 * MiB;
constexpr size_t W_M1_DN = W_M1_GU + 112 * MiB;
constexpr size_t W_M3_GU = W_M1_DN + 56 * MiB;
constexpr size_t W_M3_DN = W_M3_GU + 112 * MiB;
constexpr size_t WS_WEND = W_M3_DN + 56 * MiB;
constexpr size_t WS_XB = WS_WEND;
constexpr size_t WS_SMALL = WS_XB + 32 * MiB;
constexpr size_t S_STATS = WS_SMALL;
constexpr size_t S_TOKE = WS_SMALL + 128 * 1024;
constexpr size_t S_TOKG = WS_SMALL + 256 * 1024;
constexpr size_t S_SLOT = WS_SMALL + 384 * 1024;
constexpr size_t S_ROWTOK = WS_SMALL + 512 * 1024;
constexpr size_t S_ROWGATE = WS_SMALL + 768 * 1024;
constexpr size_t S_ANG = WS_SMALL + 1 * MiB;
constexpr size_t S_KR = WS_SMALL + 3 * MiB;
constexpr size_t S_MASK = WS_SMALL + 4 * MiB;
constexpr size_t WS_BIG = WS_SMALL + 8 * MiB;
constexpr size_t WS_R2 = WS_BIG + 238 * MiB;
constexpr size_t WS_END = WS_R2 + 68 * MiB;
static_assert(WS_WEND == 415 * MiB, "weight map");
static_assert(WS_END <= 880 * MiB, "workspace budget");
constexpr size_t B_UV = WS_BIG, B_GATED = WS_BIG + 128 * MiB;
constexpr size_t B_PROJB = WS_BIG, B_OB = WS_BIG + 192 * MiB;
constexpr size_t B_PROJC = WS_BIG, B_OPRE = WS_BIG + 128 * MiB;
constexpr size_t B_PROJD = WS_BIG, B_CQ = WS_BIG + 32 * MiB, B_CKV = WS_BIG + 40 * MiB, B_Q = WS_BIG + 48 * MiB, B_KV = WS_BIG + 96 * MiB;
constexpr size_t B_H = WS_BIG;
constexpr int CW_BAR = 4096;
constexpr int CW_CNT = 16384;

constexpr int RING_BYTES = 131072;
constexpr int LDS_BYTES = 147456;
constexpr int LDSCTL_OFF = LDS_BYTES - 256;

typedef __bf16 bf16x2_t __attribute__((ext_vector_type(2)));
__device__ __forceinline__ unsigned cvt_pk_bf16(float lo, float hi) { const f32x2 v = {lo, hi}; const bf16x2_t b = __builtin_convertvector(v, bf16x2_t); return __builtin_bit_cast(unsigned, b); }
__device__ __forceinline__ float bf2f(unsigned short b) { return __uint_as_float((unsigned)b << 16); }
__device__ __forceinline__ float bflo(unsigned w) { return __uint_as_float(w << 16); }
__device__ __forceinline__ float bfhi(unsigned w) { return __uint_as_float(w & 0xffff0000u); }
__device__ __forceinline__ float fast_exp2(float x) { return __builtin_amdgcn_exp2f(x); }
__device__ __forceinline__ float fast_rcp(float x) { return __builtin_amdgcn_rcpf(x); }
__device__ __forceinline__ float sigmoidf_(float x) { return fast_rcp(1.0f + fast_exp2(-1.4426950408889634f * x)); }
__device__ __forceinline__ float siluf_(float x) { return x * sigmoidf_(x); }
__device__ __forceinline__ float gelu_tanh(float x) { const float u = x + 0.044715f * x * x * x; return x * fast_rcp(1.0f + fast_exp2(-2.302208198f * u)); }
template <int CTRL> __device__ __forceinline__ float dppmov(float v) { return __int_as_float(__builtin_amdgcn_update_dpp(0, __float_as_int(v), CTRL, 0xF, 0xF, true)); }
__device__ __forceinline__ float row_sum16(float v) { v += dppmov<0xB1>(v); v += dppmov<0x4E>(v); v += dppmov<0x124>(v); v += dppmov<0x128>(v); return v; }
__device__ __forceinline__ float rdlane(float v, int l) { return __int_as_float(__builtin_amdgcn_readlane(__float_as_int(v), l)); }
__device__ __forceinline__ float wave_sum(float v) { v = row_sum16(v); return (rdlane(v, 0) + rdlane(v, 16)) + (rdlane(v, 32) + rdlane(v, 48)); }
__device__ __forceinline__ float half_sum32(float v, int lane) { v = row_sum16(v); const float lo = rdlane(v, 0) + rdlane(v, 16), hi = rdlane(v, 32) + rdlane(v, 48); return lane < 32 ? lo : hi; }
#define LDS_WAIT() asm volatile("s_waitcnt lgkmcnt(0)" ::: "memory")
#define VM_WAIT() asm volatile("s_waitcnt vmcnt(0)" ::: "memory")
#define LDS_BARRIER() asm volatile("s_waitcnt lgkmcnt(0)\n\ts_barrier" ::: "memory")
namespace pg8 {
constexpr int BM = 256, BK = 64, HALF = 128, HTB = HALF * BK * 2  , STAGE_BYTES = 8 * HTB, NXCD = 8, WGM = 8;
__host__ __device__ __forceinline__ int lds_byte(int r, int c) { const int st = (r >> 4) * 2 + (c >> 5), rr = r & 15, cc = c & 31, ob = rr * 64 + cc * 2; return st * 1024 + (ob ^ (((ob >> 9) & 1) << 5)); }
__host__ __device__ __forceinline__ void stage_rc(int b, int& R, int& C) { const int st = b / 1024, sb = b % 1024, swz = sb ^ (((sb >> 9) & 1) << 5); R = (st >> 1) * 16 + swz / 64; C = (st & 1) * 32 + (swz % 64) / 2; }
__host__ __device__ __forceinline__ int perm32(int rho) { const int n = rho >> 4, i = rho & 15; return 8 * (i >> 2) + 4 * n + (i & 3); }

struct Unit { int pm, pn, e; };
struct Gemm { const bf16* A; const bf16* Bt; int M, N, K, lda; size_t bes; };

struct StaticOrder {
    int nM, nN, nwg, G, c;
    __device__ void init(int M_, int N_, int G_, int c_) { nM = M_ / BM; nN = N_ / BM; nwg = nM * nN; G = G_; c = c_; }
    __device__ bool next(int i, Unit& u) const {
        const long L = (long)i * G + c; if (L >= nwg) return false;
        int wgid = (int)L; { const int q = nwg / NXCD, r = nwg % NXCD, xcd = wgid % NXCD, off = wgid / NXCD; wgid = (xcd < r ? xcd * (q + 1) : r * (q + 1) + (xcd - r) * q) + off; }
        const int nig = WGM * nN, gid = wgid / nig, fm = gid * WGM, gsz = (nM - fm) < WGM ? (nM - fm) : WGM;
        u.pm = fm + ((wgid % nig) % gsz); u.pn = (wgid % nig) / gsz; u.e = 0; return true;
    }
};
struct MoeOrder {
    StaticOrder so; int pend[NE];
    __device__ bool next(int i, Unit& u) const {
        if (!so.next(i, u)) return false;
        const int r0 = u.pm * BM; int e = 0;
#pragma unroll
        for (int j = 0; j < NE - 1; ++j) e += (r0 >= pend[j]) ? 1 : 0;
        u.e = e; return true;
    }
};

template <int ACT  > struct EpiBf16 {
    static constexpr bool PERM = true;
    bf16* O; int ldc; float sc; int sc_pn;
    __device__ __forceinline__ void operator()(const f32x4 (&acc)[2][2][4][2], const Unit& u, int wr, int wc, int fr, int fq) const {
        const int row0 = u.pm * BM + wr * 64 + fr, col0 = u.pn * BM + wc * 32 + 8 * fq;
        const float s = (u.pn < sc_pn) ? sc : 1.0f;
#pragma unroll
        for (int ai = 0; ai < 2; ++ai)
#pragma unroll
            for (int m = 0; m < 4; ++m) { bf16* rowp = O + (size_t)(row0 + ai * HALF + m * 16) * ldc + col0;
#pragma unroll
                for (int bj = 0; bj < 2; ++bj) { f32x4 v0 = acc[ai][bj][m][0], v1 = acc[ai][bj][m][1];
                    if (ACT == 1) { v0 = (f32x4){gelu_tanh(v0[0]), gelu_tanh(v0[1]), gelu_tanh(v0[2]), gelu_tanh(v0[3])}; v1 = (f32x4){gelu_tanh(v1[0]), gelu_tanh(v1[1]), gelu_tanh(v1[2]), gelu_tanh(v1[3])}; }
                    else { v0 = v0 * s; v1 = v1 * s; }
                    u32x4 w; w.x = cvt_pk_bf16(v0[0], v0[1]); w.y = cvt_pk_bf16(v0[2], v0[3]); w.z = cvt_pk_bf16(v1[0], v1[1]); w.w = cvt_pk_bf16(v1[2], v1[3]);
                    *(u32x4*)(rowp + bj * HALF) = w; } }
    }
};
struct EpiSwiGLU {
    static constexpr bool PERM = true;
    bf16* H; int ldh;
    __device__ __forceinline__ void operator()(const f32x4 (&acc)[2][2][4][2], const Unit& u, int wr, int wc, int fr, int fq) const {
        const int row0 = u.pm * BM + wr * 64 + fr, col0 = u.pn * HALF + wc * 32 + 8 * fq;
#pragma unroll
        for (int ai = 0; ai < 2; ++ai)
#pragma unroll
            for (int m = 0; m < 4; ++m) { bf16* rowp = H + (size_t)(row0 + ai * HALF + m * 16) * ldh + col0;
                const f32x4 g0 = acc[ai][0][m][0], g1 = acc[ai][0][m][1], u0 = acc[ai][1][m][0], u1 = acc[ai][1][m][1];
                u32x4 w; w.x = cvt_pk_bf16(siluf_(g0[0]) * u0[0], siluf_(g0[1]) * u0[1]); w.y = cvt_pk_bf16(siluf_(g0[2]) * u0[2], siluf_(g0[3]) * u0[3]);
                w.z = cvt_pk_bf16(siluf_(g1[0]) * u1[0], siluf_(g1[1]) * u1[1]); w.w = cvt_pk_bf16(siluf_(g1[2]) * u1[2], siluf_(g1[3]) * u1[3]);
                *(u32x4*)rowp = w; }
    }
};
struct EpiResid {
    static constexpr bool PERM = false;
    const bf16* X; float* Y; float alpha;
    __device__ __forceinline__ void operator()(const f32x4 (&acc)[2][2][4][2], const Unit& u, int wr, int wc, int fr, int fq) const {
        const int row0 = u.pm * BM + wr * 64 + fr, col0 = u.pn * BM + wc * 32 + 4 * fq;
#pragma unroll
        for (int ai = 0; ai < 2; ++ai)
#pragma unroll
            for (int m = 0; m < 4; ++m) { const size_t off = (size_t)(row0 + ai * HALF + m * 16) * D + col0;
#pragma unroll
                for (int bj = 0; bj < 2; ++bj)
#pragma unroll
                    for (int n = 0; n < 2; ++n) { const u32x2 xw = *(const u32x2*)(X + off + bj * HALF + n * 16); const f32x4 xv = (f32x4){bflo(xw.x), bfhi(xw.x), bflo(xw.y), bfhi(xw.y)};
                        *(f32x4*)(Y + off + bj * HALF + n * 16) = xv * alpha + acc[ai][bj][m][n]; } }
    }
};
struct EpiF32 {
    static constexpr bool PERM = false;
    float* C; int ldc;
    __device__ __forceinline__ void operator()(const f32x4 (&acc)[2][2][4][2], const Unit& u, int wr, int wc, int fr, int fq) const {
        const int row0 = u.pm * BM + wr * 64 + fr, col0 = u.pn * BM + wc * 32 + 4 * fq;
#pragma unroll
        for (int ai = 0; ai < 2; ++ai)
#pragma unroll
            for (int m = 0; m < 4; ++m) { float* rowp = C + (size_t)(row0 + ai * HALF + m * 16) * ldc + col0;
#pragma unroll
                for (int bj = 0; bj < 2; ++bj)
#pragma unroll
                    for (int n = 0; n < 2; ++n) *(f32x4*)(rowp + bj * HALF + n * 16) = acc[ai][bj][m][n]; }
    }
};
struct EpiMoeDown {
    static constexpr bool PERM = true;
    bf16* YK; const int* rowtok; const float* rowgate;
    __device__ __forceinline__ void operator()(const f32x4 (&acc)[2][2][4][2], const Unit& u, int wr, int wc, int fr, int fq) const {
        const int row0 = u.pm * BM + wr * 64 + fr, col0 = u.pn * BM + wc * 32 + 8 * fq;
#pragma unroll
        for (int ai = 0; ai < 2; ++ai)
#pragma unroll
            for (int m = 0; m < 4; ++m) { const int r = row0 + ai * HALF + m * 16; const int rt = rowtok[r]; const float gt = rowgate[r];
                if (rt >= 0) { bf16* rowp = YK + (size_t)(rt & 1) * ((size_t)M * D) + (size_t)(rt >> 1) * D + col0;
#pragma unroll
                    for (int bj = 0; bj < 2; ++bj) { const f32x4 v0 = acc[ai][bj][m][0] * gt, v1 = acc[ai][bj][m][1] * gt;
                        u32x4 w; w.x = cvt_pk_bf16(v0[0], v0[1]); w.y = cvt_pk_bf16(v0[2], v0[3]); w.z = cvt_pk_bf16(v1[0], v1[1]); w.w = cvt_pk_bf16(v1[2], v1[3]);
                        *(u32x4*)(rowp + bj * HALF) = w; } } }
    }
};

template <class Epi, class Sched>
__device__ __forceinline__ void gemm_phase(LAS unsigned char* lds, const Gemm g, const Sched& S, const Epi& E) {
    const int tid = threadIdx.x, wid = __builtin_amdgcn_readfirstlane(tid >> 6), lane = tid & 63, wr = wid >> 2, wc = wid & 3, fr = lane & 15, fq = lane >> 4;
    const int K = g.K, nt = K / BK;
    unsigned voffA[2], voffB[2];
#pragma unroll
    for (int i = 0; i < 2; ++i) { int R, C; stage_rc(tid * 16 + i * 8192, R, C); const int Rb = Epi::PERM ? ((R & ~31) + perm32(R & 31)) : R;
        voffA[i] = (unsigned)(R * g.lda + C) * 2u; voffB[i] = (unsigned)(Rb * K + C) * 2u; }
    const size_t kstep = (size_t)(BK * 2);
    const size_t hstepA = (size_t)HALF * g.lda * 2, tstepA = 2 * hstepA;
    const size_t hstepB = (size_t)HALF * K * 2, tstepB = 2 * hstepB;
    const size_t besB = g.bes * 2;
    const unsigned ldsw = (unsigned)wid * 1024u;
    const int aoff = lds_byte(wr * 64 + fr, fq * 8), boff = lds_byte(wc * 32 + fr, fq * 8);
#define PG8_SA(b, h) (((b) * 2 + (h)) * HTB)
#define PG8_SB(b, h) ((4 + (b) * 2 + (h)) * HTB)
#define PG8_STAGE(bufoff, gbase, voff) do { _Pragma("unroll") for (int _i = 0; _i < 2; ++_i) \
        __builtin_amdgcn_global_load_lds((const unsigned*)((const char*)(gbase) + (voff)[_i]), (LAS unsigned*)(lds + (bufoff) + ldsw + _i * 8192), 16, 0, 0); } while (0)
#define PG8_LDA(dst, b, h) do { _Pragma("unroll") for (int m = 0; m < 4; ++m) _Pragma("unroll") for (int k = 0; k < 2; ++k) dst[m][k] = *(const LAS bf16x8*)(lds + PG8_SA(b, h) + aoff + m * 2048 + k * 1024); } while (0)
#define PG8_LDB(dst, b, h) do { _Pragma("unroll") for (int n = 0; n < 2; ++n) _Pragma("unroll") for (int k = 0; k < 2; ++k) dst[n][k] = *(const LAS bf16x8*)(lds + PG8_SB(b, h) + boff + n * 2048 + k * 1024); } while (0)
#define PG8_MMA(ai, bj, At, Bt) do { __builtin_amdgcn_s_setprio(1); _Pragma("unroll") for (int m = 0; m < 4; ++m) _Pragma("unroll") for (int n = 0; n < 2; ++n) _Pragma("unroll") for (int k = 0; k < 2; ++k) \
        acc[ai][bj][m][n] = __builtin_amdgcn_mfma_f32_16x16x32_bf16(Bt[n][k], At[m][k], acc[ai][bj][m][n], 0, 0, 0); __builtin_amdgcn_s_setprio(0); } while (0)
#define PG8_WAIT_V(n) asm volatile("s_waitcnt vmcnt(" #n ")" ::: "memory")
#define PG8_WAIT_L(n) asm volatile("s_waitcnt lgkmcnt(" #n ")" ::: "memory")
#define PG8_BAR __builtin_amdgcn_s_barrier()
#define PG8_SCHED __builtin_amdgcn_sched_barrier(0)
    Unit cur, nxt; int ui = 0;
    if (!S.next(0, cur)) return;
    f32x4 acc[2][2][4][2];
#pragma unroll
    for (int a = 0; a < 2; ++a)
#pragma unroll
        for (int b = 0; b < 2; ++b)
#pragma unroll
            for (int m = 0; m < 4; ++m)
#pragma unroll
                for (int n = 0; n < 2; ++n) acc[a][b][m][n] = (f32x4){0.f, 0.f, 0.f, 0.f};
    bf16x8 At[4][2], B0[2][2], B1[2][2];
    const char* cA = (const char*)g.A + (size_t)cur.pm * tstepA; const char* cB = (const char*)g.Bt + (size_t)cur.e * besB + (size_t)cur.pn * tstepB;
    PG8_STAGE(PG8_SB(0, 0), cB, voffB); PG8_STAGE(PG8_SB(0, 1), cB + hstepB, voffB); PG8_STAGE(PG8_SA(0, 0), cA, voffA); PG8_STAGE(PG8_SA(0, 1), cA + hstepA, voffA);
    if (wr == 1) PG8_BAR;
    PG8_WAIT_V(2); PG8_BAR;
    PG8_STAGE(PG8_SB(1, 0), cB + kstep, voffB); PG8_STAGE(PG8_SA(1, 0), cA + kstep, voffA); PG8_STAGE(PG8_SB(1, 1), cB + hstepB + kstep, voffB);
    PG8_WAIT_V(6); PG8_BAR;
    for (;;) {
        const bool has_next = S.next(ui + 1, nxt);
        const char* nA = has_next ? (const char*)g.A + (size_t)nxt.pm * tstepA : cA; const char* nB = has_next ? (const char*)g.Bt + (size_t)nxt.e * besB + (size_t)nxt.pn * tstepB : cB;
        for (int t = 0; t < nt; t += 2) {
            const bool last = (t == nt - 2);
            const char* a1 = cA + (size_t)(t + 1) * kstep;
            const char* a2 = last ? nA : cA + (size_t)(t + 2) * kstep; const char* b2 = last ? nB : cB + (size_t)(t + 2) * kstep;
            const char* a3 = a2 + kstep; const char* b3 = b2 + kstep;
            PG8_LDB(B0, 0, 0); PG8_LDB(B1, 0, 1); PG8_SCHED; PG8_LDA(At, 0, 0); PG8_STAGE(PG8_SA(1, 1), a1 + hstepA, voffA);
            PG8_WAIT_V(8); PG8_WAIT_L(0); PG8_BAR; PG8_MMA(0, 0, At, B0); PG8_MMA(0, 1, At, B1); PG8_BAR; PG8_SCHED;
            PG8_LDA(At, 0, 1); PG8_STAGE(PG8_SB(0, 0), b2, voffB); PG8_STAGE(PG8_SB(0, 1), b2 + hstepB, voffB); PG8_STAGE(PG8_SA(0, 0), a2, voffA);
            PG8_WAIT_V(8); PG8_WAIT_L(0); PG8_BAR; PG8_MMA(1, 0, At, B0); PG8_MMA(1, 1, At, B1); PG8_BAR; PG8_SCHED;
            PG8_LDB(B0, 1, 0); PG8_LDB(B1, 1, 1); PG8_SCHED; PG8_LDA(At, 1, 0); PG8_STAGE(PG8_SA(0, 1), a2 + hstepA, voffA);
            PG8_WAIT_V(8); PG8_WAIT_L(0); PG8_BAR; PG8_MMA(0, 0, At, B0); PG8_MMA(0, 1, At, B1); PG8_BAR; PG8_SCHED;
            PG8_LDA(At, 1, 1); PG8_STAGE(PG8_SB(1, 0), b3, voffB); PG8_STAGE(PG8_SB(1, 1), b3 + hstepB, voffB); PG8_STAGE(PG8_SA(1, 0), a3, voffA);
            PG8_WAIT_V(8); PG8_WAIT_L(0); PG8_BAR; PG8_MMA(1, 0, At, B0); PG8_MMA(1, 1, At, B1); PG8_BAR; PG8_SCHED;
        }
        if (wr == 0) PG8_BAR;
        E(acc, cur, wr, wc, fr, fq);
        if (!has_next) break;
#pragma unroll
        for (int a = 0; a < 2; ++a)
#pragma unroll
            for (int b = 0; b < 2; ++b)
#pragma unroll
                for (int m = 0; m < 4; ++m)
#pragma unroll
                    for (int n = 0; n < 2; ++n) acc[a][b][m][n] = (f32x4){0.f, 0.f, 0.f, 0.f};
        cur = nxt; cA = nA; cB = nB; ++ui;
        if (wr == 1) PG8_BAR;
    }
    PG8_WAIT_V(0);
    PG8_BAR;
#undef PG8_SA
#undef PG8_SB
#undef PG8_STAGE
#undef PG8_LDA
#undef PG8_LDB
#undef PG8_MMA
#undef PG8_WAIT_V
#undef PG8_WAIT_L
#undef PG8_BAR
#undef PG8_SCHED
}
}
#define XB_TMO      128
#define XB_XCNT(j)  (256  + 64 * (j))
#define XB_XSUB(j)  (1280 + 64 * (j))
#define XB_XGEN(j)  (2304 + 64 * (j))
#define XB_TOP      3328
#define XB_TOPGEN   3392
#define XCD_BAR_WORDS 3456
#define XB_SPIN_CAP (1u << 18)
__device__ __forceinline__ unsigned xb_ld(unsigned* p)              { return __hip_atomic_load(p, __ATOMIC_RELAXED, __HIP_MEMORY_SCOPE_AGENT); }
__device__ __forceinline__ unsigned xb_add(unsigned* p, unsigned v) { return __hip_atomic_fetch_add(p, v, __ATOMIC_RELAXED, __HIP_MEMORY_SCOPE_AGENT); }
__device__ __forceinline__ unsigned xb_xcc_id() { return (unsigned)__builtin_amdgcn_s_getreg((3 << 11) | 20) & 0xFu; }
#define XB_SPIN(cond, bar) do { unsigned _sp = 0; while (cond) { __builtin_amdgcn_s_sleep(1); \
    if ((++_sp & 255u) == 0u) { if (xb_ld(&(bar)[XB_TMO])) break; if (_sp > XB_SPIN_CAP) { atomicAdd(&(bar)[XB_TMO], 1u); break; } } } } while (0)
struct XcdBarrier { unsigned* bar; unsigned x; volatile LAS unsigned* st; };
__device__ __forceinline__ XcdBarrier xcd_barrier_post(unsigned* bar, volatile LAS unsigned* st) {
    XcdBarrier b; b.bar = bar; b.x = xb_xcc_id(); b.st = st;
    if (threadIdx.x == 0) (void)xb_add(&bar[XB_XCNT(b.x)], 1u);
    return b;
}
__device__ __forceinline__ void xcd_barrier_complete(unsigned* bar, unsigned x, unsigned& nloc, unsigned& nx) {
    const unsigned G = gridDim.x * gridDim.y * gridDim.z;
    unsigned sum, cnt, mine, sp = 0u;
    for (;;) {
        sum = 0u; cnt = 0u; mine = 0u;
#pragma unroll
        for (unsigned j = 0; j < 16; ++j) { const unsigned c = xb_ld(&bar[XB_XCNT(j)]); sum += c; cnt += (c > 0u) ? 1u : 0u; mine = (j == x) ? c : mine; }
        if (sum == G) break;
        __builtin_amdgcn_s_sleep(1);
        if ((++sp & 255u) == 0u) { if (xb_ld(&bar[XB_TMO])) break; if (sp > XB_SPIN_CAP) { atomicAdd(&bar[XB_TMO], 1u); break; } }
    }
    nloc = mine > 0u ? mine : 1u; nx = cnt > 0u ? cnt : 1u;
}
__device__ __forceinline__ void xcd_barrier(const XcdBarrier& b) {
    asm volatile("s_waitcnt vmcnt(0)" ::: "memory");
    __syncthreads();
    if (threadIdx.x == 0) {
        unsigned* bar = b.bar;
        __builtin_amdgcn_s_waitcnt(0);
        unsigned nloc = b.st[0], nx = b.st[1];
        if (nloc == 0u) { xcd_barrier_complete(bar, b.x, nloc, nx); b.st[0] = nloc; b.st[1] = nx; }
        const unsigned old = xb_add(&bar[XB_XSUB(b.x)], 1u);
        const unsigned gen = old / nloc;
        if (old + 1u == (gen + 1u) * nloc) {
            __builtin_amdgcn_fence(__ATOMIC_RELEASE, "agent");
            asm volatile("s_waitcnt vmcnt(0)" ::: "memory");
            const unsigned og = xb_add(&bar[XB_TOP], 1u);
            const unsigned tg = og / nx;
            if (og + 1u == (tg + 1u) * nx) xb_add(&bar[XB_TOPGEN], 1u);
            else XB_SPIN(xb_ld(&bar[XB_TOPGEN]) == tg, bar);
            __builtin_amdgcn_fence(__ATOMIC_ACQUIRE, "agent");
            xb_add(&bar[XB_XGEN(b.x)], 1u);
            asm volatile("s_waitcnt vmcnt(0)" ::: "memory");
        } else {
            XB_SPIN(xb_ld(&bar[XB_XGEN(b.x)]) == gen, bar);
            __builtin_amdgcn_fence(__ATOMIC_ACQUIRE, "agent");
            asm volatile("s_waitcnt vmcnt(0)" ::: "memory");
        }
    }
    __syncthreads();
}

struct Frame {
    LAS unsigned char* lds;
    unsigned* ctl;
    unsigned char* ws;
    int tid, lane, wave, G, bid;
};
struct Args { const void* in[34]; float* out; unsigned char* ws; int ph_lo, ph_hi; };

enum { I_X = 0, I_POS, I_A_WIN, I_A_LNG, I_A_LNB, I_A_WS, I_A_BS, I_A_WOUT, I_B_WIN, I_B_WOUT, I_C_WIN, I_C_LB, I_C_NG, I_C_WOUT,
       I_D_WIN, I_D_QNG, I_D_WUQ, I_D_KVNG, I_D_WUKV, I_D_WOUT, I_F0_GU, I_F0_DN, I_M1_R, I_M1_GU, I_M1_DN, I_F2_GU, I_F2_DN, I_M3_R, I_M3_GU, I_M3_DN,
       I_LNM_G, I_LNM_B, I_LNF_G, I_LNF_B };

__device__ __forceinline__ void cvt_load(f32x4 (&r)[8], const float* W, int Kv, int Nv, int k0, int n0, int lane) {
    const int n = n0 + 4 * (lane & 7);
#pragma unroll
    for (int i = 0; i < 8; ++i) { const int k = k0 + 8 * i + (lane >> 3); r[i] = (k < Kv && n < Nv) ? *(const f32x4*)(W + (size_t)k * Nv + n) : (f32x4){0.f, 0.f, 0.f, 0.f}; }
}
__device__ __forceinline__ void cvt_store(const f32x4 (&r)[8], bf16* WT, int Kp, int mode, int k0, int n0, LAS float* scr, int lane) {
#pragma unroll
    for (int i = 0; i < 8; ++i) { LAS float* p = scr + (8 * i + (lane >> 3)) * 33 + 4 * (lane & 7); p[0] = r[i].x; p[1] = r[i].y; p[2] = r[i].z; p[3] = r[i].w; }
    LDS_WAIT(); asm volatile("" ::: "memory");
    int drow0;
    if (mode == 0) drow0 = n0; else { const int j = (n0 < FF) ? n0 : n0 - FF; drow0 = 256 * (j >> 7) + (j & 127) + ((n0 < FF) ? 0 : 128); }
    const int c = lane & 7;
#pragma unroll
    for (int j = 0; j < 4; ++j) { const int n = (lane >> 3) + 8 * j; const LAS float* s = scr + (8 * c) * 33 + n;
        u32x4 o; o.x = cvt_pk_bf16(s[0 * 33], s[1 * 33]); o.y = cvt_pk_bf16(s[2 * 33], s[3 * 33]); o.z = cvt_pk_bf16(s[4 * 33], s[5 * 33]); o.w = cvt_pk_bf16(s[6 * 33], s[7 * 33]);
        *(u32x4*)(WT + (size_t)(drow0 + n) * Kp + k0 + 8 * c) = o; }
    LDS_WAIT(); asm volatile("" ::: "memory");
}
__device__ __forceinline__ void convert_matrix_g(const Frame& F, int gw, int NGW, const float* W, int Kv, int Nv, bf16* WT, int Kp, int Np, int mode, int nmat) {
    LAS float* scr = (LAS float*)(F.lds + F.wave * 16384);
    const int nkb = Kp / 64, nnb = Np / 32, per = nkb * nnb;
    const long total = (long)per * nmat;
#define CVT_DEC(it_, mat_, k0_, n0_) const int mat_ = (int)((it_) / per), r_##mat_ = (int)((it_) % per); const int k0_ = 64 * (r_##mat_ / nnb), n0_ = 32 * (r_##mat_ % nnb)
    f32x4 ra[8], rb[8];
    long it = gw;
    if (it < total) { CVT_DEC(it, m0, k0, n0); cvt_load(ra, W + (size_t)m0 * Kv * Nv, Kv, Nv, k0, n0, F.lane); }
    while (it < total) {
        { const long nx = it + NGW; if (nx < total) { CVT_DEC(nx, m1, k1, n1); cvt_load(rb, W + (size_t)m1 * Kv * Nv, Kv, Nv, k1, n1, F.lane); }
          CVT_DEC(it, m0, k0, n0); cvt_store(ra, WT + (size_t)m0 * Kp * Np, Kp, mode, k0, n0, scr, F.lane); it = nx; }
        if (it >= total) break;
        { const long nx = it + NGW; if (nx < total) { CVT_DEC(nx, m1, k1, n1); cvt_load(ra, W + (size_t)m1 * Kv * Nv, Kv, Nv, k1, n1, F.lane); }
          CVT_DEC(it, m0, k0, n0); cvt_store(rb, WT + (size_t)m0 * Kp * Np, Kp, mode, k0, n0, scr, F.lane); it = nx; }
    }
#undef CVT_DEC
}
__device__ __forceinline__ void convert_matrix(const Frame& F, const float* W, int Kv, int Nv, bf16* WT, int Kp, int Np, int mode, int nmat) {
    convert_matrix_g(F, F.bid * NWAVES + F.wave, F.G * NWAVES, W, Kv, Nv, WT, Kp, Np, mode, nmat);
}

__device__ __forceinline__ void ln_row(f32x4 (&v)[4], const float* g, const float* b, int lane) {
    float s = 0.f;
#pragma unroll
    for (int j = 0; j < 4; ++j) s += (v[j].x + v[j].y) + (v[j].z + v[j].w);
    const float mean = wave_sum(s) * (1.f / D); float s2 = 0.f;
#pragma unroll
    for (int j = 0; j < 4; ++j) { v[j] = v[j] - mean; s2 += (v[j].x * v[j].x + v[j].y * v[j].y) + (v[j].z * v[j].z + v[j].w * v[j].w); }
    const float rstd = __builtin_amdgcn_rsqf(wave_sum(s2) * (1.f / D) + LN_EPS);
#pragma unroll
    for (int j = 0; j < 4; ++j) { const f32x4 gg = *(const f32x4*)(g + 4 * lane + 256 * j), bb = *(const f32x4*)(b + 4 * lane + 256 * j); v[j] = v[j] * rstd * gg + bb; }
}
__device__ __forceinline__ void store_row_bf(const f32x4 (&v)[4], bf16* ob, int lane) {
#pragma unroll
    for (int j = 0; j < 4; ++j) { u32x2 w; w.x = cvt_pk_bf16(v[j].x, v[j].y); w.y = cvt_pk_bf16(v[j].z, v[j].w); *(u32x2*)(ob + 4 * lane + 256 * j) = w; }
}
__device__ __forceinline__ void store_row_f32(const f32x4 (&v)[4], float* of, int lane) {
#pragma unroll
    for (int j = 0; j < 4; ++j) *(f32x4*)(of + 4 * lane + 256 * j) = v[j];
}
__device__ __forceinline__ void ln_phase(const Frame& F, const float* xf, bf16* xb, const float* g, const float* b) {
    const int gw = F.bid * NWAVES + F.wave, NGW = F.G * NWAVES;
    for (int r = gw; r < M; r += 2 * NGW) {
        const int r2 = r + NGW; const bool has2 = r2 < M; const int rr2 = has2 ? r2 : r;
        f32x4 v[4], w[4];
#pragma unroll
        for (int j = 0; j < 4; ++j) { v[j] = *(const f32x4*)(xf + (size_t)r * D + 4 * F.lane + 256 * j); w[j] = *(const f32x4*)(xf + (size_t)rr2 * D + 4 * F.lane + 256 * j); }
        ln_row(v, g, b, F.lane); ln_row(w, g, b, F.lane);
        store_row_bf(v, xb + (size_t)r * D, F.lane);
        if (has2) store_row_bf(w, xb + (size_t)r2 * D, F.lane);
    }
}
__device__ __forceinline__ void ln_route_phase(const Frame& F, const float* xf, bf16* xb, const float* g, const float* b, const float* wr, unsigned* cnt  ) {
    LAS float* WR = (LAS float*)F.lds;
    LAS int* EB = (LAS int*)(F.lds + 32768);
    for (int i = F.tid; i < D * NE / 4; i += NTHREADS) ((LAS f32x4*)WR)[i] = ((const f32x4*)wr)[i];
    __syncthreads();
    int* toke = (int*)(F.ws + S_TOKE); float* tokg = (float*)(F.ws + S_TOKG); int* slot = (int*)(F.ws + S_SLOT);
    for (int blk = F.bid; blk < M / 64; blk += F.G) {
        for (int i = 0; i < 8; ++i) {
            const int rl = F.wave * 8 + i, r = blk * 64 + rl;
            f32x4 v[4];
#pragma unroll
            for (int j = 0; j < 4; ++j) v[j] = *(const f32x4*)(xf + (size_t)r * D + 4 * F.lane + 256 * j);
            ln_row(v, g, b, F.lane);
            store_row_bf(v, xb + (size_t)r * D, F.lane);
            float lg[NE];
#pragma unroll
            for (int e = 0; e < NE; ++e) lg[e] = 0.f;
#pragma unroll
            for (int j = 0; j < 4; ++j)
#pragma unroll
                for (int c = 0; c < 4; ++c) { const LAS f32x4* wp = (const LAS f32x4*)(WR + (size_t)(4 * F.lane + 256 * j + c) * NE); const f32x4 w0 = wp[0], w1 = wp[1]; const float xv = v[j][c];
                    lg[0] += xv * w0.x; lg[1] += xv * w0.y; lg[2] += xv * w0.z; lg[3] += xv * w0.w; lg[4] += xv * w1.x; lg[5] += xv * w1.y; lg[6] += xv * w1.z; lg[7] += xv * w1.w; }
#pragma unroll
            for (int e = 0; e < NE; ++e) lg[e] = wave_sum(lg[e]);
            int e0 = 0; float l0 = lg[0];
#pragma unroll
            for (int e = 1; e < NE; ++e) if (lg[e] > l0) { l0 = lg[e]; e0 = e; }
            int e1 = -1; float l1 = -3.0e38f;
#pragma unroll
            for (int e = 0; e < NE; ++e) if (e != e0 && lg[e] > l1) { l1 = lg[e]; e1 = e; }
            const float ex = __expf(l1 - l0), g0 = 1.f / (1.f + ex), g1 = ex * g0;
            if (F.lane == 0) { toke[2 * r] = e0; toke[2 * r + 1] = e1; tokg[2 * r] = g0; tokg[2 * r + 1] = g1; EB[2 * rl] = e0; EB[2 * rl + 1] = e1; }
        }
        __syncthreads();
        if (F.wave == 0) {
            const int lane = F.lane; const int ea = EB[lane], eb = EB[64 + lane];
            const u64 lt = (1ull << lane) - 1ull; int myc = 0, ra = 0, rbk = 0;
#pragma unroll
            for (int e = 0; e < NE; ++e) { const u64 ma = __ballot(ea == e), mb = __ballot(eb == e); const int pa = __builtin_popcountll(ma), c = pa + __builtin_popcountll(mb);
                if (lane == e) myc = c; if (ea == e) ra = __builtin_popcountll(ma & lt); if (eb == e) rbk = pa + __builtin_popcountll(mb & lt); }
            int basev = 0; if (lane < NE) basev = (int)__hip_atomic_fetch_add(cnt + 64 * lane, (unsigned)myc, __ATOMIC_RELAXED, __HIP_MEMORY_SCOPE_AGENT);
            int ba = 0, bb = 0;
#pragma unroll
            for (int e = 0; e < NE; ++e) { const int be = __builtin_amdgcn_readlane(basev, e); if (ea == e) ba = be; if (eb == e) bb = be; }
            slot[(size_t)(blk * 64) * 2 + lane] = ba + ra; slot[(size_t)(blk * 64) * 2 + 64 + lane] = bb + rbk;
        }
        __syncthreads();
    }
}
__device__ __forceinline__ int moe_segments(const unsigned* cnt, int (&cntv)[NE], int (&pstart)[NE], int (&pend)[NE]) {
    int acc = 0;
#pragma unroll
    for (int e = 0; e < NE; ++e) { cntv[e] = (int)__hip_atomic_load(cnt + 64 * e, __ATOMIC_RELAXED, __HIP_MEMORY_SCOPE_AGENT); pstart[e] = acc; acc += (cntv[e] + 255) & ~255; pend[e] = acc; }
    return acc;
}
__device__ __forceinline__ void moe_gather_phase(const Frame& F, const bf16* xb, bf16* xr, const unsigned* cnt) {
    int cntv[NE], pstart[NE], pend[NE]; moe_segments(cnt, cntv, pstart, pend);
    const int* toke = (const int*)(F.ws + S_TOKE); const float* tokg = (const float*)(F.ws + S_TOKG); const int* slot = (const int*)(F.ws + S_SLOT);
    int* rowtok = (int*)(F.ws + S_ROWTOK); float* rowgate = (float*)(F.ws + S_ROWGATE);
    const int gw = F.bid * NWAVES + F.wave, NGW = F.G * NWAVES;
    for (int a = gw; a < 2 * M; a += NGW) {
        const int e = toke[a]; int ps = 0;
#pragma unroll
        for (int j = 0; j < NE; ++j) ps = (e == j) ? pstart[j] : ps;
        const int dest = ps + slot[a]; const int t = a >> 1;
        const u32x4* src = (const u32x4*)(xb + (size_t)t * D); u32x4* dst = (u32x4*)(xr + (size_t)dest * D);
        dst[F.lane] = src[F.lane]; dst[F.lane + 64] = src[F.lane + 64];
        if (F.lane == 0) { rowtok[dest] = a; rowgate[dest] = tokg[a]; }
    }
    for (int i = gw; i < NE * 256; i += NGW) {
        const int e = i >> 8, j = i & 255; int ps = 0, cv = 0, pe = 0;
#pragma unroll
        for (int q = 0; q < NE; ++q) { ps = (e == q) ? pstart[q] : ps; cv = (e == q) ? cntv[q] : cv; pe = (e == q) ? pend[q] : pe; }
        const int r = ps + cv + j;
        if (r < pe) { u32x4* dst = (u32x4*)(xr + (size_t)r * D); const u32x4 z = (u32x4){0u, 0u, 0u, 0u}; dst[F.lane] = z; dst[F.lane + 64] = z; if (F.lane == 0) { rowtok[r] = -1; rowgate[r] = 0.f; } }
    }
}
__device__ __forceinline__ void ln_moe_load(f32x4 (&v)[4], const bf16* xb, const bf16* yk, int r, int lane) {
#pragma unroll
    for (int j = 0; j < 4; ++j) { const size_t o = (size_t)r * D + 4 * lane + 256 * j; const u32x2 x = *(const u32x2*)(xb + o);
        const u32x2 a = *(const u32x2*)(yk + o), c = *(const u32x2*)(yk + (size_t)M * D + o);
        v[j].x = bflo(x.x) * ALPHA + bflo(a.x) + bflo(c.x); v[j].y = bfhi(x.x) * ALPHA + bfhi(a.x) + bfhi(c.x); v[j].z = bflo(x.y) * ALPHA + bflo(a.y) + bflo(c.y); v[j].w = bfhi(x.y) * ALPHA + bfhi(a.y) + bfhi(c.y); }
}
__device__ __forceinline__ void ln_moe_phase(const Frame& F, const bf16* yk, float* outf, bf16* xb, const float* g, const float* b) {
    const int gw = F.bid * NWAVES + F.wave, NGW = F.G * NWAVES;
    for (int r = gw; r < M; r += 2 * NGW) {
        const int r2 = r + NGW; const bool has2 = r2 < M; const int rr2 = has2 ? r2 : r;
        f32x4 v[4], w[4];
        ln_moe_load(v, xb, yk, r, F.lane); ln_moe_load(w, xb, yk, rr2, F.lane);
        ln_row(v, g, b, F.lane); ln_row(w, g, b, F.lane);
        if (outf) { store_row_f32(v, outf + (size_t)r * D, F.lane); if (has2) store_row_f32(w, outf + (size_t)r2 * D, F.lane); }
        else { store_row_bf(v, xb + (size_t)r * D, F.lane); if (has2) store_row_bf(w, xb + (size_t)r2 * D, F.lane); }
    }
}
__device__ __forceinline__ void cvt_rows_phase(const Frame& F, const float* x, bf16* xb) {
    const int gw = F.bid * NWAVES + F.wave, NGW = F.G * NWAVES;
    for (int r = gw; r < M; r += NGW) {
#pragma unroll
        for (int j = 0; j < 4; ++j) { const size_t o = (size_t)r * D + 4 * F.lane + 256 * j; const f32x4 v = *(const f32x4*)(x + o);
            u32x2 w; w.x = cvt_pk_bf16(v.x, v.y); w.y = cvt_pk_bf16(v.z, v.w); *(u32x2*)(xb + o) = w; }
    }
}
__device__ __forceinline__ void gmlp_stats_phase(const Frame& F, const bf16* uv, float* stats) {
    const int gw = F.bid * NWAVES + F.wave, NGW = F.G * NWAVES;
    for (int r = gw; r < M; r += NGW) {
        const u32x4* p = (const u32x4*)(uv + (size_t)r * 4096 + 2048);
        float x[32]; float s = 0.f;
#pragma unroll
        for (int j = 0; j < 4; ++j) { const u32x4 w = p[F.lane + 64 * j];
            x[8 * j + 0] = bflo(w.x); x[8 * j + 1] = bfhi(w.x); x[8 * j + 2] = bflo(w.y); x[8 * j + 3] = bfhi(w.y); x[8 * j + 4] = bflo(w.z); x[8 * j + 5] = bfhi(w.z); x[8 * j + 6] = bflo(w.w); x[8 * j + 7] = bfhi(w.w); }
#pragma unroll
        for (int i = 0; i < 32; ++i) s += x[i];
        const float mean = wave_sum(s) * (1.f / 2048.f); float s2 = 0.f;
#pragma unroll
        for (int i = 0; i < 32; ++i) { const float d = x[i] - mean; s2 += d * d; }
        const float rstd = __builtin_amdgcn_rsqf(wave_sum(s2) * (1.f / 2048.f) + LN_EPS);
        if (F.lane == 0) { stats[2 * r] = mean; stats[2 * r + 1] = rstd; }
    }
}
constexpr int GM_WS = 136, GM_VS = 136;
__device__ __forceinline__ void gmlp_spatial_phase(const Frame& F, const bf16* uv, const float* stats, const float* ws_in  , const float* bs  ,
                                                   const float* lng, const float* lnb, bf16* gated) {
    LAS bf16* Ws = (LAS bf16*)F.lds;
    LAS bf16* Vt = (LAS bf16*)(F.lds + 128 * GM_WS * 2);
    const int tid = F.tid, lane = F.lane, w = F.wave, wr = w >> 2, wc = w & 3, fr = lane & 15, fq = lane >> 4;
    for (int u = F.bid; u < 1024; u += F.G) {
        const int bc = u >> 3, g = u & 7; const size_t rowbase = (size_t)bc * 128;
        { const int t = tid >> 2, c0 = (tid & 3) * 32; const float* wp = ws_in + ((size_t)g * 128 + t) * 128 + c0;
#pragma unroll
            for (int q = 0; q < 4; ++q) { const f32x4 a = *(const f32x4*)(wp + 8 * q), b = *(const f32x4*)(wp + 8 * q + 4); const int s0 = c0 + 8 * q;
                u32x4 o; o.x = cvt_pk_bf16(s0 + 0 <= t ? a.x : 0.f, s0 + 1 <= t ? a.y : 0.f); o.y = cvt_pk_bf16(s0 + 2 <= t ? a.z : 0.f, s0 + 3 <= t ? a.w : 0.f);
                o.z = cvt_pk_bf16(s0 + 4 <= t ? b.x : 0.f, s0 + 5 <= t ? b.y : 0.f); o.w = cvt_pk_bf16(s0 + 6 <= t ? b.z : 0.f, s0 + 7 <= t ? b.w : 0.f);
                *(LAS u32x4*)(Ws + t * GM_WS + s0) = o; } }
        { const int so = tid & 15, dq = tid >> 4; const int col = 256 * g + 8 * dq;
            const f32x4 g0 = *(const f32x4*)(lng + col), g1 = *(const f32x4*)(lng + col + 4), b0 = *(const f32x4*)(lnb + col), b1 = *(const f32x4*)(lnb + col + 4);
            float vv[8][8];
#pragma unroll
            for (int j = 0; j < 8; ++j) { const size_t r = rowbase + 8 * so + j; const u32x4 wv = *(const u32x4*)(uv + r * 4096 + 2048 + col); const float mean = stats[2 * r], rstd = stats[2 * r + 1];
                vv[j][0] = (bflo(wv.x) - mean) * rstd * g0.x + b0.x; vv[j][1] = (bfhi(wv.x) - mean) * rstd * g0.y + b0.y; vv[j][2] = (bflo(wv.y) - mean) * rstd * g0.z + b0.z; vv[j][3] = (bfhi(wv.y) - mean) * rstd * g0.w + b0.w;
                vv[j][4] = (bflo(wv.z) - mean) * rstd * g1.x + b1.x; vv[j][5] = (bfhi(wv.z) - mean) * rstd * g1.y + b1.y; vv[j][6] = (bflo(wv.w) - mean) * rstd * g1.z + b1.z; vv[j][7] = (bfhi(wv.w) - mean) * rstd * g1.w + b1.w; }
#pragma unroll
            for (int dd = 0; dd < 8; ++dd) { u32x4 o; o.x = cvt_pk_bf16(vv[0][dd], vv[1][dd]); o.y = cvt_pk_bf16(vv[2][dd], vv[3][dd]); o.z = cvt_pk_bf16(vv[4][dd], vv[5][dd]); o.w = cvt_pk_bf16(vv[6][dd], vv[7][dd]);
                *(LAS u32x4*)(Vt + (8 * dq + dd) * GM_VS + 8 * so) = o; } }
        __syncthreads();
        f32x4 acc[4][4];
#pragma unroll
        for (int a = 0; a < 4; ++a)
#pragma unroll
            for (int b = 0; b < 4; ++b) acc[a][b] = (f32x4){0.f, 0.f, 0.f, 0.f};
        const int nks = wr ? 4 : 2;
        for (int ks = 0; ks < nks; ++ks) {
            bf16x8 wf[4], vf[4];
#pragma unroll
            for (int mt = 0; mt < 4; ++mt) wf[mt] = *(const LAS bf16x8*)(Ws + (64 * wr + 16 * mt + fr) * GM_WS + 32 * ks + 8 * fq);
#pragma unroll
            for (int nt = 0; nt < 4; ++nt) vf[nt] = *(const LAS bf16x8*)(Vt + (64 * wc + 16 * nt + fr) * GM_VS + 32 * ks + 8 * fq);
#pragma unroll
            for (int mt = 0; mt < 4; ++mt)
#pragma unroll
                for (int nt = 0; nt < 4; ++nt) acc[mt][nt] = __builtin_amdgcn_mfma_f32_16x16x32_bf16(vf[nt], wf[mt], acc[mt][nt], 0, 0, 0);
        }
#pragma unroll
        for (int mt = 0; mt < 4; ++mt) { const int tl = 64 * wr + 16 * mt + fr; const float bias = bs[g * 128 + tl]; const size_t r = rowbase + tl;
#pragma unroll
            for (int nt = 0; nt < 4; ++nt) { const int col = 256 * g + 64 * wc + 16 * nt + 4 * fq; const u32x2 uu = *(const u32x2*)(uv + r * 4096 + col);
                const f32x4 sv = acc[mt][nt] + bias;
                u32x2 o; o.x = cvt_pk_bf16(bflo(uu.x) * sv.x, bfhi(uu.x) * sv.y); o.y = cvt_pk_bf16(bflo(uu.y) * sv.z, bfhi(uu.y) * sv.w);
                *(u32x2*)(gated + r * 2048 + col) = o; } }
        __syncthreads();
    }
}
constexpr int PB_LD = 3584, PB_QI = 3072, PB_KI = 3328, PB_WI = 3392;
__device__ __forceinline__ unsigned sortable(float s) { const unsigned b = __float_as_uint(s + 0.0f); return b ^ ((b >> 31) ? 0xffffffffu : 0x80000000u); }
template <int NJ>
__device__ __forceinline__ void dsa_select(const LAS unsigned* sc, int t, int lane, u64* mrow) {
    unsigned key[NJ];
#pragma unroll
    for (int j = 0; j < NJ; ++j) { const int s = 64 * j + lane; key[j] = (s <= t) ? sc[s] : 0u; }
    unsigned T = 0u; int need = 0;
    if (t >= 256) {
        for (int bit = 31; bit >= 0; --bit) {
            const unsigned cand = T | (1u << bit); int c = 0;
#pragma unroll
            for (int j = 0; j < NJ; ++j) c += __builtin_popcountll(__ballot(key[j] >= cand));
            if (c >= 256) T = cand;
        }
        int ngt = 0;
#pragma unroll
        for (int j = 0; j < NJ; ++j) ngt += __builtin_popcountll(__ballot(key[j] > T));
        need = 256 - ngt;
    }
    int running = 0;
#pragma unroll
    for (int j = 0; j < NJ; ++j) {
        const bool adm = (64 * j + lane) <= t;
        const bool gt = key[j] > T, eq = (key[j] == T);
        const u64 eqm = __ballot(eq && adm);
        const int rank = running + __builtin_popcountll(eqm & ((1ull << lane) - 1ull));
        const bool sel = adm && (gt || (t < 256) || (eq && rank < need));
        const u64 word = __ballot(sel);
        running += __builtin_popcountll(eqm);
        if (lane == 0) mrow[j] = word;
    }
    if (lane == 0) {
#pragma unroll
        for (int j = NJ; j < 32; ++j) mrow[j] = 0ull;
    }
}
__device__ __forceinline__ void dsa_topk_phase(const Frame& F, const bf16* proj, u64* mask) {
    LAS unsigned* SC = (LAS unsigned*)F.lds;
    const int lane = F.lane, w = F.wave, fr = lane & 15, fq = lane >> 4;
    for (int it = 0; it < 1024 / 256 + 1; ++it) {
        const int idx = it * F.G + F.bid; if (idx >= 1024) break;
        const int b = idx >> 7, tq0 = idx & 127; const int tq = ((idx >> 8) & 1) ? 127 - tq0 : tq0;
        const int t0 = 16 * tq; const size_t rb = (size_t)b * SEQ;
        bf16x8 qf[4][2]; float wq[4];
        { const bf16* qp = proj + (rb + t0 + fr) * PB_LD;
#pragma unroll
            for (int h = 0; h < 4; ++h) {
#pragma unroll
                for (int ks = 0; ks < 2; ++ks) qf[h][ks] = *(const bf16x8*)(qp + PB_QI + 64 * h + 32 * ks + 8 * fq);
                wq[h] = bf2f(qp[PB_WI + h]); } }
        for (int kt = w; kt <= tq; kt += NWAVES) {
            const bf16* kp = proj + (rb + 16 * kt + fr) * PB_LD + PB_KI + 8 * fq;
            const bf16x8 kf0 = *(const bf16x8*)kp, kf1 = *(const bf16x8*)(kp + 32);
            f32x4 sc = (f32x4){0.f, 0.f, 0.f, 0.f};
#pragma unroll
            for (int h = 0; h < 4; ++h) { f32x4 d = (f32x4){0.f, 0.f, 0.f, 0.f};
                d = __builtin_amdgcn_mfma_f32_16x16x32_bf16(kf0, qf[h][0], d, 0, 0, 0); d = __builtin_amdgcn_mfma_f32_16x16x32_bf16(kf1, qf[h][1], d, 0, 0, 0);
                sc.x += wq[h] * fmaxf(d.x, 0.f); sc.y += wq[h] * fmaxf(d.y, 0.f); sc.z += wq[h] * fmaxf(d.z, 0.f); sc.w += wq[h] * fmaxf(d.w, 0.f); }
            u32x4 o; o.x = sortable(sc.x); o.y = sortable(sc.y); o.z = sortable(sc.z); o.w = sortable(sc.w);
            *(LAS u32x4*)(SC + fr * 2048 + 16 * kt + 4 * fq) = o;
        }
        __syncthreads();
        for (int qq = 0; qq < 2; ++qq) {
            const int ql = 2 * w + qq, t = t0 + ql;
            u64* mrow = mask + (rb + t) * 32;
            const int nj8 = (t >> 9) + 1;
            if (nj8 == 1) dsa_select<8>(SC + ql * 2048, t, lane, mrow);
            else if (nj8 == 2) dsa_select<16>(SC + ql * 2048, t, lane, mrow);
            else if (nj8 == 3) dsa_select<24>(SC + ql * 2048, t, lane, mrow);
            else dsa_select<32>(SC + ql * 2048, t, lane, mrow);
        }
        __syncthreads();
    }
}
template <int DK> struct AttnCfg { static constexpr int KP = DK + 8, VP = 96  , KBYTES = 64 * KP * 2, VBYTES = 64 * VP * 2, BUF = KBYTES + VBYTES; };
struct AttnArgs { const bf16* Q; int ldq, qoff;
                  const bf16* K1; int ldk1, k1off, k1hs;
                  const bf16* K2; int ldk2;
                  const bf16* V; int ldv, voff, vhs;
                  bf16* O;
                  const u64* mask;
                  const float* ang; };
__device__ __forceinline__ int crow(int r, int hi) { return (r & 3) + 8 * (r >> 2) + 4 * hi; }
template <int DK, bool MASKED>
__device__ __forceinline__ void attn_unit(const Frame& F, const AttnArgs& A, int b, int h, int qb) {
    typedef AttnCfg<DK> C;
    const int tid = F.tid, lane = F.lane, w = F.wave, r32 = lane & 31, hi = lane >> 5;
    const size_t rb = (size_t)b * SEQ; const int q0 = qb * 256, qrow = q0 + 32 * w + r32;
    const int NT = (q0 + 256) / 64;
    constexpr int NKS = DK / 16;
    bf16x8 qf[NKS];
    { const bf16* qp = A.Q + (rb + qrow) * A.ldq + A.qoff + h * DK + 8 * hi;
#pragma unroll
        for (int ks = 0; ks < NKS; ++ks) qf[ks] = *(const bf16x8*)(qp + 16 * ks); }
    if constexpr (DK == 96) {
        const float* ap = A.ang + (rb + qrow) * 32 + 16 * hi;
        const u32x4 w1 = __builtin_bit_cast(u32x4, qf[4]), w2 = __builtin_bit_cast(u32x4, qf[5]); u32x4 o1, o2;
#pragma unroll
        for (int e = 0; e < 4; ++e) { const f32x4 cs = *(const f32x4*)(ap + 4 * e);
            const float a0 = bflo(w1[e]), a1 = bfhi(w1[e]), b0 = bflo(w2[e]), b1 = bfhi(w2[e]);
            o1[e] = cvt_pk_bf16(a0 * cs.x - b0 * cs.y, a1 * cs.z - b1 * cs.w); o2[e] = cvt_pk_bf16(b0 * cs.x + a0 * cs.y, b1 * cs.z + a1 * cs.w); }
        qf[4] = __builtin_bit_cast(bf16x8, o1); qf[5] = __builtin_bit_cast(bf16x8, o2);
    }
    const int skey = tid >> 3, sch = tid & 7;
    const int skey2 = (tid + 512) / 12, sch2 = (tid + 512) % 12;
    const int skey1 = (DK == 96) ? tid / 12 : skey, sch1 = (DK == 96) ? tid % 12 : sch;
    u32x4 kreg0, kreg1 = (u32x4){0u, 0u, 0u, 0u}, vreg; u64 mw = 0ull;
#define ATT_LOAD_TILE(kt_) do { const size_t kr = rb + 64 * (kt_); \
        if (DK == 64) { kreg0 = *(const u32x4*)(A.K1 + (kr + skey) * A.ldk1 + A.k1off + h * A.k1hs + 8 * sch); } \
        else { \
            kreg0 = (sch1 < 8) ? *(const u32x4*)(A.K1 + (kr + skey1) * A.ldk1 + A.k1off + h * A.k1hs + 8 * sch1) : *(const u32x4*)(A.K2 + (kr + skey1) * A.ldk2 + 8 * (sch1 - 8)); \
            if (tid < 256) kreg1 = (sch2 < 8) ? *(const u32x4*)(A.K1 + (kr + skey2) * A.ldk1 + A.k1off + h * A.k1hs + 8 * sch2) : *(const u32x4*)(A.K2 + (kr + skey2) * A.ldk2 + 8 * (sch2 - 8)); \
        } \
        vreg = *(const u32x4*)(A.V + (kr + skey) * A.ldv + A.voff + h * A.vhs + 8 * sch); \
        if (MASKED) mw = A.mask[(rb + qrow) * 32 + (kt_)]; } while (0)
#define ATT_STORE_TILE(buf_) do { LAS unsigned char* base = F.lds + (buf_) * C::BUF; \
        *(LAS u32x4*)(base + (skey1 * C::KP + 8 * sch1) * 2) = kreg0; \
        if (DK == 96) { if (tid < 256) *(LAS u32x4*)(base + (skey2 * C::KP + 8 * sch2) * 2) = kreg1; } \
        *(LAS u32x4*)(base + C::KBYTES + (skey * C::VP + 8 * sch) * 2) = vreg; } while (0)
    float m_run = -1.0e30f, l_run = 0.f; f32x16 o0 = {}, o1 = {};
    ATT_LOAD_TILE(0); u64 mcur = mw; ATT_STORE_TILE(0); __syncthreads();
    const int wq_max = q0 + 32 * w + 31, wq_min = q0 + 32 * w;
    for (int kt = 0; kt < NT; ++kt) {
        if (kt + 1 < NT) ATT_LOAD_TILE(kt + 1);
        if (64 * kt <= wq_max) {
            const LAS unsigned char* kb = F.lds + (kt & 1) * C::BUF; const LAS unsigned char* vb = kb + C::KBYTES;
            const float NEG = -1.0e30f;
            f32x16 p0 = {}, p1 = {};
            if (MASKED) { const int nlo = (int)~((unsigned)mcur >> (4 * hi)), nhh = (int)~((unsigned)(mcur >> 32) >> (4 * hi));
#pragma unroll
                for (int r = 0; r < 16; ++r) { const unsigned bitp = (r & 3) + 8 * (r >> 2);
                    p0[r] = __int_as_float(__builtin_amdgcn_sbfe(nlo, bitp, 1u) & (int)0xF149F2CA); p1[r] = __int_as_float(__builtin_amdgcn_sbfe(nhh, bitp, 1u) & (int)0xF149F2CA); }
            } else if (64 * kt + 63 > wq_min) {
#pragma unroll
                for (int r = 0; r < 16; ++r) { const int kv = 64 * kt + crow(r, hi); p0[r] = (kv <= qrow) ? 0.f : NEG; p1[r] = (kv + 32 <= qrow) ? 0.f : NEG; }
            }
#pragma unroll
            for (int ks = 0; ks < NKS; ++ks) {
                const bf16x8 a0 = *(const LAS bf16x8*)(kb + (r32 * C::KP + 16 * ks + 8 * hi) * 2), a1 = *(const LAS bf16x8*)(kb + ((32 + r32) * C::KP + 16 * ks + 8 * hi) * 2);
                p0 = __builtin_amdgcn_mfma_f32_32x32x16_bf16(a0, qf[ks], p0, 0, 0, 0); p1 = __builtin_amdgcn_mfma_f32_32x32x16_bf16(a1, qf[ks], p1, 0, 0, 0);
            }
            f32x16 pm = __builtin_elementwise_max(p0, p1);
            float mx = fmaxf(fmaxf(fmaxf(pm[0], pm[1]), fmaxf(pm[2], pm[3])), fmaxf(fmaxf(pm[4], pm[5]), fmaxf(pm[6], pm[7])));
            mx = fmaxf(mx, fmaxf(fmaxf(fmaxf(pm[8], pm[9]), fmaxf(pm[10], pm[11])), fmaxf(fmaxf(pm[12], pm[13]), fmaxf(pm[14], pm[15]))));
            { auto rr = __builtin_amdgcn_permlane32_swap(__float_as_uint(mx), __float_as_uint(mx), false, false); mx = fmaxf(__uint_as_float(rr[0]), __uint_as_float(rr[1])); }
            const float m_new = fmaxf(m_run, mx);
            if (__any(m_new != m_run)) { const float alpha = fast_exp2(m_run - m_new); l_run *= alpha; o0 = o0 * alpha; o1 = o1 * alpha; }
            m_run = m_new;
            p0 = p0 - m_new; p1 = p1 - m_new;
#pragma unroll
            for (int r = 0; r < 16; ++r) { p0[r] = fast_exp2(p0[r]); p1[r] = fast_exp2(p1[r]); }
            { const f32x16 ps = p0 + p1; l_run += ((ps[0] + ps[1]) + (ps[2] + ps[3])) + ((ps[4] + ps[5]) + (ps[6] + ps[7])) + (((ps[8] + ps[9]) + (ps[10] + ps[11])) + ((ps[12] + ps[13]) + (ps[14] + ps[15]))); }
            bf16x8 pk[4];
#pragma unroll
            for (int s = 0; s < 2; ++s) {
                u32x4 a; a.x = cvt_pk_bf16(p0[8 * s + 0], p0[8 * s + 1]); a.y = cvt_pk_bf16(p0[8 * s + 2], p0[8 * s + 3]); a.z = cvt_pk_bf16(p0[8 * s + 4], p0[8 * s + 5]); a.w = cvt_pk_bf16(p0[8 * s + 6], p0[8 * s + 7]);
                u32x4 c; c.x = cvt_pk_bf16(p1[8 * s + 0], p1[8 * s + 1]); c.y = cvt_pk_bf16(p1[8 * s + 2], p1[8 * s + 3]); c.z = cvt_pk_bf16(p1[8 * s + 4], p1[8 * s + 5]); c.w = cvt_pk_bf16(p1[8 * s + 6], p1[8 * s + 7]);
                pk[s] = __builtin_bit_cast(bf16x8, a); pk[2 + s] = __builtin_bit_cast(bf16x8, c); }
            const int gi = (lane >> 4) & 1, q4 = (lane & 15) >> 2, p4 = lane & 3;
            const LAS unsigned char* vlane = vb + ((4 * hi + q4) * C::VP + 16 * gi + 4 * p4) * 2;
#pragma unroll
            for (int s4 = 0; s4 < 4; ++s4) {
#pragma unroll
                for (int db = 0; db < 2; ++db) {
                    const s16x4 lo4 = __builtin_bit_cast(s16x4, __builtin_amdgcn_ds_read_tr16_b64_v4i16((LAS s16x4*)(vlane + ((16 * s4) * C::VP + 32 * db) * 2)));
                    const s16x4 hi4 = __builtin_bit_cast(s16x4, __builtin_amdgcn_ds_read_tr16_b64_v4i16((LAS s16x4*)(vlane + ((16 * s4 + 8) * C::VP + 32 * db) * 2)));
                    const bf16x8 vf = (bf16x8){lo4[0], lo4[1], lo4[2], lo4[3], hi4[0], hi4[1], hi4[2], hi4[3]};
                    if (db == 0) o0 = __builtin_amdgcn_mfma_f32_32x32x16_bf16(vf, pk[s4], o0, 0, 0, 0); else o1 = __builtin_amdgcn_mfma_f32_32x32x16_bf16(vf, pk[s4], o1, 0, 0, 0);
                }
            }
        }
        if (kt + 1 < NT) { ATT_STORE_TILE((kt + 1) & 1); mcur = mw; }
        __syncthreads();
    }
    { auto rr = __builtin_amdgcn_permlane32_swap(__float_as_uint(l_run), __float_as_uint(l_run), false, false); l_run = __uint_as_float(rr[0]) + __uint_as_float(rr[1]); }
    const float inv = 1.0f / l_run;
    bf16* op = A.O + (rb + qrow) * D + h * 64 + 4 * hi;
#pragma unroll
    for (int g4 = 0; g4 < 4; ++g4) {
        u32x2 a; a.x = cvt_pk_bf16(o0[4 * g4 + 0] * inv, o0[4 * g4 + 1] * inv); a.y = cvt_pk_bf16(o0[4 * g4 + 2] * inv, o0[4 * g4 + 3] * inv);
        u32x2 c; c.x = cvt_pk_bf16(o1[4 * g4 + 0] * inv, o1[4 * g4 + 1] * inv); c.y = cvt_pk_bf16(o1[4 * g4 + 2] * inv, o1[4 * g4 + 3] * inv);
        *(u32x2*)(op + 8 * g4) = a; *(u32x2*)(op + 32 + 8 * g4) = c;
    }
}
#undef ATT_LOAD_TILE
#undef ATT_STORE_TILE
template <int DK, bool MASKED>
__device__ __forceinline__ void attn_phase(const Frame& F, const AttnArgs& A) {
    for (int i = 0; i < 4; ++i) {
        const int u = i * F.G + F.bid; if (u >= 1024) break;
        const int bh = u >> 3, qp = u & 7, qb = ((u >> 8) & 1) ? 7 - qp : qp;
        attn_unit<DK, MASKED>(F, A, bh >> 4, bh & 15, qb);
    }
}
constexpr int HG_QS = 136, HG_HS = 72, HG_VS = 72, HG_SS = 136;
constexpr int HG_QT = 0, HG_KT = HG_QT + 64 * HG_QS * 2, HG_KH = HG_KT + 64 * HG_QS * 2, HG_VT = HG_KH + 128 * HG_HS * 2, HG_SB = HG_VT + 32 * HG_VS * 2,
              HG_GL = HG_SB + 2 * 32 * HG_SS * 2, HG_SEG = HG_GL + 512, HG_END = HG_SEG + 4 * 128 * 4;
static_assert(HG_END <= RING_BYTES, "hgrn2 LDS");
__device__ __forceinline__ void hgrn2_scan_phase(const Frame& F, const bf16* proj, const float* lb_logits  , float* opre  ) {
    LAS bf16* Qt = (LAS bf16*)(F.lds + HG_QT); LAS bf16* Kt = (LAS bf16*)(F.lds + HG_KT); LAS bf16* Kh = (LAS bf16*)(F.lds + HG_KH); LAS bf16* Vt = (LAS bf16*)(F.lds + HG_VT);
    LAS bf16* Sb = (LAS bf16*)(F.lds + HG_SB); LAS float* GL = (LAS float*)(F.lds + HG_GL); LAS float* SEG = (LAS float*)(F.lds + HG_SEG);
    const int tid = F.tid, lane = F.lane, w = F.wave, fr = lane & 15, fq = lane >> 4;
    for (int u = F.bid; u < 256; u += F.G) {
        const int b = u >> 5, h = (u >> 2) & 7, vq = u & 3;
        const size_t rb = (size_t)b * SEQ;
        const int k = tid & 127, tseg = tid >> 7;
        float lbv; { const int c = 128 * h + k; const float a0 = lb_logits[c], a1 = lb_logits[1024 + c], a2 = lb_logits[2048 + c], a3 = lb_logits[3072 + c];
            const float mx = fmaxf(fmaxf(a0, a1), fmaxf(a2, a3)); const float e0 = __expf(a0 - mx), e1 = __expf(a1 - mx), e2 = __expf(a2 - mx), e3 = __expf(a3 - mx);
            lbv = (e1 + e2) / (e0 + e1 + e2 + e3); }
        f32x4 sacc[2]; sacc[0] = (f32x4){0.f, 0.f, 0.f, 0.f}; sacc[1] = sacc[0];
        for (int i = tid; i < 2 * 32 * HG_SS / 2; i += NTHREADS) ((LAS unsigned*)Sb)[i] = 0u;
        const int vt = w & 1, tt = w >> 1;
        unsigned short rq[16], rf[16], rv[8];
#define HG_FETCH(cc) do { const size_t r0_ = rb + 64 * (cc); const bf16* pp_ = proj + (r0_ + 16 * tseg) * 4096 + 128 * h + k; \
            _Pragma("unroll") for (int j = 0; j < 16; ++j) { rq[j] = pp_[(size_t)j * 4096]; rf[j] = pp_[(size_t)j * 4096 + 1024]; } \
            if (tid < 256) { const bf16* vp_ = proj + (r0_ + 8 * (tid & 7)) * 4096 + 2048 + 128 * h + 32 * vq + (tid >> 3); \
                _Pragma("unroll") for (int j = 0; j < 8; ++j) rv[j] = vp_[(size_t)j * 4096]; } } while (0)
        HG_FETCH(0);
        for (int c = 0; c < 32; ++c) {
            const size_t r0 = rb + 64 * c;
            float gl[16], kk[16], qv[16];
            { float run = 0.f;
#pragma unroll
                for (int j = 0; j < 16; ++j) { const float fp = bf2f(rf[j]); qv[j] = bf2f(rq[j]);
                    const float sg = sigmoidf_(fp); const float f = lbv + (1.f - lbv) * sg; kk[j] = (1.f - lbv) * (1.f - sg); run += __logf(f); gl[j] = run; }
                SEG[tseg * 128 + k] = run; }
            if (tid < 256) { const int so = tid & 7, v = tid >> 3;
                u32x4 o; o.x = (unsigned)rv[0] | ((unsigned)rv[1] << 16); o.y = (unsigned)rv[2] | ((unsigned)rv[3] << 16);
                o.z = (unsigned)rv[4] | ((unsigned)rv[5] << 16); o.w = (unsigned)rv[6] | ((unsigned)rv[7] << 16);
                *(LAS u32x4*)(Vt + v * HG_VS + 8 * so) = o; }
            if (c + 1 < 32) HG_FETCH(c + 1);
            LDS_BARRIER();
            { float off = 0.f, tot = 0.f;
#pragma unroll
                for (int s = 0; s < 4; ++s) { const float sv = SEG[s * 128 + k]; off += (s < tseg) ? sv : 0.f; tot += sv; }
                if (tseg == 0) GL[k] = tot;
                unsigned kh[8];
#pragma unroll
                for (int j = 0; j < 16; ++j) { const float G = off + gl[j]; const float eg = __expf(G);
                    const float qs = qv[j] * eg, ks = kk[j] * __expf(-G), khv = kk[j] * __expf(tot - G);
                    Qt[(16 * tseg + j) * HG_QS + k] = (bf16)(cvt_pk_bf16(qs, 0.f) & 0xffffu); Kt[(16 * tseg + j) * HG_QS + k] = (bf16)(cvt_pk_bf16(ks, 0.f) & 0xffffu);
                    if (j & 1) kh[j >> 1] = (kh[j >> 1] & 0xffffu) | (cvt_pk_bf16(0.f, khv) & 0xffff0000u); else kh[j >> 1] = cvt_pk_bf16(khv, 0.f) & 0xffffu; }
                *(LAS u32x4*)(Kh + k * HG_HS + 16 * tseg) = (u32x4){kh[0], kh[1], kh[2], kh[3]}; *(LAS u32x4*)(Kh + k * HG_HS + 16 * tseg + 8) = (u32x4){kh[4], kh[5], kh[6], kh[7]}; }
            LDS_BARRIER();
            const LAS bf16* Sbc = Sb + (c & 1) * 32 * HG_SS; LAS bf16* Sbn = Sb + ((c + 1) & 1) * 32 * HG_SS;
            bf16x8 bq[4];
#pragma unroll
            for (int ks = 0; ks < 4; ++ks) bq[ks] = *(const LAS bf16x8*)(Qt + (16 * tt + fr) * HG_QS + 32 * ks + 8 * fq);
            f32x4 sc[4];
#pragma unroll
            for (int st = 0; st < 4; ++st) { sc[st] = (f32x4){0.f, 0.f, 0.f, 0.f};
                if (st <= tt) {
#pragma unroll
                    for (int ks = 0; ks < 4; ++ks) { const bf16x8 ka = *(const LAS bf16x8*)(Kt + (16 * st + fr) * HG_QS + 32 * ks + 8 * fq); sc[st] = __builtin_amdgcn_mfma_f32_16x16x32_bf16(ka, bq[ks], sc[st], 0, 0, 0); }
                    if (st == tt) {
#pragma unroll
                        for (int i = 0; i < 4; ++i) if (4 * fq + i > fr) sc[st][i] = 0.f; } } }
            f32x4 oacc = (f32x4){0.f, 0.f, 0.f, 0.f};
#pragma unroll
            for (int m = 0; m < 2; ++m) {
                u32x4 pw; pw.x = cvt_pk_bf16(sc[2 * m][0], sc[2 * m][1]); pw.y = cvt_pk_bf16(sc[2 * m][2], sc[2 * m][3]); pw.z = cvt_pk_bf16(sc[2 * m + 1][0], sc[2 * m + 1][1]); pw.w = cvt_pk_bf16(sc[2 * m + 1][2], sc[2 * m + 1][3]);
                const LAS bf16* vp = Vt + (16 * vt + fr) * HG_VS + 32 * m + 4 * fq;
                const u32x2 va = *(const LAS u32x2*)vp, vb = *(const LAS u32x2*)(vp + 16);
                const bf16x8 vf = __builtin_bit_cast(bf16x8, (u32x4){va.x, va.y, vb.x, vb.y});
                oacc = __builtin_amdgcn_mfma_f32_16x16x32_bf16(vf, __builtin_bit_cast(bf16x8, pw), oacc, 0, 0, 0);
            }
#pragma unroll
            for (int ks = 0; ks < 4; ++ks) { const bf16x8 sa = *(const LAS bf16x8*)(Sbc + (16 * vt + fr) * HG_SS + 32 * ks + 8 * fq); oacc = __builtin_amdgcn_mfma_f32_16x16x32_bf16(sa, bq[ks], oacc, 0, 0, 0); }
            *(f32x4*)(opre + (r0 + 16 * tt + fr) * D + 128 * h + 32 * vq + 16 * vt + 4 * fq) = oacc;
#pragma unroll
            for (int x = 0; x < 2; ++x) { const int kt = tt + 4 * x;
                const f32x4 dec = *(const LAS f32x4*)(GL + 16 * kt + 4 * fq);
                f32x4 a = sacc[x]; a.x *= __expf(dec.x); a.y *= __expf(dec.y); a.z *= __expf(dec.z); a.w *= __expf(dec.w);
#pragma unroll
                for (int m = 0; m < 2; ++m) { const bf16x8 ka = *(const LAS bf16x8*)(Kh + (16 * kt + fr) * HG_HS + 32 * m + 8 * fq), vbf = *(const LAS bf16x8*)(Vt + (16 * vt + fr) * HG_VS + 32 * m + 8 * fq);
                    a = __builtin_amdgcn_mfma_f32_16x16x32_bf16(ka, vbf, a, 0, 0, 0); }
                sacc[x] = a;
                u32x2 o; o.x = cvt_pk_bf16(a.x, a.y); o.y = cvt_pk_bf16(a.z, a.w);
                *(LAS u32x2*)(Sbn + (16 * vt + fr) * HG_SS + 16 * kt + 4 * fq) = o; }
            LDS_BARRIER();
        }
#undef HG_FETCH
    }
}
__device__ __forceinline__ void hgrn2_norm_phase(const Frame& F, const float* opre, const bf16* proj, const float* ng, bf16* ob) {
    const int gw = F.bid * NWAVES + F.wave, NGW = F.G * NWAVES, lane = F.lane;
    for (int r = gw; r < M; r += NGW) {
#pragma unroll
        for (int j = 0; j < 4; ++j) { const int col = 4 * lane + 256 * j; const f32x4 v = *(const f32x4*)(opre + (size_t)r * D + col);
            float ss = (v.x * v.x + v.y * v.y) + (v.z * v.z + v.w * v.w);
            ss = half_sum32(ss, lane);
            const float rs = __builtin_amdgcn_rsqf(ss * (1.f / 128.f) + RMS_EPS);
            const f32x4 g4 = *(const f32x4*)(ng + (col & 127)); const u32x2 gt = *(const u32x2*)(proj + (size_t)r * 4096 + 3072 + col);
            u32x2 o; o.x = cvt_pk_bf16(v.x * rs * g4.x * siluf_(bflo(gt.x)), v.y * rs * g4.y * siluf_(bfhi(gt.x))); o.y = cvt_pk_bf16(v.z * rs * g4.z * siluf_(bflo(gt.y)), v.w * rs * g4.w * siluf_(bfhi(gt.y)));
            *(u32x2*)(ob + (size_t)r * D + col) = o; }
    }
}
__device__ __forceinline__ void mla_norm_phase(const Frame& F, const float* projd, const int* positions, const float* qg, const float* kvg, bf16* cq, bf16* ckv, bf16* kr, float* ang) {
    const int gw = F.bid * NWAVES + F.wave, NGW = F.G * NWAVES, lane = F.lane;
    for (int r = gw; r < M; r += NGW) {
        const f32x4 a = *(const f32x4*)(projd + (size_t)r * 512 + 8 * lane), c = *(const f32x4*)(projd + (size_t)r * 512 + 8 * lane + 4);
        float x[8] = {a.x, a.y, a.z, a.w, c.x, c.y, c.z, c.w};
        float ss = 0.f;
#pragma unroll
        for (int i = 0; i < 8; ++i) ss += x[i] * x[i];
        const float s16 = row_sum16(ss);
        const float s32 = rdlane(s16, 0) + rdlane(s16, 16);
        float px[8];
#pragma unroll
        for (int i = 0; i < 8; ++i) px[i] = dppmov<0x4E>(x[i]);
        if (lane < 32) {
            const float rs = __builtin_amdgcn_rsqf(s32 * (1.f / 256.f) + RMS_EPS);
            const f32x4 g0 = *(const f32x4*)(qg + 8 * lane), g1 = *(const f32x4*)(qg + 8 * lane + 4);
            u32x4 o; o.x = cvt_pk_bf16(x[0] * rs * g0.x, x[1] * rs * g0.y); o.y = cvt_pk_bf16(x[2] * rs * g0.z, x[3] * rs * g0.w); o.z = cvt_pk_bf16(x[4] * rs * g1.x, x[5] * rs * g1.y); o.w = cvt_pk_bf16(x[6] * rs * g1.z, x[7] * rs * g1.w);
            *(u32x4*)(cq + (size_t)r * 256 + 8 * lane) = o;
        } else if (lane < 48) {
            const int l2 = lane - 32; const float rs = __builtin_amdgcn_rsqf(s16 * (1.f / 128.f) + RMS_EPS);
            const f32x4 g0 = *(const f32x4*)(kvg + 8 * l2), g1 = *(const f32x4*)(kvg + 8 * l2 + 4);
            u32x4 o; o.x = cvt_pk_bf16(x[0] * rs * g0.x, x[1] * rs * g0.y); o.y = cvt_pk_bf16(x[2] * rs * g0.z, x[3] * rs * g0.w); o.z = cvt_pk_bf16(x[4] * rs * g1.x, x[5] * rs * g1.y); o.w = cvt_pk_bf16(x[6] * rs * g1.z, x[7] * rs * g1.w);
            *(u32x4*)(ckv + (size_t)r * 256 + 8 * l2) = o;
        } else {
            *(u32x4*)(ckv + (size_t)r * 256 + 128 + 8 * (lane - 48)) = (u32x4){0u, 0u, 0u, 0u};
            if (lane < 52) {
                const int l3 = lane - 48, i0 = 8 * (l3 & 1); const bool second = l3 >= 2; const float pos = (float)positions[r];
                float outv[8];
#pragma unroll
                for (int i = 0; i < 8; ++i) { const float invf = fast_exp2(-(float)(i0 + i) * (13.287712379549449f / 16.f)); const float an = pos * invf; float rev = an * 0.15915494309189535f; rev = rev - floorf(rev); const float cs = __builtin_amdgcn_cosf(rev), sn = __builtin_amdgcn_sinf(rev);
                    outv[i] = second ? (x[i] * cs + px[i] * sn) : (x[i] * cs - px[i] * sn);
                    if (!second) { ang[(size_t)r * 32 + 2 * (i0 + i)] = cs; ang[(size_t)r * 32 + 2 * (i0 + i) + 1] = sn; } }
                u32x4 o; o.x = cvt_pk_bf16(outv[0], outv[1]); o.y = cvt_pk_bf16(outv[2], outv[3]); o.z = cvt_pk_bf16(outv[4], outv[5]); o.w = cvt_pk_bf16(outv[6], outv[7]);
                *(u32x4*)(kr + (size_t)r * 32 + 8 * l3) = o;
            }
        }
    }
}
__device__ __forceinline__ void mla_qrope_phase(const Frame& F, bf16* q, const float* ang) {
    const int gw = F.bid * NWAVES + F.wave, NGW = F.G * NWAVES, lane = F.lane;
    const int hh = lane >> 2, part = lane & 3, i0 = 8 * (part & 1); const bool second = part >= 2;
    for (int r = gw; r < M; r += NGW) {
        bf16* p = q + (size_t)r * 1536 + 96 * hh + 64 + 8 * part;
        const u32x4 wv = *(const u32x4*)p;
        float x[8] = {bflo(wv.x), bfhi(wv.x), bflo(wv.y), bfhi(wv.y), bflo(wv.z), bfhi(wv.z), bflo(wv.w), bfhi(wv.w)};
        float outv[8];
#pragma unroll
        for (int i = 0; i < 8; ++i) { const float px = __shfl_xor(x[i], 2); const f32x2 cssn = *(const f32x2*)(ang + (size_t)r * 32 + 2 * (i0 + i));
            outv[i] = second ? (x[i] * cssn.x + px * cssn.y) : (x[i] * cssn.x - px * cssn.y); }
        u32x4 o; o.x = cvt_pk_bf16(outv[0], outv[1]); o.y = cvt_pk_bf16(outv[2], outv[3]); o.z = cvt_pk_bf16(outv[4], outv[5]); o.w = cvt_pk_bf16(outv[6], outv[7]);
        *(u32x4*)p = o;
    }
}
constexpr int NPHASE = 36;
#ifndef MK_ONE_LAUNCH
#define MK_ONE_LAUNCH 1
#endif
#ifndef MK_DUP
#define MK_DUP 0ull
#endif
#ifndef MK_NRUN
#define MK_NRUN NPHASE
#endif
__device__ __forceinline__ void prologue_phase(const Frame& F, const Args& args, unsigned char* ws, bf16* XB) {
#define INP(i) ((const float*)args.in[i])

        convert_matrix(F, INP(I_A_WIN), 1024, 4096, (bf16*)(ws + W_A_IN), 1024, 4096, 0, 1);
        convert_matrix(F, INP(I_A_WOUT), 2048, 1024, (bf16*)(ws + W_A_OUT), 2048, 1024, 0, 1);
        convert_matrix(F, INP(I_B_WIN), 1024, 3396, (bf16*)(ws + W_B_IN), 1024, 3584, 0, 1);
        convert_matrix(F, INP(I_B_WOUT), 1024, 1024, (bf16*)(ws + W_B_OUT), 1024, 1024, 0, 1);
        convert_matrix(F, INP(I_C_WIN), 1024, 4096, (bf16*)(ws + W_C_IN), 1024, 4096, 0, 1);
        convert_matrix(F, INP(I_C_WOUT), 1024, 1024, (bf16*)(ws + W_C_OUT), 1024, 1024, 0, 1);
        convert_matrix(F, INP(I_D_WIN), 1024, 416, (bf16*)(ws + W_D_IN), 1024, 512, 0, 1);
        convert_matrix(F, INP(I_D_WUQ), 256, 1536, (bf16*)(ws + W_D_UQ), 256, 1536, 0, 1);
        convert_matrix(F, INP(I_D_WUKV), 128, 2048, (bf16*)(ws + W_D_UKV), 256, 2048, 0, 1);
        convert_matrix(F, INP(I_D_WOUT), 1024, 1024, (bf16*)(ws + W_D_OUT), 1024, 1024, 0, 1);
        convert_matrix(F, INP(I_F0_GU), 1024, 2 * FF, (bf16*)(ws + W_F0_GU), 1024, 2 * FF, 1, 1);
        convert_matrix(F, INP(I_F0_DN), FF, 1024, (bf16*)(ws + W_F0_DN), FF, 1024, 0, 1);
        convert_matrix(F, INP(I_F2_GU), 1024, 2 * FF, (bf16*)(ws + W_F2_GU), 1024, 2 * FF, 1, 1);
        convert_matrix(F, INP(I_F2_DN), FF, 1024, (bf16*)(ws + W_F2_DN), FF, 1024, 0, 1);
        convert_matrix(F, INP(I_M1_GU), 1024, 2 * FF, (bf16*)(ws + W_M1_GU), 1024, 2 * FF, 1, NE);
        convert_matrix(F, INP(I_M1_DN), FF, 1024, (bf16*)(ws + W_M1_DN), FF, 1024, 0, NE);
        cvt_rows_phase(F, INP(I_X), XB);
    #undef INP
}
__global__ void __launch_bounds__(NTHREADS, 2) fwd_kernel(Args args) {
    extern __shared__ __attribute__((aligned(16))) unsigned char lds_raw[];
    Frame F;
    F.lds = (LAS unsigned char*)lds_raw;
    F.tid = threadIdx.x; F.lane = F.tid & 63; F.wave = __builtin_amdgcn_readfirstlane(F.tid >> 6);
    F.G = gridDim.x; F.bid = blockIdx.x;
    F.ws = args.ws; F.ctl = (unsigned*)(args.ws + WS_CTL);
    unsigned char* ws = args.ws;
    const int lo = args.ph_lo, hi = args.ph_hi;
    for (int u = F.tid; u < (LDS_BYTES - LDSCTL_OFF) / 4; u += NTHREADS) ((LAS unsigned*)(F.lds + LDSCTL_OFF))[u] = 0u;
    __syncthreads();
    XcdBarrier bar; bar.bar = F.ctl + CW_BAR; bar.x = 0; bar.st = nullptr;
    const bool multi = (hi - lo) > 1;
    if (multi) bar = xcd_barrier_post(F.ctl + CW_BAR, (volatile LAS unsigned*)(F.lds + LDSCTL_OFF + 64));
#define IN(k) (lo <= (k) && (k) < hi)
#define SEAM(k) do { if (IN(k) && IN((k) + 1)) xcd_barrier(bar); } while (0)
#define DUPP(k) (((unsigned long long)(MK_DUP) >> (k)) & 1ull)
#define PHASE(k, ...) do { if (IN(k)) { __VA_ARGS__; if (DUPP(k)) { xcd_barrier(bar); __VA_ARGS__; } } SEAM(k); } while (0)
#define INP(i) ((const float*)args.in[i])
    float* XF = args.out;
    bf16* XB = (bf16*)(ws + WS_XB);
    bf16* H = (bf16*)(ws + B_H);
    bf16* OB = (bf16*)(ws + B_OB);
    bf16* XR = (bf16*)(ws + WS_R2); bf16* YK = (bf16*)(ws + WS_R2);
    LAS unsigned char* ring = F.lds;

#define GEMM(EpiT, Aptr, lda_, Bptr, Nn, Kk, epi) do { pg8::Gemm g_{(Aptr), (Bptr), M, (Nn), (Kk), (lda_), 0}; pg8::StaticOrder S_; S_.init(M, (Nn), F.G, F.bid); \
        pg8::gemm_phase<EpiT, pg8::StaticOrder>(ring, g_, S_, (epi)); } while (0)
#define FFN_DENSE(p0, WGU, WDN, lg, lb) do { \
        PHASE(p0, GEMM(pg8::EpiSwiGLU, XB, D, (const bf16*)(ws + (WGU)), 2 * FF, D, (pg8::EpiSwiGLU{H, FF}));); \
        PHASE((p0) + 1, GEMM(pg8::EpiResid, H, FF, (const bf16*)(ws + (WDN)), D, FF, (pg8::EpiResid{XB, XF, ALPHA}));); \
        PHASE((p0) + 2, ln_phase(F, XF, XB, (lg), (lb));); } while (0)
#define FFN_MOE(p0, slot_, WR, WGU, WDN, lmg, lmb, lfg, lfb, OUTF) do { \
        unsigned* cnt_ = F.ctl + CW_CNT + (slot_) * 512; \
        PHASE(p0, ln_route_phase(F, XF, XB, (lmg), (lmb), (WR), cnt_);); \
        PHASE((p0) + 1, moe_gather_phase(F, XB, XR, cnt_);); \
        PHASE((p0) + 2, int cv_[NE], ps_[NE]; pg8::MoeOrder S_; const int rows_ = moe_segments(cnt_, cv_, ps_, S_.pend); S_.so.init(rows_, 2 * FF, F.G, F.bid); \
            pg8::Gemm g_{XR, (const bf16*)(ws + (WGU)), rows_, 2 * FF, D, D, (size_t)2 * FF * D}; pg8::gemm_phase<pg8::EpiSwiGLU, pg8::MoeOrder>(ring, g_, S_, pg8::EpiSwiGLU{H, FF});); \
        PHASE((p0) + 3, int cv_[NE], ps_[NE]; pg8::MoeOrder S_; const int rows_ = moe_segments(cnt_, cv_, ps_, S_.pend); S_.so.init(rows_, D, F.G, F.bid); \
            pg8::Gemm g_{H, (const bf16*)(ws + (WDN)), rows_, D, FF, FF, (size_t)D * FF}; \
            pg8::gemm_phase<pg8::EpiMoeDown, pg8::MoeOrder>(ring, g_, S_, pg8::EpiMoeDown{YK, (const int*)(ws + S_ROWTOK), (const float*)(ws + S_ROWGATE)}); \
            if ((slot_) == 0) {   \
                const int nwg_ = S_.so.nwg; int n3_ = ((nwg_ - 1) % F.G) + 1; if (n3_ >= F.G) n3_ = 0; \
                if (F.bid >= n3_) { const int gw_ = (F.bid - n3_) * NWAVES + F.wave, ngw_ = (F.G - n3_) * NWAVES; \
                    convert_matrix_g(F, gw_, ngw_, INP(I_M3_GU), 1024, 2 * FF, (bf16*)(ws + W_M3_GU), 1024, 2 * FF, 1, NE); \
                    convert_matrix_g(F, gw_, ngw_, INP(I_M3_DN), FF, 1024, (bf16*)(ws + W_M3_DN), FF, 1024, 0, NE); } }); \
        PHASE((p0) + 4, ln_moe_phase(F, YK, (OUTF), XB, (lfg), (lfb));); } while (0)

    PHASE(0, prologue_phase(F, args, ws, XB););
    { bf16* UV = (bf16*)(ws + B_UV); bf16* GATED = (bf16*)(ws + B_GATED); float* STATS = (float*)(ws + S_STATS);
      PHASE(1, GEMM(pg8::EpiBf16<1>, XB, D, (const bf16*)(ws + W_A_IN), 4096, D, (pg8::EpiBf16<1>{UV, 4096, 1.f, 0})););
      PHASE(2, gmlp_stats_phase(F, UV, STATS););
      PHASE(3, gmlp_spatial_phase(F, UV, STATS, INP(I_A_WS), INP(I_A_BS), INP(I_A_LNG), INP(I_A_LNB), GATED););
      PHASE(4, GEMM(pg8::EpiResid, GATED, 2048, (const bf16*)(ws + W_A_OUT), D, 2048, (pg8::EpiResid{XB, XF, ALPHA})););
      PHASE(5, ln_phase(F, XF, XB, INP(I_LNM_G), INP(I_LNM_B));); }
    FFN_DENSE(6, W_F0_GU, W_F0_DN, INP(I_LNF_G), INP(I_LNF_B));
    { bf16* PROJ = (bf16*)(ws + B_PROJB); u64* MASK = (u64*)(ws + S_MASK);
      PHASE(9, GEMM(pg8::EpiBf16<0>, XB, D, (const bf16*)(ws + W_B_IN), 3584, D, (pg8::EpiBf16<0>{PROJ, 3584, 0.125f * 1.4426950408889634f, 4})););
      PHASE(10, dsa_topk_phase(F, PROJ, MASK););
      PHASE(11, AttnArgs A; A.Q = PROJ; A.ldq = PB_LD; A.qoff = 0; A.K1 = PROJ; A.ldk1 = PB_LD; A.k1off = 1024; A.k1hs = 64; A.K2 = nullptr; A.ldk2 = 0; A.V = PROJ; A.ldv = PB_LD; A.voff = 2048; A.vhs = 64;
          A.O = OB; A.mask = MASK; A.ang = nullptr; attn_phase<64, true>(F, A););
      PHASE(12, GEMM(pg8::EpiResid, OB, D, (const bf16*)(ws + W_B_OUT), D, D, (pg8::EpiResid{XB, XF, ALPHA}));); }
    FFN_MOE(13, 0, INP(I_M1_R), W_M1_GU, W_M1_DN, INP(I_LNM_G) + D, INP(I_LNM_B) + D, INP(I_LNF_G) + D, INP(I_LNF_B) + D, (float*)nullptr);
    { bf16* PROJ = (bf16*)(ws + B_PROJC); float* OPRE = (float*)(ws + B_OPRE);
      PHASE(18, GEMM(pg8::EpiBf16<0>, XB, D, (const bf16*)(ws + W_C_IN), 4096, D, (pg8::EpiBf16<0>{PROJ, 4096, 1.f, 0})););
      PHASE(19, hgrn2_scan_phase(F, PROJ, INP(I_C_LB), OPRE););
      PHASE(20, hgrn2_norm_phase(F, OPRE, PROJ, INP(I_C_NG), OB););
      PHASE(21, GEMM(pg8::EpiResid, OB, D, (const bf16*)(ws + W_C_OUT), D, D, (pg8::EpiResid{XB, XF, ALPHA})););
      PHASE(22, ln_phase(F, XF, XB, INP(I_LNM_G) + 2 * D, INP(I_LNM_B) + 2 * D);); }
    FFN_DENSE(23, W_F2_GU, W_F2_DN, INP(I_LNF_G) + 2 * D, INP(I_LNF_B) + 2 * D);
    { float* PROJD = (float*)(ws + B_PROJD); bf16* CQ = (bf16*)(ws + B_CQ); bf16* CKV = (bf16*)(ws + B_CKV); bf16* Q = (bf16*)(ws + B_Q); bf16* KV = (bf16*)(ws + B_KV);
      bf16* KR = (bf16*)(ws + S_KR); float* ANG = (float*)(ws + S_ANG);
      PHASE(26, GEMM(pg8::EpiF32, XB, D, (const bf16*)(ws + W_D_IN), 512, D, (pg8::EpiF32{PROJD, 512})););
      PHASE(27, mla_norm_phase(F, PROJD, (const int*)args.in[I_POS], INP(I_D_QNG), INP(I_D_KVNG), CQ, CKV, KR, ANG););
      PHASE(28, GEMM(pg8::EpiBf16<0>, CQ, 256, (const bf16*)(ws + W_D_UQ), 1536, 256, (pg8::EpiBf16<0>{Q, 1536, 0.10206207261596577f * 1.4426950408889634f, 6}));
                    GEMM(pg8::EpiBf16<0>, CKV, 256, (const bf16*)(ws + W_D_UKV), 2048, 256, (pg8::EpiBf16<0>{KV, 2048, 1.f, 0})););
      PHASE(29, AttnArgs A; A.Q = Q; A.ldq = 1536; A.qoff = 0; A.K1 = KV; A.ldk1 = 2048; A.k1off = 0; A.k1hs = 128; A.K2 = KR; A.ldk2 = 32; A.V = KV; A.ldv = 2048; A.voff = 64; A.vhs = 128;
          A.O = OB; A.mask = nullptr; A.ang = ANG; attn_phase<96, false>(F, A););
      PHASE(30, GEMM(pg8::EpiResid, OB, D, (const bf16*)(ws + W_D_OUT), D, D, (pg8::EpiResid{XB, XF, ALPHA}));); }
    FFN_MOE(31, 1, INP(I_M3_R), W_M3_GU, W_M3_DN, INP(I_LNM_G) + 3 * D, INP(I_LNM_B) + 3 * D, INP(I_LNF_G) + 3 * D, INP(I_LNF_B) + 3 * D, args.out);
#undef IN
#undef SEAM
}

extern "C" void kernel_launch(void* const* d_in, const int* in_sizes, int n_in, void* d_out, int out_size, void* d_ws, size_t ws_size, hipStream_t stream) {
    static int grid = 0;
    if (grid == 0) {
        if (n_in != 34 || out_size != M * D || ws_size < WS_END) { fprintf(stderr, "kernel_launch: unexpected problem (n_in %d, out %d, ws %zu < %zu)\n", n_in, out_size, ws_size, (size_t)WS_END); grid = -1; return; }
        int dev = 0, cus = 0;
        if (hipGetDevice(&dev) != hipSuccess || hipDeviceGetAttribute(&cus, hipDeviceAttributeMultiprocessorCount, dev) != hipSuccess) { grid = -1; return; }
        if (hipFuncSetAttribute((const void*)fwd_kernel, hipFuncAttributeMaxDynamicSharedMemorySize, LDS_BYTES) != hipSuccess) { fprintf(stderr, "kernel_launch: hipFuncSetAttribute failed\n"); grid = -1; return; }
        int per_cu = 0;
        if (hipOccupancyMaxActiveBlocksPerMultiprocessor(&per_cu, (const void*)fwd_kernel, NTHREADS, LDS_BYTES) != hipSuccess || per_cu < 1) fprintf(stderr, "kernel_launch: occupancy query reports %d\n", per_cu);
        (void)hipGetLastError();
        grid = cus;
    }
    if (grid < 0) return;
    if (hipMemsetAsync((char*)d_ws + WS_CTL, 0, CTL_ZERO_BYTES, stream) != hipSuccess) return;
    Args a{};
    for (int i = 0; i < 34; ++i) a.in[i] = d_in[i];
    a.out = (float*)d_out; a.ws = (unsigned char*)d_ws;
#if MK_ONE_LAUNCH
    a.ph_lo = 0; a.ph_hi = MK_NRUN;
    hipLaunchKernelGGL(fwd_kernel, dim3(grid), dim3(NTHREADS), LDS_BYTES, stream, a);
#else
    for (int p = 0; p < MK_NRUN; ++p) { a.ph_lo = p; a.ph_hi = p + 1; hipLaunchKernelGGL(fwd_kernel, dim3(grid), dim3(NTHREADS), LDS_BYTES, stream, a); }
#endif
}
```

```cpp
#include <hip/hip_runtime.h>
#include <cstdio>
#include <cstdint>

#define LAS __attribute__((address_space(3)))
#define GAS __attribute__((address_space(1)))
typedef unsigned short bf16;
typedef short bf16x8 __attribute__((ext_vector_type(8)));
typedef short s16x4 __attribute__((ext_vector_type(4)));
typedef float f32x2 __attribute__((ext_vector_type(2)));
typedef float f32x4 __attribute__((ext_vector_type(4)));
typedef float f32x16 __attribute__((ext_vector_type(16)));
typedef unsigned u32x2 __attribute__((ext_vector_type(2)));
typedef unsigned u32x4 __attribute__((ext_vector_type(4)));
typedef unsigned long long u64;

constexpr int NB = 8, SEQ = 2048, D = 1024, M = NB * SEQ;
constexpr int FF = 3584, NE = 8;
constexpr int MOE_ROWS = 34816;
constexpr float ALPHA = 1.6817928305074290f;
constexpr float LN_EPS = 1e-5f, RMS_EPS = 1e-6f;
constexpr int NWAVES = 8, NTHREADS = 512;

constexpr size_t MiB = 1u << 20;
constexpr size_t WS_CTL = 0, CTL_ZERO_BYTES = 1 * MiB;
constexpr size_t WS_W0 = 1 * MiB;
constexpr size_t W_A_IN = WS_W0;
constexpr size_t W_A_OUT = W_A_IN + 8 * MiB;
constexpr size_t W_B_IN = W_A_OUT + 4 * MiB;
constexpr size_t W_B_OUT = W_B_IN + 7 * MiB;
constexpr size_t W_C_IN = W_B_OUT + 2 * MiB;
constexpr size_t W_C_OUT = W_C_IN + 8 * MiB;
constexpr size_t W_D_IN = W_C_OUT + 2 * MiB;
constexpr size_t W_D_UQ = W_D_IN + 1 * MiB;
constexpr size_t W_D_UKV = W_D_UQ + 1 * MiB;
constexpr size_t W_D_OUT = W_D_UKV + 1 * MiB;
constexpr size_t W_F0_GU = W_D_OUT + 2 * MiB;
constexpr size_t W_F0_DN = W_F0_GU + 14 * MiB;
constexpr size_t W_F2_GU = W_F0_DN + 7 * MiB;
constexpr size_t W_F2_DN = W_F2_GU + 14 * MiB;
constexpr size_t W_M1_GU = W_F2_DN + 7 * MiB;
constexpr size_t W_M1_DN = W_M1_GU + 112 * MiB;
constexpr size_t W_M3_GU = W_M1_DN + 56 * MiB;
constexpr size_t W_M3_DN = W_M3_GU + 112 * MiB;
constexpr size_t WS_WEND = W_M3_DN + 56 * MiB;
constexpr size_t WS_XB = WS_WEND;
constexpr size_t WS_SMALL = WS_XB + 32 * MiB;
constexpr size_t S_STATS = WS_SMALL;
constexpr size_t S_TOKE = WS_SMALL + 128 * 1024;
constexpr size_t S_TOKG = WS_SMALL + 256 * 1024;
constexpr size_t S_SLOT = WS_SMALL + 384 * 1024;
constexpr size_t S_ROWTOK = WS_SMALL + 512 * 1024;
constexpr size_t S_ROWGATE = WS_SMALL + 768 * 1024;
constexpr size_t S_ANG = WS_SMALL + 1 * MiB;
constexpr size_t S_KR = WS_SMALL + 3 * MiB;
constexpr size_t S_MASK = WS_SMALL + 4 * MiB;
constexpr size_t WS_BIG = WS_SMALL + 8 * MiB;
constexpr size_t WS_R2 = WS_BIG + 238 * MiB;
constexpr size_t WS_END = WS_R2 + 68 * MiB;
static_assert(WS_WEND == 415 * MiB, "weight map");
static_assert(WS_END <= 880 * MiB, "workspace budget");
constexpr size_t B_UV = WS_BIG, B_GATED = WS_BIG + 128 * MiB;
constexpr size_t B_PROJB = WS_BIG, B_OB = WS_BIG + 192 * MiB;
constexpr size_t B_PROJC = WS_BIG, B_OPRE = WS_BIG + 128 * MiB;
constexpr size_t B_PROJD = WS_BIG, B_CQ = WS_BIG + 32 * MiB, B_CKV = WS_BIG + 40 * MiB, B_Q = WS_BIG + 48 * MiB, B_KV = WS_BIG + 96 * MiB;
constexpr size_t B_H = WS_BIG;
constexpr int CW_BAR = 4096;
constexpr int CW_CNT = 16384;

constexpr int RING_BYTES = 131072;
constexpr int LDS_BYTES = 147456;
constexpr int LDSCTL_OFF = LDS_BYTES - 256;

typedef __bf16 bf16x2_t __attribute__((ext_vector_type(2)));
__device__ __forceinline__ unsigned cvt_pk_bf16(float lo, float hi) { const f32x2 v = {lo, hi}; const bf16x2_t b = __builtin_convertvector(v, bf16x2_t); return __builtin_bit_cast(unsigned, b); }
__device__ __forceinline__ float bf2f(unsigned short b) { return __uint_as_float((unsigned)b << 16); }
__device__ __forceinline__ float bflo(unsigned w) { return __uint_as_float(w << 16); }
__device__ __forceinline__ float bfhi(unsigned w) { return __uint_as_float(w & 0xffff0000u); }
__device__ __forceinline__ float fast_exp2(float x) { return __builtin_amdgcn_exp2f(x); }
__device__ __forceinline__ float fast_rcp(float x) { return __builtin_amdgcn_rcpf(x); }
__device__ __forceinline__ float sigmoidf_(float x) { return fast_rcp(1.0f + fast_exp2(-1.4426950408889634f * x)); }
__device__ __forceinline__ float siluf_(float x) { return x * sigmoidf_(x); }
__device__ __forceinline__ float gelu_tanh(float x) { const float u = x + 0.044715f * x * x * x; return x * fast_rcp(1.0f + fast_exp2(-2.302208198f * u)); }
template <int CTRL> __device__ __forceinline__ float dppmov(float v) { return __int_as_float(__builtin_amdgcn_update_dpp(0, __float_as_int(v), CTRL, 0xF, 0xF, true)); }
__device__ __forceinline__ float row_sum16(float v) { v += dppmov<0xB1>(v); v += dppmov<0x4E>(v); v += dppmov<0x124>(v); v += dppmov<0x128>(v); return v; }
__device__ __forceinline__ float rdlane(float v, int l) { return __int_as_float(__builtin_amdgcn_readlane(__float_as_int(v), l)); }
__device__ __forceinline__ float wave_sum(float v) { v = row_sum16(v); return (rdlane(v, 0) + rdlane(v, 16)) + (rdlane(v, 32) + rdlane(v, 48)); }
__device__ __forceinline__ float half_sum32(float v, int lane) { v = row_sum16(v); const float lo = rdlane(v, 0) + rdlane(v, 16), hi = rdlane(v, 32) + rdlane(v, 48); return lane < 32 ? lo : hi; }
#define LDS_WAIT() asm volatile("s_waitcnt lgkmcnt(0)" ::: "memory")
#define VM_WAIT() asm volatile("s_waitcnt vmcnt(0)" ::: "memory")
#define LDS_BARRIER() asm volatile("s_waitcnt lgkmcnt(0)\n\ts_barrier" ::: "memory")
namespace pg8 {
constexpr int BM = 256, BK = 64, HALF = 128, HTB = HALF * BK * 2  , STAGE_BYTES = 8 * HTB, NXCD = 8, WGM = 4;
__host__ __device__ __forceinline__ int lds_byte(int r, int c) { const int st = (r >> 4) * 2 + (c >> 5), rr = r & 15, cc = c & 31, ob = rr * 64 + cc * 2; return st * 1024 + (ob ^ (((ob >> 9) & 1) << 5)); }
__host__ __device__ __forceinline__ void stage_rc(int b, int& R, int& C) { const int st = b / 1024, sb = b % 1024, swz = sb ^ (((sb >> 9) & 1) << 5); R = (st >> 1) * 16 + swz / 64; C = (st & 1) * 32 + (swz % 64) / 2; }
__host__ __device__ __forceinline__ int perm32(int rho) { const int n = rho >> 4, i = rho & 15; return 8 * (i >> 2) + 4 * n + (i & 3); }

struct Unit { int pm, pn, e; };
struct Gemm { const bf16* A; const bf16* Bt; int M, N, K, lda; size_t bes; };

struct StaticOrder {
    int nM, nN, nwg, G, c;
    __device__ void init(int M_, int N_, int G_, int c_) { nM = M_ / BM; nN = N_ / BM; nwg = nM * nN; G = G_; c = c_; }
    __device__ bool next(int i, Unit& u) const {
        const long L = (long)i * G + c; if (L >= nwg) return false;
        int wgid = (int)L; { const int q = nwg / NXCD, r = nwg % NXCD, xcd = wgid % NXCD, off = wgid / NXCD; wgid = (xcd < r ? xcd * (q + 1) : r * (q + 1) + (xcd - r) * q) + off; }
        const int nig = WGM * nN, gid = wgid / nig, fm = gid * WGM, gsz = (nM - fm) < WGM ? (nM - fm) : WGM;
        u.pm = fm + ((wgid % nig) % gsz); u.pn = (wgid % nig) / gsz; u.e = 0; return true;
    }
};
struct MoeOrder {
    StaticOrder so; int pend[NE];
    __device__ bool next(int i, Unit& u) const {
        if (!so.next(i, u)) return false;
        const int r0 = u.pm * BM; int e = 0;
#pragma unroll
        for (int j = 0; j < NE - 1; ++j) e += (r0 >= pend[j]) ? 1 : 0;
        u.e = e; return true;
    }
};

template <int ACT  > struct EpiBf16 {
    static constexpr bool PERM = true;
    bf16* O; int ldc; float sc; int sc_pn;
    __device__ __forceinline__ void operator()(const f32x4 (&acc)[2][2][4][2], const Unit& u, int wr, int wc, int fr, int fq) const {
        const int row0 = u.pm * BM + wr * 64 + fr, col0 = u.pn * BM + wc * 32 + 8 * fq;
        const float s = (u.pn < sc_pn) ? sc : 1.0f;
#pragma unroll
        for (int ai = 0; ai < 2; ++ai)
#pragma unroll
            for (int m = 0; m < 4; ++m) { bf16* rowp = O + (size_t)(row0 + ai * HALF + m * 16) * ldc + col0;
#pragma unroll
                for (int bj = 0; bj < 2; ++bj) { f32x4 v0 = acc[ai][bj][m][0], v1 = acc[ai][bj][m][1];
                    if (ACT == 1) { v0 = (f32x4){gelu_tanh(v0[0]), gelu_tanh(v0[1]), gelu_tanh(v0[2]), gelu_tanh(v0[3])}; v1 = (f32x4){gelu_tanh(v1[0]), gelu_tanh(v1[1]), gelu_tanh(v1[2]), gelu_tanh(v1[3])}; }
                    else { v0 = v0 * s; v1 = v1 * s; }
                    u32x4 w; w.x = cvt_pk_bf16(v0[0], v0[1]); w.y = cvt_pk_bf16(v0[2], v0[3]); w.z = cvt_pk_bf16(v1[0], v1[1]); w.w = cvt_pk_bf16(v1[2], v1[3]);
                    *(u32x4*)(rowp + bj * HALF) = w; } }
    }
};
struct EpiSwiGLU {
    static constexpr bool PERM = true;
    bf16* H; int ldh;
    __device__ __forceinline__ void operator()(const f32x4 (&acc)[2][2][4][2], const Unit& u, int wr, int wc, int fr, int fq) const {
        const int row0 = u.pm * BM + wr * 64 + fr, col0 = u.pn * HALF + wc * 32 + 8 * fq;
#pragma unroll
        for (int ai = 0; ai < 2; ++ai)
#pragma unroll
            for (int m = 0; m < 4; ++m) { bf16* rowp = H + (size_t)(row0 + ai * HALF + m * 16) * ldh + col0;
                const f32x4 g0 = acc[ai][0][m][0], g1 = acc[ai][0][m][1], u0 = acc[ai][1][m][0], u1 = acc[ai][1][m][1];
                u32x4 w; w.x = cvt_pk_bf16(siluf_(g0[0]) * u0[0], siluf_(g0[1]) * u0[1]); w.y = cvt_pk_bf16(siluf_(g0[2]) * u0[2], siluf_(g0[3]) * u0[3]);
                w.z = cvt_pk_bf16(siluf_(g1[0]) * u1[0], siluf_(g1[1]) * u1[1]); w.w = cvt_pk_bf16(siluf_(g1[2]) * u1[2], siluf_(g1[3]) * u1[3]);
                *(u32x4*)rowp = w; }
    }
};
struct EpiResid {
    static constexpr bool PERM = false;
    const bf16* X; float* Y; float alpha;
    __device__ __forceinline__ void operator()(const f32x4 (&acc)[2][2][4][2], const Unit& u, int wr, int wc, int fr, int fq) const {
        const int row0 = u.pm * BM + wr * 64 + fr, col0 = u.pn * BM + wc * 32 + 4 * fq;
#pragma unroll
        for (int ai = 0; ai < 2; ++ai)
#pragma unroll
            for (int m = 0; m < 4; ++m) { const size_t off = (size_t)(row0 + ai * HALF + m * 16) * D + col0;
#pragma unroll
                for (int bj = 0; bj < 2; ++bj)
#pragma unroll
                    for (int n = 0; n < 2; ++n) { const u32x2 xw = *(const u32x2*)(X + off + bj * HALF + n * 16); const f32x4 xv = (f32x4){bflo(xw.x), bfhi(xw.x), bflo(xw.y), bfhi(xw.y)};
                        *(f32x4*)(Y + off + bj * HALF + n * 16) = xv * alpha + acc[ai][bj][m][n]; } }
    }
};
struct EpiF32 {
    static constexpr bool PERM = false;
    float* C; int ldc;
    __device__ __forceinline__ void operator()(const f32x4 (&acc)[2][2][4][2], const Unit& u, int wr, int wc, int fr, int fq) const {
        const int row0 = u.pm * BM + wr * 64 + fr, col0 = u.pn * BM + wc * 32 + 4 * fq;
#pragma unroll
        for (int ai = 0; ai < 2; ++ai)
#pragma unroll
            for (int m = 0; m < 4; ++m) { float* rowp = C + (size_t)(row0 + ai * HALF + m * 16) * ldc + col0;
#pragma unroll
                for (int bj = 0; bj < 2; ++bj)
#pragma unroll
                    for (int n = 0; n < 2; ++n) *(f32x4*)(rowp + bj * HALF + n * 16) = acc[ai][bj][m][n]; }
    }
};
struct EpiMoeDown {
    static constexpr bool PERM = true;
    bf16* YK; const int* rowtok; const float* rowgate;
    __device__ __forceinline__ void operator()(const f32x4 (&acc)[2][2][4][2], const Unit& u, int wr, int wc, int fr, int fq) const {
        const int row0 = u.pm * BM + wr * 64 + fr, col0 = u.pn * BM + wc * 32 + 8 * fq;
#pragma unroll
        for (int ai = 0; ai < 2; ++ai)
#pragma unroll
            for (int m = 0; m < 4; ++m) { const int r = row0 + ai * HALF + m * 16; const int rt = rowtok[r]; const float gt = rowgate[r];
                if (rt >= 0) { bf16* rowp = YK + (size_t)(rt & 1) * ((size_t)M * D) + (size_t)(rt >> 1) * D + col0;
#pragma unroll
                    for (int bj = 0; bj < 2; ++bj) { const f32x4 v0 = acc[ai][bj][m][0] * gt, v1 = acc[ai][bj][m][1] * gt;
                        u32x4 w; w.x = cvt_pk_bf16(v0[0], v0[1]); w.y = cvt_pk_bf16(v0[2], v0[3]); w.z = cvt_pk_bf16(v1[0], v1[1]); w.w = cvt_pk_bf16(v1[2], v1[3]);
                        *(u32x4*)(rowp + bj * HALF) = w; } } }
    }
};

template <class Epi, class Sched>
__device__ __forceinline__ void gemm_phase(LAS unsigned char* lds, const Gemm g, const Sched& S, const Epi& E) {
    const int tid = threadIdx.x, wid = __builtin_amdgcn_readfirstlane(tid >> 6), lane = tid & 63, wr = wid >> 2, wc = wid & 3, fr = lane & 15, fq = lane >> 4;
    const int K = g.K, nt = K / BK;
    unsigned voffA[2], voffB[2];
#pragma unroll
    for (int i = 0; i < 2; ++i) { int R, C; stage_rc(tid * 16 + i * 8192, R, C); const int Rb = Epi::PERM ? ((R & ~31) + perm32(R & 31)) : R;
        voffA[i] = (unsigned)(R * g.lda + C) * 2u; voffB[i] = (unsigned)(Rb * K + C) * 2u; }
    const size_t kstep = (size_t)(BK * 2);
    const size_t hstepA = (size_t)HALF * g.lda * 2, tstepA = 2 * hstepA;
    const size_t hstepB = (size_t)HALF * K * 2, tstepB = 2 * hstepB;
    const size_t besB = g.bes * 2;
    const unsigned ldsw = (unsigned)wid * 1024u;
    const int aoff = lds_byte(wr * 64 + fr, fq * 8), boff = lds_byte(wc * 32 + fr, fq * 8);
#define PG8_SA(b, h) (((b) * 2 + (h)) * HTB)
#define PG8_SB(b, h) ((4 + (b) * 2 + (h)) * HTB)
#define PG8_STAGE(bufoff, gbase, voff) do { _Pragma("unroll") for (int _i = 0; _i < 2; ++_i) \
        __builtin_amdgcn_global_load_lds((const unsigned*)((const char*)(gbase) + (voff)[_i]), (LAS unsigned*)(lds + (bufoff) + ldsw + _i * 8192), 16, 0, 0); } while (0)
#define PG8_LDA(dst, b, h) do { _Pragma("unroll") for (int m = 0; m < 4; ++m) _Pragma("unroll") for (int k = 0; k < 2; ++k) dst[m][k] = *(const LAS bf16x8*)(lds + PG8_SA(b, h) + aoff + m * 2048 + k * 1024); } while (0)
#define PG8_LDB(dst, b, h) do { _Pragma("unroll") for (int n = 0; n < 2; ++n) _Pragma("unroll") for (int k = 0; k < 2; ++k) dst[n][k] = *(const LAS bf16x8*)(lds + PG8_SB(b, h) + boff + n * 2048 + k * 1024); } while (0)
#define PG8_MMA(ai, bj, At, Bt) do { __builtin_amdgcn_s_setprio(1); _Pragma("unroll") for (int m = 0; m < 4; ++m) _Pragma("unroll") for (int n = 0; n < 2; ++n) _Pragma("unroll") for (int k = 0; k < 2; ++k) \
        acc[ai][bj][m][n] = __builtin_amdgcn_mfma_f32_16x16x32_bf16(Bt[n][k], At[m][k], acc[ai][bj][m][n], 0, 0, 0); __builtin_amdgcn_s_setprio(0); } while (0)
#define PG8_WAIT_V(n) asm volatile("s_waitcnt vmcnt(" #n ")" ::: "memory")
#define PG8_WAIT_L(n) asm volatile("s_waitcnt lgkmcnt(" #n ")" ::: "memory")
#define PG8_BAR __builtin_amdgcn_s_barrier()
#define PG8_SCHED __builtin_amdgcn_sched_barrier(0)
    Unit cur, nxt; int ui = 0;
    if (!S.next(0, cur)) return;
    f32x4 acc[2][2][4][2];
#pragma unroll
    for (int a = 0; a < 2; ++a)
#pragma unroll
        for (int b = 0; b < 2; ++b)
#pragma unroll
            for (int m = 0; m < 4; ++m)
#pragma unroll
                for (int n = 0; n < 2; ++n) acc[a][b][m][n] = (f32x4){0.f, 0.f, 0.f, 0.f};
    bf16x8 At[4][2], B0[2][2], B1[2][2];
    const char* cA = (const char*)g.A + (size_t)cur.pm * tstepA; const char* cB = (const char*)g.Bt + (size_t)cur.e * besB + (size_t)cur.pn * tstepB;
    PG8_STAGE(PG8_SB(0, 0), cB, voffB); PG8_STAGE(PG8_SB(0, 1), cB + hstepB, voffB); PG8_STAGE(PG8_SA(0, 0), cA, voffA); PG8_STAGE(PG8_SA(0, 1), cA + hstepA, voffA);
    if (wr == 1) PG8_BAR;
    PG8_WAIT_V(2); PG8_BAR;
    PG8_STAGE(PG8_SB(1, 0), cB + kstep, voffB); PG8_STAGE(PG8_SA(1, 0), cA + kstep, voffA); PG8_STAGE(PG8_SB(1, 1), cB + hstepB + kstep, voffB);
    PG8_WAIT_V(6); PG8_BAR;
    for (;;) {
        const bool has_next = S.next(ui + 1, nxt);
        const char* nA = has_next ? (const char*)g.A + (size_t)nxt.pm * tstepA : cA; const char* nB = has_next ? (const char*)g.Bt + (size_t)nxt.e * besB + (size_t)nxt.pn * tstepB : cB;
        for (int t = 0; t < nt; t += 2) {
            const bool last = (t == nt - 2);
            const char* a1 = cA + (size_t)(t + 1) * kstep;
            const char* a2 = last ? nA : cA + (size_t)(t + 2) * kstep; const char* b2 = last ? nB : cB + (size_t)(t + 2) * kstep;
            const char* a3 = a2 + kstep; const char* b3 = b2 + kstep;
            PG8_LDB(B0, 0, 0); PG8_LDB(B1, 0, 1); PG8_SCHED; PG8_LDA(At, 0, 0); PG8_STAGE(PG8_SA(1, 1), a1 + hstepA, voffA);
            PG8_WAIT_V(8); PG8_WAIT_L(0); PG8_BAR; PG8_MMA(0, 0, At, B0); PG8_MMA(0, 1, At, B1); PG8_BAR; PG8_SCHED;
            PG8_LDA(At, 0, 1); PG8_STAGE(PG8_SB(0, 0), b2, voffB); PG8_STAGE(PG8_SB(0, 1), b2 + hstepB, voffB); PG8_STAGE(PG8_SA(0, 0), a2, voffA);
            PG8_WAIT_V(8); PG8_WAIT_L(0); PG8_BAR; PG8_MMA(1, 0, At, B0); PG8_MMA(1, 1, At, B1); PG8_BAR; PG8_SCHED;
            PG8_LDB(B0, 1, 0); PG8_LDB(B1, 1, 1); PG8_SCHED; PG8_LDA(At, 1, 0); PG8_STAGE(PG8_SA(0, 1), a2 + hstepA, voffA);
            PG8_WAIT_V(8); PG8_WAIT_L(0); PG8_BAR; PG8_MMA(0, 0, At, B0); PG8_MMA(0, 1, At, B1); PG8_BAR; PG8_SCHED;
            PG8_LDA(At, 1, 1); PG8_STAGE(PG8_SB(1, 0), b3, voffB); PG8_STAGE(PG8_SB(1, 1), b3 + hstepB, voffB); PG8_STAGE(PG8_SA(1, 0), a3, voffA);
            PG8_WAIT_V(8); PG8_WAIT_L(0); PG8_BAR; PG8_MMA(1, 0, At, B0); PG8_MMA(1, 1, At, B1); PG8_BAR; PG8_SCHED;
        }
        if (wr == 0) PG8_BAR;
        E(acc, cur, wr, wc, fr, fq);
        if (!has_next) break;
#pragma unroll
        for (int a = 0; a < 2; ++a)
#pragma unroll
            for (int b = 0; b < 2; ++b)
#pragma unroll
                for (int m = 0; m < 4; ++m)
#pragma unroll
                    for (int n = 0; n < 2; ++n) acc[a][b][m][n] = (f32x4){0.f, 0.f, 0.f, 0.f};
        cur = nxt; cA = nA; cB = nB; ++ui;
        if (wr == 1) PG8_BAR;
    }
    PG8_WAIT_V(0);
    PG8_BAR;
#undef PG8_SA
#undef PG8_SB
#undef PG8_STAGE
#undef PG8_LDA
#undef PG8_LDB
#undef PG8_MMA
#undef PG8_WAIT_V
#undef PG8_WAIT_L
#undef PG8_BAR
#undef PG8_SCHED
}
}
#define XB_TMO      128
#define XB_XCNT(j)  (256  + 64 * (j))
#define XB_XSUB(j)  (1280 + 64 * (j))
#define XB_XGEN(j)  (2304 + 64 * (j))
#define XB_TOP      3328
#define XB_TOPGEN   3392
#define XCD_BAR_WORDS 3456
#define XB_SPIN_CAP (1u << 18)
__device__ __forceinline__ unsigned xb_ld(unsigned* p)              { return __hip_atomic_load(p, __ATOMIC_RELAXED, __HIP_MEMORY_SCOPE_AGENT); }
__device__ __forceinline__ unsigned xb_add(unsigned* p, unsigned v) { return __hip_atomic_fetch_add(p, v, __ATOMIC_RELAXED, __HIP_MEMORY_SCOPE_AGENT); }
__device__ __forceinline__ unsigned xb_xcc_id() { return (unsigned)__builtin_amdgcn_s_getreg((3 << 11) | 20) & 0xFu; }
#define XB_SPIN(cond, bar) do { unsigned _sp = 0; while (cond) { __builtin_amdgcn_s_sleep(1); \
    if ((++_sp & 255u) == 0u) { if (xb_ld(&(bar)[XB_TMO])) break; if (_sp > XB_SPIN_CAP) { atomicAdd(&(bar)[XB_TMO], 1u); break; } } } } while (0)
struct XcdBarrier { unsigned* bar; unsigned x; volatile LAS unsigned* st; };
__device__ __forceinline__ XcdBarrier xcd_barrier_post(unsigned* bar, volatile LAS unsigned* st) {
    XcdBarrier b; b.bar = bar; b.x = xb_xcc_id(); b.st = st;
    if (threadIdx.x == 0) (void)xb_add(&bar[XB_XCNT(b.x)], 1u);
    return b;
}
__device__ __forceinline__ void xcd_barrier_complete(unsigned* bar, unsigned x, unsigned& nloc, unsigned& nx) {
    const unsigned G = gridDim.x * gridDim.y * gridDim.z;
    unsigned sum, cnt, mine, sp = 0u;
    for (;;) {
        sum = 0u; cnt = 0u; mine = 0u;
#pragma unroll
        for (unsigned j = 0; j < 16; ++j) { const unsigned c = xb_ld(&bar[XB_XCNT(j)]); sum += c; cnt += (c > 0u) ? 1u : 0u; mine = (j == x) ? c : mine; }
        if (sum == G) break;
        __builtin_amdgcn_s_sleep(1);
        if ((++sp & 255u) == 0u) { if (xb_ld(&bar[XB_TMO])) break; if (sp > XB_SPIN_CAP) { atomicAdd(&bar[XB_TMO], 1u); break; } }
    }
    nloc = mine > 0u ? mine : 1u; nx = cnt > 0u ? cnt : 1u;
}
__device__ __forceinline__ void xcd_barrier(const XcdBarrier& b) {
    asm volatile("s_waitcnt vmcnt(0)" ::: "memory");
    __syncthreads();
    if (threadIdx.x == 0) {
        unsigned* bar = b.bar;
        __builtin_amdgcn_s_waitcnt(0);
        unsigned nloc = b.st[0], nx = b.st[1];
        if (nloc == 0u) { xcd_barrier_complete(bar, b.x, nloc, nx); b.st[0] = nloc; b.st[1] = nx; }
        const unsigned old = xb_add(&bar[XB_XSUB(b.x)], 1u);
        const unsigned gen = old / nloc;
        if (old + 1u == (gen + 1u) * nloc) {
            __builtin_amdgcn_fence(__ATOMIC_RELEASE, "agent");
            asm volatile("s_waitcnt vmcnt(0)" ::: "memory");
            const unsigned og = xb_add(&bar[XB_TOP], 1u);
            const unsigned tg = og / nx;
            if (og + 1u == (tg + 1u) * nx) xb_add(&bar[XB_TOPGEN], 1u);
            else XB_SPIN(xb_ld(&bar[XB_TOPGEN]) == tg, bar);
            __builtin_amdgcn_fence(__ATOMIC_ACQUIRE, "agent");
            xb_add(&bar[XB_XGEN(b.x)], 1u);
            asm volatile("s_waitcnt vmcnt(0)" ::: "memory");
        } else {
            XB_SPIN(xb_ld(&bar[XB_XGEN(b.x)]) == gen, bar);
            __builtin_amdgcn_fence(__ATOMIC_ACQUIRE, "agent");
            asm volatile("s_waitcnt vmcnt(0)" ::: "memory");
        }
    }
    __syncthreads();
}

struct Frame {
    LAS unsigned char* lds;
    unsigned* ctl;
    unsigned char* ws;
    int tid, lane, wave, G, bid;
};
struct Args { const void* in[34]; float* out; unsigned char* ws; int ph_lo, ph_hi; };

enum { I_X = 0, I_POS, I_A_WIN, I_A_LNG, I_A_LNB, I_A_WS, I_A_BS, I_A_WOUT, I_B_WIN, I_B_WOUT, I_C_WIN, I_C_LB, I_C_NG, I_C_WOUT,
       I_D_WIN, I_D_QNG, I_D_WUQ, I_D_KVNG, I_D_WUKV, I_D_WOUT, I_F0_GU, I_F0_DN, I_M1_R, I_M1_GU, I_M1_DN, I_F2_GU, I_F2_DN, I_M3_R, I_M3_GU, I_M3_DN,
       I_LNM_G, I_LNM_B, I_LNF_G, I_LNF_B };

__device__ __forceinline__ void cvt_load(f32x4 (&r)[8], const float* W, int Kv, int Nv, int k0, int n0, int lane) {
    const int n = n0 + 4 * (lane & 7);
#pragma unroll
    for (int i = 0; i < 8; ++i) { const int k = k0 + 8 * i + (lane >> 3); r[i] = (k < Kv && n < Nv) ? *(const f32x4*)(W + (size_t)k * Nv + n) : (f32x4){0.f, 0.f, 0.f, 0.f}; }
}
__device__ __forceinline__ void cvt_store(const f32x4 (&r)[8], bf16* WT, int Kp, int mode, int k0, int n0, LAS float* scr, int lane) {
#pragma unroll
    for (int i = 0; i < 8; ++i) { LAS float* p = scr + (8 * i + (lane >> 3)) * 33 + 4 * (lane & 7); p[0] = r[i].x; p[1] = r[i].y; p[2] = r[i].z; p[3] = r[i].w; }
    LDS_WAIT(); asm volatile("" ::: "memory");
    int drow0;
    if (mode == 0) drow0 = n0; else { const int j = (n0 < FF) ? n0 : n0 - FF; drow0 = 256 * (j >> 7) + (j & 127) + ((n0 < FF) ? 0 : 128); }
    const int c = lane & 7;
#pragma unroll
    for (int j = 0; j < 4; ++j) { const int n = (lane >> 3) + 8 * j; const LAS float* s = scr + (8 * c) * 33 + n;
        u32x4 o; o.x = cvt_pk_bf16(s[0 * 33], s[1 * 33]); o.y = cvt_pk_bf16(s[2 * 33], s[3 * 33]); o.z = cvt_pk_bf16(s[4 * 33], s[5 * 33]); o.w = cvt_pk_bf16(s[6 * 33], s[7 * 33]);
        *(u32x4*)(WT + (size_t)(drow0 + n) * Kp + k0 + 8 * c) = o; }
    LDS_WAIT(); asm volatile("" ::: "memory");
}
__device__ __forceinline__ void convert_matrix_g(const Frame& F, int gw, int NGW, const float* W, int Kv, int Nv, bf16* WT, int Kp, int Np, int mode, int nmat) {
    LAS float* scr = (LAS float*)(F.lds + F.wave * 16384);
    const int nkb = Kp / 64, nnb = Np / 32, per = nkb * nnb;
    const long total = (long)per * nmat;
#define CVT_DEC(it_, mat_, k0_, n0_) const int mat_ = (int)((it_) / per), r_##mat_ = (int)((it_) % per); const int k0_ = 64 * (r_##mat_ / nnb), n0_ = 32 * (r_##mat_ % nnb)
    f32x4 ra[8], rb[8];
    long it = gw;
    if (it < total) { CVT_DEC(it, m0, k0, n0); cvt_load(ra, W + (size_t)m0 * Kv * Nv, Kv, Nv, k0, n0, F.lane); }
    while (it < total) {
        { const long nx = it + NGW; if (nx < total) { CVT_DEC(nx, m1, k1, n1); cvt_load(rb, W + (size_t)m1 * Kv * Nv, Kv, Nv, k1, n1, F.lane); }
          CVT_DEC(it, m0, k0, n0); cvt_store(ra, WT + (size_t)m0 * Kp * Np, Kp, mode, k0, n0, scr, F.lane); it = nx; }
        if (it >= total) break;
        { const long nx = it + NGW; if (nx < total) { CVT_DEC(nx, m1, k1, n1); cvt_load(ra, W + (size_t)m1 * Kv * Nv, Kv, Nv, k1, n1, F.lane); }
          CVT_DEC(it, m0, k0, n0); cvt_store(rb, WT + (size_t)m0 * Kp * Np, Kp, mode, k0, n0, scr, F.lane); it = nx; }
    }
#undef CVT_DEC
}
__device__ __forceinline__ void convert_matrix(const Frame& F, const float* W, int Kv, int Nv, bf16* WT, int Kp, int Np, int mode, int nmat) {
    convert_matrix_g(F, F.bid * NWAVES + F.wave, F.G * NWAVES, W, Kv, Nv, WT, Kp, Np, mode, nmat);
}

__device__ __forceinline__ void ln_row(f32x4 (&v)[4], const float* g, const float* b, int lane) {
    float s = 0.f;
#pragma unroll
    for (int j = 0; j < 4; ++j) s += (v[j].x + v[j].y) + (v[j].z + v[j].w);
    const float mean = wave_sum(s) * (1.f / D); float s2 = 0.f;
#pragma unroll
    for (int j = 0; j < 4; ++j) { v[j] = v[j] - mean; s2 += (v[j].x * v[j].x + v[j].y * v[j].y) + (v[j].z * v[j].z + v[j].w * v[j].w); }
    const float rstd = __builtin_amdgcn_rsqf(wave_sum(s2) * (1.f / D) + LN_EPS);
#pragma unroll
    for (int j = 0; j < 4; ++j) { const f32x4 gg = *(const f32x4*)(g + 4 * lane + 256 * j), bb = *(const f32x4*)(b + 4 * lane + 256 * j); v[j] = v[j] * rstd * gg + bb; }
}
__device__ __forceinline__ void store_row_bf(const f32x4 (&v)[4], bf16* ob, int lane) {
#pragma unroll
    for (int j = 0; j < 4; ++j) { u32x2 w; w.x = cvt_pk_bf16(v[j].x, v[j].y); w.y = cvt_pk_bf16(v[j].z, v[j].w); *(u32x2*)(ob + 4 * lane + 256 * j) = w; }
}
__device__ __forceinline__ void store_row_f32(const f32x4 (&v)[4], float* of, int lane) {
#pragma unroll
    for (int j = 0; j < 4; ++j) *(f32x4*)(of + 4 * lane + 256 * j) = v[j];
}
__device__ __forceinline__ void ln_phase(const Frame& F, const float* xf, bf16* xb, const float* g, const float* b) {
    const int gw = F.bid * NWAVES + F.wave, NGW = F.G * NWAVES;
    for (int r = gw; r < M; r += 2 * NGW) {
        const int r2 = r + NGW; const bool has2 = r2 < M; const int rr2 = has2 ? r2 : r;
        f32x4 v[4], w[4];
#pragma unroll
        for (int j = 0; j < 4; ++j) { v[j] = *(const f32x4*)(xf + (size_t)r * D + 4 * F.lane + 256 * j); w[j] = *(const f32x4*)(xf + (size_t)rr2 * D + 4 * F.lane + 256 * j); }
        ln_row(v, g, b, F.lane); ln_row(w, g, b, F.lane);
        store_row_bf(v, xb + (size_t)r * D, F.lane);
        if (has2) store_row_bf(w, xb + (size_t)r2 * D, F.lane);
    }
}
__device__ __forceinline__ void ln_route_phase(const Frame& F, const float* xf, bf16* xb, const float* g, const float* b, const float* wr, unsigned* cnt  ) {
    LAS float* WR = (LAS float*)F.lds;
    LAS int* EB = (LAS int*)(F.lds + 32768);
    for (int i = F.tid; i < D * NE / 4; i += NTHREADS) ((LAS f32x4*)WR)[i] = ((const f32x4*)wr)[i];
    __syncthreads();
    int* toke = (int*)(F.ws + S_TOKE); float* tokg = (float*)(F.ws + S_TOKG); int* slot = (int*)(F.ws + S_SLOT);
    for (int blk = F.bid; blk < M / 64; blk += F.G) {
        for (int i = 0; i < 8; ++i) {
            const int rl = F.wave * 8 + i, r = blk * 64 + rl;
            f32x4 v[4];
#pragma unroll
            for (int j = 0; j < 4; ++j) v[j] = *(const f32x4*)(xf + (size_t)r * D + 4 * F.lane + 256 * j);
            ln_row(v, g, b, F.lane);
            store_row_bf(v, xb + (size_t)r * D, F.lane);
            float lg[NE];
#pragma unroll
            for (int e = 0; e < NE; ++e) lg[e] = 0.f;
#pragma unroll
            for (int j = 0; j < 4; ++j)
#pragma unroll
                for (int c = 0; c < 4; ++c) { const LAS f32x4* wp = (const LAS f32x4*)(WR + (size_t)(4 * F.lane + 256 * j + c) * NE); const f32x4 w0 = wp[0], w1 = wp[1]; const float xv = v[j][c];
                    lg[0] += xv * w0.x; lg[1] += xv * w0.y; lg[2] += xv * w0.z; lg[3] += xv * w0.w; lg[4] += xv * w1.x; lg[5] += xv * w1.y; lg[6] += xv * w1.z; lg[7] += xv * w1.w; }
#pragma unroll
            for (int e = 0; e < NE; ++e) lg[e] = wave_sum(lg[e]);
            int e0 = 0; float l0 = lg[0];
#pragma unroll
            for (int e = 1; e < NE; ++e) if (lg[e] > l0) { l0 = lg[e]; e0 = e; }
            int e1 = -1; float l1 = -3.0e38f;
#pragma unroll
            for (int e = 0; e < NE; ++e) if (e != e0 && lg[e] > l1) { l1 = lg[e]; e1 = e; }
            const float ex = __expf(l1 - l0), g0 = 1.f / (1.f + ex), g1 = ex * g0;
            if (F.lane == 0) { toke[2 * r] = e0; toke[2 * r + 1] = e1; tokg[2 * r] = g0; tokg[2 * r + 1] = g1; EB[2 * rl] = e0; EB[2 * rl + 1] = e1; }
        }
        __syncthreads();
        if (F.wave == 0) {
            const int lane = F.lane; const int ea = EB[lane], eb = EB[64 + lane];
            const u64 lt = (1ull << lane) - 1ull; int myc = 0, ra = 0, rbk = 0;
#pragma unroll
            for (int e = 0; e < NE; ++e) { const u64 ma = __ballot(ea == e), mb = __ballot(eb == e); const int pa = __builtin_popcountll(ma), c = pa + __builtin_popcountll(mb);
                if (lane == e) myc = c; if (ea == e) ra = __builtin_popcountll(ma & lt); if (eb == e) rbk = pa + __builtin_popcountll(mb & lt); }
            int basev = 0; if (lane < NE) basev = (int)__hip_atomic_fetch_add(cnt + 64 * lane, (unsigned)myc, __ATOMIC_RELAXED, __HIP_MEMORY_SCOPE_AGENT);
            int ba = 0, bb = 0;
#pragma unroll
            for (int e = 0; e < NE; ++e) { const int be = __builtin_amdgcn_readlane(basev, e); if (ea == e) ba = be; if (eb == e) bb = be; }
            slot[(size_t)(blk * 64) * 2 + lane] = ba + ra; slot[(size_t)(blk * 64) * 2 + 64 + lane] = bb + rbk;
        }
        __syncthreads();
    }
}
__device__ __forceinline__ int moe_segments(const unsigned* cnt, int (&cntv)[NE], int (&pstart)[NE], int (&pend)[NE]) {
    int acc = 0;
#pragma unroll
    for (int e = 0; e < NE; ++e) { cntv[e] = (int)__hip_atomic_load(cnt + 64 * e, __ATOMIC_RELAXED, __HIP_MEMORY_SCOPE_AGENT); pstart[e] = acc; acc += (cntv[e] + 255) & ~255; pend[e] = acc; }
    return acc;
}
__device__ __forceinline__ void moe_gather_phase(const Frame& F, const bf16* xb, bf16* xr, const unsigned* cnt) {
    int cntv[NE], pstart[NE], pend[NE]; moe_segments(cnt, cntv, pstart, pend);
    const int* toke = (const int*)(F.ws + S_TOKE); const float* tokg = (const float*)(F.ws + S_TOKG); const int* slot = (const int*)(F.ws + S_SLOT);
    int* rowtok = (int*)(F.ws + S_ROWTOK); float* rowgate = (float*)(F.ws + S_ROWGATE);
    const int gw = F.bid * NWAVES + F.wave, NGW = F.G * NWAVES;
    for (int a = gw; a < 2 * M; a += NGW) {
        const int e = toke[a]; int ps = 0;
#pragma unroll
        for (int j = 0; j < NE; ++j) ps = (e == j) ? pstart[j] : ps;
        const int dest = ps + slot[a]; const int t = a >> 1;
        const u32x4* src = (const u32x4*)(xb + (size_t)t * D); u32x4* dst = (u32x4*)(xr + (size_t)dest * D);
        dst[F.lane] = src[F.lane]; dst[F.lane + 64] = src[F.lane + 64];
        if (F.lane == 0) { rowtok[dest] = a; rowgate[dest] = tokg[a]; }
    }
    for (int i = gw; i < NE * 256; i += NGW) {
        const int e = i >> 8, j = i & 255; int ps = 0, cv = 0, pe = 0;
#pragma unroll
        for (int q = 0; q < NE; ++q) { ps = (e == q) ? pstart[q] : ps; cv = (e == q) ? cntv[q] : cv; pe = (e == q) ? pend[q] : pe; }
        const int r = ps + cv + j;
        if (r < pe) { u32x4* dst = (u32x4*)(xr + (size_t)r * D); const u32x4 z = (u32x4){0u, 0u, 0u, 0u}; dst[F.lane] = z; dst[F.lane + 64] = z; if (F.lane == 0) { rowtok[r] = -1; rowgate[r] = 0.f; } }
    }
}
__device__ __forceinline__ void ln_moe_load(f32x4 (&v)[4], const bf16* xb, const bf16* yk, int r, int lane) {
#pragma unroll
    for (int j = 0; j < 4; ++j) { const size_t o = (size_t)r * D + 4 * lane + 256 * j; const u32x2 x = *(const u32x2*)(xb + o);
        const u32x2 a = *(const u32x2*)(yk + o), c = *(const u32x2*)(yk + (size_t)M * D + o);
        v[j].x = bflo(x.x) * ALPHA + bflo(a.x) + bflo(c.x); v[j].y = bfhi(x.x) * ALPHA + bfhi(a.x) + bfhi(c.x); v[j].z = bflo(x.y) * ALPHA + bflo(a.y) + bflo(c.y); v[j].w = bfhi(x.y) * ALPHA + bfhi(a.y) + bfhi(c.y); }
}
__device__ __forceinline__ void ln_moe_phase(const Frame& F, const bf16* yk, float* outf, bf16* xb, const float* g, const float* b) {
    const int gw = F.bid * NWAVES + F.wave, NGW = F.G * NWAVES;
    for (int r = gw; r < M; r += 2 * NGW) {
        const int r2 = r + NGW; const bool has2 = r2 < M; const int rr2 = has2 ? r2 : r;
        f32x4 v[4], w[4];
        ln_moe_load(v, xb, yk, r, F.lane); ln_moe_load(w, xb, yk, rr2, F.lane);
        ln_row(v, g, b, F.lane); ln_row(w, g, b, F.lane);
        if (outf) { store_row_f32(v, outf + (size_t)r * D, F.lane); if (has2) store_row_f32(w, outf + (size_t)r2 * D, F.lane); }
        else { store_row_bf(v, xb + (size_t)r * D, F.lane); if (has2) store_row_bf(w, xb + (size_t)r2 * D, F.lane); }
    }
}
__device__ __forceinline__ void cvt_rows_phase(const Frame& F, const float* x, bf16* xb) {
    const int gw = F.bid * NWAVES + F.wave, NGW = F.G * NWAVES;
    for (int r = gw; r < M; r += NGW) {
#pragma unroll
        for (int j = 0; j < 4; ++j) { const size_t o = (size_t)r * D + 4 * F.lane + 256 * j; const f32x4 v = *(const f32x4*)(x + o);
            u32x2 w; w.x = cvt_pk_bf16(v.x, v.y); w.y = cvt_pk_bf16(v.z, v.w); *(u32x2*)(xb + o) = w; }
    }
}
__device__ __forceinline__ void gmlp_stats_phase(const Frame& F, const bf16* uv, float* stats) {
    const int gw = F.bid * NWAVES + F.wave, NGW = F.G * NWAVES;
    for (int r = gw; r < M; r += NGW) {
        const u32x4* p = (const u32x4*)(uv + (size_t)r * 4096 + 2048);
        float x[32]; float s = 0.f;
#pragma unroll
        for (int j = 0; j < 4; ++j) { const u32x4 w = p[F.lane + 64 * j];
            x[8 * j + 0] = bflo(w.x); x[8 * j + 1] = bfhi(w.x); x[8 * j + 2] = bflo(w.y); x[8 * j + 3] = bfhi(w.y); x[8 * j + 4] = bflo(w.z); x[8 * j + 5] = bfhi(w.z); x[8 * j + 6] = bflo(w.w); x[8 * j + 7] = bfhi(w.w); }
#pragma unroll
        for (int i = 0; i < 32; ++i) s += x[i];
        const float mean = wave_sum(s) * (1.f / 2048.f); float s2 = 0.f;
#pragma unroll
        for (int i = 0; i < 32; ++i) { const float d = x[i] - mean; s2 += d * d; }
        const float rstd = __builtin_amdgcn_rsqf(wave_sum(s2) * (1.f / 2048.f) + LN_EPS);
        if (F.lane == 0) { stats[2 * r] = mean; stats[2 * r + 1] = rstd; }
    }
}
constexpr int GM_WS = 136, GM_VS = 136;
__device__ __forceinline__ void gmlp_spatial_phase(const Frame& F, const bf16* uv, const float* stats, const float* ws_in  , const float* bs  ,
                                                   const float* lng, const float* lnb, bf16* gated) {
    LAS bf16* Ws = (LAS bf16*)F.lds;
    LAS bf16* Vt = (LAS bf16*)(F.lds + 128 * GM_WS * 2);
    const int tid = F.tid, lane = F.lane, w = F.wave, wr = w >> 2, wc = w & 3, fr = lane & 15, fq = lane >> 4;
    for (int u = F.bid; u < 1024; u += F.G) {
        const int bc = u >> 3, g = u & 7; const size_t rowbase = (size_t)bc * 128;
        { const int t = tid >> 2, c0 = (tid & 3) * 32; const float* wp = ws_in + ((size_t)g * 128 + t) * 128 + c0;
#pragma unroll
            for (int q = 0; q < 4; ++q) { const f32x4 a = *(const f32x4*)(wp + 8 * q), b = *(const f32x4*)(wp + 8 * q + 4); const int s0 = c0 + 8 * q;
                u32x4 o; o.x = cvt_pk_bf16(s0 + 0 <= t ? a.x : 0.f, s0 + 1 <= t ? a.y : 0.f); o.y = cvt_pk_bf16(s0 + 2 <= t ? a.z : 0.f, s0 + 3 <= t ? a.w : 0.f);
                o.z = cvt_pk_bf16(s0 + 4 <= t ? b.x : 0.f, s0 + 5 <= t ? b.y : 0.f); o.w = cvt_pk_bf16(s0 + 6 <= t ? b.z : 0.f, s0 + 7 <= t ? b.w : 0.f);
                *(LAS u32x4*)(Ws + t * GM_WS + s0) = o; } }
        { const int so = tid & 15, dq = tid >> 4; const int col = 256 * g + 8 * dq;
            const f32x4 g0 = *(const f32x4*)(lng + col), g1 = *(const f32x4*)(lng + col + 4), b0 = *(const f32x4*)(lnb + col), b1 = *(const f32x4*)(lnb + col + 4);
            float vv[8][8];
#pragma unroll
            for (int j = 0; j < 8; ++j) { const size_t r = rowbase + 8 * so + j; const u32x4 wv = *(const u32x4*)(uv + r * 4096 + 2048 + col); const float mean = stats[2 * r], rstd = stats[2 * r + 1];
                vv[j][0] = (bflo(wv.x) - mean) * rstd * g0.x + b0.x; vv[j][1] = (bfhi(wv.x) - mean) * rstd * g0.y + b0.y; vv[j][2] = (bflo(wv.y) - mean) * rstd * g0.z + b0.z; vv[j][3] = (bfhi(wv.y) - mean) * rstd * g0.w + b0.w;
                vv[j][4] = (bflo(wv.z) - mean) * rstd * g1.x + b1.x; vv[j][5] = (bfhi(wv.z) - mean) * rstd * g1.y + b1.y; vv[j][6] = (bflo(wv.w) - mean) * rstd * g1.z + b1.z; vv[j][7] = (bfhi(wv.w) - mean) * rstd * g1.w + b1.w; }
#pragma unroll
            for (int dd = 0; dd < 8; ++dd) { u32x4 o; o.x = cvt_pk_bf16(vv[0][dd], vv[1][dd]); o.y = cvt_pk_bf16(vv[2][dd], vv[3][dd]); o.z = cvt_pk_bf16(vv[4][dd], vv[5][dd]); o.w = cvt_pk_bf16(vv[6][dd], vv[7][dd]);
                *(LAS u32x4*)(Vt + (8 * dq + dd) * GM_VS + 8 * so) = o; } }
        __syncthreads();
        f32x4 acc[4][4];
#pragma unroll
        for (int a = 0; a < 4; ++a)
#pragma unroll
            for (int b = 0; b < 4; ++b) acc[a][b] = (f32x4){0.f, 0.f, 0.f, 0.f};
        const int nks = wr ? 4 : 2;
        for (int ks = 0; ks < nks; ++ks) {
            bf16x8 wf[4], vf[4];
#pragma unroll
            for (int mt = 0; mt < 4; ++mt) wf[mt] = *(const LAS bf16x8*)(Ws + (64 * wr + 16 * mt + fr) * GM_WS + 32 * ks + 8 * fq);
#pragma unroll
            for (int nt = 0; nt < 4; ++nt) vf[nt] = *(const LAS bf16x8*)(Vt + (64 * wc + 16 * nt + fr) * GM_VS + 32 * ks + 8 * fq);
#pragma unroll
            for (int mt = 0; mt < 4; ++mt)
#pragma unroll
                for (int nt = 0; nt < 4; ++nt) acc[mt][nt] = __builtin_amdgcn_mfma_f32_16x16x32_bf16(vf[nt], wf[mt], acc[mt][nt], 0, 0, 0);
        }
#pragma unroll
        for (int mt = 0; mt < 4; ++mt) { const int tl = 64 * wr + 16 * mt + fr; const float bias = bs[g * 128 + tl]; const size_t r = rowbase + tl;
#pragma unroll
            for (int nt = 0; nt < 4; ++nt) { const int col = 256 * g + 64 * wc + 16 * nt + 4 * fq; const u32x2 uu = *(const u32x2*)(uv + r * 4096 + col);
                const f32x4 sv = acc[mt][nt] + bias;
                u32x2 o; o.x = cvt_pk_bf16(bflo(uu.x) * sv.x, bfhi(uu.x) * sv.y); o.y = cvt_pk_bf16(bflo(uu.y) * sv.z, bfhi(uu.y) * sv.w);
                *(u32x2*)(gated + r * 2048 + col) = o; } }
        __syncthreads();
    }
}
constexpr int PB_LD = 3584, PB_QI = 3072, PB_KI = 3328, PB_WI = 3392;
__device__ __forceinline__ unsigned sortable(float s) { const unsigned b = __float_as_uint(s + 0.0f); return b ^ ((b >> 31) ? 0xffffffffu : 0x80000000u); }
template <int NJ>
__device__ __forceinline__ void dsa_select(const LAS unsigned* sc, int t, int lane, u64* mrow) {
    unsigned key[NJ];
#pragma unroll
    for (int j = 0; j < NJ; ++j) { const int s = 64 * j + lane; key[j] = (s <= t) ? sc[s] : 0u; }
    unsigned T = 0u; int need = 0;
    if (t >= 256) {
        for (int bit = 31; bit >= 0; --bit) {
            const unsigned cand = T | (1u << bit); int c = 0;
#pragma unroll
            for (int j = 0; j < NJ; ++j) c += __builtin_popcountll(__ballot(key[j] >= cand));
            if (c >= 256) T = cand;
        }
        int ngt = 0;
#pragma unroll
        for (int j = 0; j < NJ; ++j) ngt += __builtin_popcountll(__ballot(key[j] > T));
        need = 256 - ngt;
    }
    int running = 0;
#pragma unroll
    for (int j = 0; j < NJ; ++j) {
        const bool adm = (64 * j + lane) <= t;
        const bool gt = key[j] > T, eq = (key[j] == T);
        const u64 eqm = __ballot(eq && adm);
        const int rank = running + __builtin_popcountll(eqm & ((1ull << lane) - 1ull));
        const bool sel = adm && (gt || (t < 256) || (eq && rank < need));
        const u64 word = __ballot(sel);
        running += __builtin_popcountll(eqm);
        if (lane == 0) mrow[j] = word;
    }
    if (lane == 0) {
#pragma unroll
        for (int j = NJ; j < 32; ++j) mrow[j] = 0ull;
    }
}
__device__ __forceinline__ void dsa_topk_phase(const Frame& F, const bf16* proj, u64* mask) {
    LAS unsigned* SC = (LAS unsigned*)F.lds;
    const int lane = F.lane, w = F.wave, fr = lane & 15, fq = lane >> 4;
    for (int it = 0; it < 1024 / 256 + 1; ++it) {
        const int idx = it * F.G + F.bid; if (idx >= 1024) break;
        const int b = idx >> 7, tq0 = idx & 127; const int tq = ((idx >> 8) & 1) ? 127 - tq0 : tq0;
        const int t0 = 16 * tq; const size_t rb = (size_t)b * SEQ;
        bf16x8 qf[4][2]; float wq[4];
        { const bf16* qp = proj + (rb + t0 + fr) * PB_LD;
#pragma unroll
            for (int h = 0; h < 4; ++h) {
#pragma unroll
                for (int ks = 0; ks < 2; ++ks) qf[h][ks] = *(const bf16x8*)(qp + PB_QI + 64 * h + 32 * ks + 8 * fq);
                wq[h] = bf2f(qp[PB_WI + h]); } }
        for (int kt = w; kt <= tq; kt += NWAVES) {
            const bf16* kp = proj + (rb + 16 * kt + fr) * PB_LD + PB_KI + 8 * fq;
            const bf16x8 kf0 = *(const bf16x8*)kp, kf1 = *(const bf16x8*)(kp + 32);
            f32x4 sc = (f32x4){0.f, 0.f, 0.f, 0.f};
#pragma unroll
            for (int h = 0; h < 4; ++h) { f32x4 d = (f32x4){0.f, 0.f, 0.f, 0.f};
                d = __builtin_amdgcn_mfma_f32_16x16x32_bf16(kf0, qf[h][0], d, 0, 0, 0); d = __builtin_amdgcn_mfma_f32_16x16x32_bf16(kf1, qf[h][1], d, 0, 0, 0);
                sc.x += wq[h] * fmaxf(d.x, 0.f); sc.y += wq[h] * fmaxf(d.y, 0.f); sc.z += wq[h] * fmaxf(d.z, 0.f); sc.w += wq[h] * fmaxf(d.w, 0.f); }
            u32x4 o; o.x = sortable(sc.x); o.y = sortable(sc.y); o.z = sortable(sc.z); o.w = sortable(sc.w);
            *(LAS u32x4*)(SC + fr * 2048 + 16 * kt + 4 * fq) = o;
        }
        __syncthreads();
        for (int qq = 0; qq < 2; ++qq) {
            const int ql = 2 * w + qq, t = t0 + ql;
            u64* mrow = mask + (rb + t) * 32;
            const int nj8 = (t >> 9) + 1;
            if (nj8 == 1) dsa_select<8>(SC + ql * 2048, t, lane, mrow);
            else if (nj8 == 2) dsa_select<16>(SC + ql * 2048, t, lane, mrow);
            else if (nj8 == 3) dsa_select<24>(SC + ql * 2048, t, lane, mrow);
            else dsa_select<32>(SC + ql * 2048, t, lane, mrow);
        }
        __syncthreads();
    }
}
template <int DK> struct AttnCfg { static constexpr int KP = DK + 8, VP = 96  , KBYTES = 64 * KP * 2, VBYTES = 64 * VP * 2, BUF = KBYTES + VBYTES; };
struct AttnArgs { const bf16* Q; int ldq, qoff;
                  const bf16* K1; int ldk1, k1off, k1hs;
                  const bf16* K2; int ldk2;
                  const bf16* V; int ldv, voff, vhs;
                  bf16* O;
                  const u64* mask;
                  const float* ang; };
__device__ __forceinline__ int crow(int r, int hi) { return (r & 3) + 8 * (r >> 2) + 4 * hi; }
template <int DK, bool MASKED>
__device__ __forceinline__ void attn_unit(const Frame& F, const AttnArgs& A, int b, int h, int qb) {
    typedef AttnCfg<DK> C;
    const int tid = F.tid, lane = F.lane, w = F.wave, r32 = lane & 31, hi = lane >> 5;
    const size_t rb = (size_t)b * SEQ; const int q0 = qb * 256, qrow = q0 + 32 * w + r32;
    const int NT = (q0 + 256) / 64;
    constexpr int NKS = DK / 16;
    bf16x8 qf[NKS];
    { const bf16* qp = A.Q + (rb + qrow) * A.ldq + A.qoff + h * DK + 8 * hi;
#pragma unroll
        for (int ks = 0; ks < NKS; ++ks) qf[ks] = *(const bf16x8*)(qp + 16 * ks); }
    if constexpr (DK == 96) {
        const float* ap = A.ang + (rb + qrow) * 32 + 16 * hi;
        const u32x4 w1 = __builtin_bit_cast(u32x4, qf[4]), w2 = __builtin_bit_cast(u32x4, qf[5]); u32x4 o1, o2;
#pragma unroll
        for (int e = 0; e < 4; ++e) { const f32x4 cs = *(const f32x4*)(ap + 4 * e);
            const float a0 = bflo(w1[e]), a1 = bfhi(w1[e]), b0 = bflo(w2[e]), b1 = bfhi(w2[e]);
            o1[e] = cvt_pk_bf16(a0 * cs.x - b0 * cs.y, a1 * cs.z - b1 * cs.w); o2[e] = cvt_pk_bf16(b0 * cs.x + a0 * cs.y, b1 * cs.z + a1 * cs.w); }
        qf[4] = __builtin_bit_cast(bf16x8, o1); qf[5] = __builtin_bit_cast(bf16x8, o2);
    }
    const int skey = tid >> 3, sch = tid & 7;
    const int skey2 = (tid + 512) / 12, sch2 = (tid + 512) % 12;
    const int skey1 = (DK == 96) ? tid / 12 : skey, sch1 = (DK == 96) ? tid % 12 : sch;
    u32x4 kreg0, kreg1 = (u32x4){0u, 0u, 0u, 0u}, vreg; u64 mw = 0ull;
#define ATT_LOAD_TILE(kt_) do { const size_t kr = rb + 64 * (kt_); \
        if (DK == 64) { kreg0 = *(const u32x4*)(A.K1 + (kr + skey) * A.ldk1 + A.k1off + h * A.k1hs + 8 * sch); } \
        else { \
            kreg0 = (sch1 < 8) ? *(const u32x4*)(A.K1 + (kr + skey1) * A.ldk1 + A.k1off + h * A.k1hs + 8 * sch1) : *(const u32x4*)(A.K2 + (kr + skey1) * A.ldk2 + 8 * (sch1 - 8)); \
            if (tid < 256) kreg1 = (sch2 < 8) ? *(const u32x4*)(A.K1 + (kr + skey2) * A.ldk1 + A.k1off + h * A.k1hs + 8 * sch2) : *(const u32x4*)(A.K2 + (kr + skey2) * A.ldk2 + 8 * (sch2 - 8)); \
        } \
        vreg = *(const u32x4*)(A.V + (kr + skey) * A.ldv + A.voff + h * A.vhs + 8 * sch); \
        if (MASKED) mw = A.mask[(rb + qrow) * 32 + (kt_)]; } while (0)
#define ATT_STORE_TILE(buf_) do { LAS unsigned char* base = F.lds + (buf_) * C::BUF; \
        *(LAS u32x4*)(base + (skey1 * C::KP + 8 * sch1) * 2) = kreg0; \
        if (DK == 96) { if (tid < 256) *(LAS u32x4*)(base + (skey2 * C::KP + 8 * sch2) * 2) = kreg1; } \
        *(LAS u32x4*)(base + C::KBYTES + (skey * C::VP + 8 * sch) * 2) = vreg; } while (0)
    float m_run = -1.0e30f, l_run = 0.f; f32x16 o0 = {}, o1 = {};
    ATT_LOAD_TILE(0); u64 mcur = mw; ATT_STORE_TILE(0); __syncthreads();
    const int wq_max = q0 + 32 * w + 31, wq_min = q0 + 32 * w;
    for (int kt = 0; kt < NT; ++kt) {
        if (kt + 1 < NT) ATT_LOAD_TILE(kt + 1);
        if (64 * kt <= wq_max) {
            const LAS unsigned char* kb = F.lds + (kt & 1) * C::BUF; const LAS unsigned char* vb = kb + C::KBYTES;
            const float NEG = -1.0e30f;
            f32x16 p0 = {}, p1 = {};
            if (MASKED) { const int nlo = (int)~((unsigned)mcur >> (4 * hi)), nhh = (int)~((unsigned)(mcur >> 32) >> (4 * hi));
#pragma unroll
                for (int r = 0; r < 16; ++r) { const unsigned bitp = (r & 3) + 8 * (r >> 2);
                    p0[r] = __int_as_float(__builtin_amdgcn_sbfe(nlo, bitp, 1u) & (int)0xF149F2CA); p1[r] = __int_as_float(__builtin_amdgcn_sbfe(nhh, bitp, 1u) & (int)0xF149F2CA); }
            } else if (64 * kt + 63 > wq_min) {
#pragma unroll
                for (int r = 0; r < 16; ++r) { const int kv = 64 * kt + crow(r, hi); p0[r] = (kv <= qrow) ? 0.f : NEG; p1[r] = (kv + 32 <= qrow) ? 0.f : NEG; }
            }
#pragma unroll
            for (int ks = 0; ks < NKS; ++ks) {
                const bf16x8 a0 = *(const LAS bf16x8*)(kb + (r32 * C::KP + 16 * ks + 8 * hi) * 2), a1 = *(const LAS bf16x8*)(kb + ((32 + r32) * C::KP + 16 * ks + 8 * hi) * 2);
                p0 = __builtin_amdgcn_mfma_f32_32x32x16_bf16(a0, qf[ks], p0, 0, 0, 0); p1 = __builtin_amdgcn_mfma_f32_32x32x16_bf16(a1, qf[ks], p1, 0, 0, 0);
            }
            f32x16 pm = __builtin_elementwise_max(p0, p1);
            float mx = fmaxf(fmaxf(fmaxf(pm[0], pm[1]), fmaxf(pm[2], pm[3])), fmaxf(fmaxf(pm[4], pm[5]), fmaxf(pm[6], pm[7])));
            mx = fmaxf(mx, fmaxf(fmaxf(fmaxf(pm[8], pm[9]), fmaxf(pm[10], pm[11])), fmaxf(fmaxf(pm[12], pm[13]), fmaxf(pm[14], pm[15]))));
            { auto rr = __builtin_amdgcn_permlane32_swap(__float_as_uint(mx), __float_as_uint(mx), false, false); mx = fmaxf(__uint_as_float(rr[0]), __uint_as_float(rr[1])); }
            const float m_new = fmaxf(m_run, mx);
            if (__any(m_new != m_run)) { const float alpha = fast_exp2(m_run - m_new); l_run *= alpha; o0 = o0 * alpha; o1 = o1 * alpha; }
            m_run = m_new;
            p0 = p0 - m_new; p1 = p1 - m_new;
#pragma unroll
            for (int r = 0; r < 16; ++r) { p0[r] = fast_exp2(p0[r]); p1[r] = fast_exp2(p1[r]); }
            { const f32x16 ps = p0 + p1; l_run += ((ps[0] + ps[1]) + (ps[2] + ps[3])) + ((ps[4] + ps[5]) + (ps[6] + ps[7])) + (((ps[8] + ps[9]) + (ps[10] + ps[11])) + ((ps[12] + ps[13]) + (ps[14] + ps[15]))); }
            bf16x8 pk[4];
#pragma unroll
            for (int s = 0; s < 2; ++s) {
                u32x4 a; a.x = cvt_pk_bf16(p0[8 * s + 0], p0[8 * s + 1]); a.y = cvt_pk_bf16(p0[8 * s + 2], p0[8 * s + 3]); a.z = cvt_pk_bf16(p0[8 * s + 4], p0[8 * s + 5]); a.w = cvt_pk_bf16(p0[8 * s + 6], p0[8 * s + 7]);
                u32x4 c; c.x = cvt_pk_bf16(p1[8 * s + 0], p1[8 * s + 1]); c.y = cvt_pk_bf16(p1[8 * s + 2], p1[8 * s + 3]); c.z = cvt_pk_bf16(p1[8 * s + 4], p1[8 * s + 5]); c.w = cvt_pk_bf16(p1[8 * s + 6], p1[8 * s + 7]);
                pk[s] = __builtin_bit_cast(bf16x8, a); pk[2 + s] = __builtin_bit_cast(bf16x8, c); }
            const int gi = (lane >> 4) & 1, q4 = (lane & 15) >> 2, p4 = lane & 3;
            const LAS unsigned char* vlane = vb + ((4 * hi + q4) * C::VP + 16 * gi + 4 * p4) * 2;
#pragma unroll
            for (int s4 = 0; s4 < 4; ++s4) {
#pragma unroll
                for (int db = 0; db < 2; ++db) {
                    const s16x4 lo4 = __builtin_bit_cast(s16x4, __builtin_amdgcn_ds_read_tr16_b64_v4i16((LAS s16x4*)(vlane + ((16 * s4) * C::VP + 32 * db) * 2)));
                    const s16x4 hi4 = __builtin_bit_cast(s16x4, __builtin_amdgcn_ds_read_tr16_b64_v4i16((LAS s16x4*)(vlane + ((16 * s4 + 8) * C::VP + 32 * db) * 2)));
                    const bf16x8 vf = (bf16x8){lo4[0], lo4[1], lo4[2], lo4[3], hi4[0], hi4[1], hi4[2], hi4[3]};
                    if (db == 0) o0 = __builtin_amdgcn_mfma_f32_32x32x16_bf16(vf, pk[s4], o0, 0, 0, 0); else o1 = __builtin_amdgcn_mfma_f32_32x32x16_bf16(vf, pk[s4], o1, 0, 0, 0);
                }
            }
        }
        if (kt + 1 < NT) { ATT_STORE_TILE((kt + 1) & 1); mcur = mw; }
        __syncthreads();
    }
    { auto rr = __builtin_amdgcn_permlane32_swap(__float_as_uint(l_run), __float_as_uint(l_run), false, false); l_run = __uint_as_float(rr[0]) + __uint_as_float(rr[1]); }
    const float inv = 1.0f / l_run;
    bf16* op = A.O + (rb + qrow) * D + h * 64 + 4 * hi;
#pragma unroll
    for (int g4 = 0; g4 < 4; ++g4) {
        u32x2 a; a.x = cvt_pk_bf16(o0[4 * g4 + 0] * inv, o0[4 * g4 + 1] * inv); a.y = cvt_pk_bf16(o0[4 * g4 + 2] * inv, o0[4 * g4 + 3] * inv);
        u32x2 c; c.x = cvt_pk_bf16(o1[4 * g4 + 0] * inv, o1[4 * g4 + 1] * inv); c.y = cvt_pk_bf16(o1[4 * g4 + 2] * inv, o1[4 * g4 + 3] * inv);
        *(u32x2*)(op + 8 * g4) = a; *(u32x2*)(op + 32 + 8 * g4) = c;
    }
}
#undef ATT_LOAD_TILE
#undef ATT_STORE_TILE
template <int DK, bool MASKED>
__device__ __forceinline__ void attn_phase(const Frame& F, const AttnArgs& A) {
    for (int i = 0; i < 4; ++i) {
        const int u = i * F.G + F.bid; if (u >= 1024) break;
        const int bh = u >> 3, qp = u & 7, qb = ((u >> 8) & 1) ? 7 - qp : qp;
        attn_unit<DK, MASKED>(F, A, bh >> 4, bh & 15, qb);
    }
}
constexpr int HG_QS = 136, HG_HS = 72, HG_VS = 72, HG_SS = 136;
constexpr int HG_QT = 0, HG_KT = HG_QT + 64 * HG_QS * 2, HG_KH = HG_KT + 64 * HG_QS * 2, HG_VT = HG_KH + 128 * HG_HS * 2, HG_SB = HG_VT + 32 * HG_VS * 2,
              HG_GL = HG_SB + 2 * 32 * HG_SS * 2, HG_SEG = HG_GL + 512, HG_END = HG_SEG + 4 * 128 * 4;
static_assert(HG_END <= RING_BYTES, "hgrn2 LDS");
__device__ __forceinline__ void hgrn2_scan_phase(const Frame& F, const bf16* proj, const float* lb_logits  , float* opre  ) {
    LAS bf16* Qt = (LAS bf16*)(F.lds + HG_QT); LAS bf16* Kt = (LAS bf16*)(F.lds + HG_KT); LAS bf16* Kh = (LAS bf16*)(F.lds + HG_KH); LAS bf16* Vt = (LAS bf16*)(F.lds + HG_VT);
    LAS bf16* Sb = (LAS bf16*)(F.lds + HG_SB); LAS float* GL = (LAS float*)(F.lds + HG_GL); LAS float* SEG = (LAS float*)(F.lds + HG_SEG);
    const int tid = F.tid, lane = F.lane, w = F.wave, fr = lane & 15, fq = lane >> 4;
    for (int u = F.bid; u < 256; u += F.G) {
        const int b = u >> 5, h = (u >> 2) & 7, vq = u & 3;
        const size_t rb = (size_t)b * SEQ;
        const int k = tid & 127, tseg = tid >> 7;
        float lbv; { const int c = 128 * h + k; const float a0 = lb_logits[c], a1 = lb_logits[1024 + c], a2 = lb_logits[2048 + c], a3 = lb_logits[3072 + c];
            const float mx = fmaxf(fmaxf(a0, a1), fmaxf(a2, a3)); const float e0 = __expf(a0 - mx), e1 = __expf(a1 - mx), e2 = __expf(a2 - mx), e3 = __expf(a3 - mx);
            lbv = (e1 + e2) / (e0 + e1 + e2 + e3); }
        f32x4 sacc[2]; sacc[0] = (f32x4){0.f, 0.f, 0.f, 0.f}; sacc[1] = sacc[0];
        for (int i = tid; i < 2 * 32 * HG_SS / 2; i += NTHREADS) ((LAS unsigned*)Sb)[i] = 0u;
        const int vt = w & 1, tt = w >> 1;
        unsigned short rq[16], rf[16], rv[8];
#define HG_FETCH(cc) do { const size_t r0_ = rb + 64 * (cc); const bf16* pp_ = proj + (r0_ + 16 * tseg) * 4096 + 128 * h + k; \
            _Pragma("unroll") for (int j = 0; j < 16; ++j) { rq[j] = pp_[(size_t)j * 4096]; rf[j] = pp_[(size_t)j * 4096 + 1024]; } \
            if (tid < 256) { const bf16* vp_ = proj + (r0_ + 8 * (tid & 7)) * 4096 + 2048 + 128 * h + 32 * vq + (tid >> 3); \
                _Pragma("unroll") for (int j = 0; j < 8; ++j) rv[j] = vp_[(size_t)j * 4096]; } } while (0)
        HG_FETCH(0);
        for (int c = 0; c < 32; ++c) {
            const size_t r0 = rb + 64 * c;
            float gl[16], kk[16], qv[16];
            { float run = 0.f;
#pragma unroll
                for (int j = 0; j < 16; ++j) { const float fp = bf2f(rf[j]); qv[j] = bf2f(rq[j]);
                    const float sg = sigmoidf_(fp); const float f = lbv + (1.f - lbv) * sg; kk[j] = (1.f - lbv) * (1.f - sg); run += __logf(f); gl[j] = run; }
                SEG[tseg * 128 + k] = run; }
            if (tid < 256) { const int so = tid & 7, v = tid >> 3;
                u32x4 o; o.x = (unsigned)rv[0] | ((unsigned)rv[1] << 16); o.y = (unsigned)rv[2] | ((unsigned)rv[3] << 16);
                o.z = (unsigned)rv[4] | ((unsigned)rv[5] << 16); o.w = (unsigned)rv[6] | ((unsigned)rv[7] << 16);
                *(LAS u32x4*)(Vt + v * HG_VS + 8 * so) = o; }
            if (c + 1 < 32) HG_FETCH(c + 1);
            LDS_BARRIER();
            { float off = 0.f, tot = 0.f;
#pragma unroll
                for (int s = 0; s < 4; ++s) { const float sv = SEG[s * 128 + k]; off += (s < tseg) ? sv : 0.f; tot += sv; }
                if (tseg == 0) GL[k] = tot;
                unsigned kh[8];
#pragma unroll
                for (int j = 0; j < 16; ++j) { const float G = off + gl[j]; const float eg = __expf(G);
                    const float qs = qv[j] * eg, ks = kk[j] * __expf(-G), khv = kk[j] * __expf(tot - G);
                    Qt[(16 * tseg + j) * HG_QS + k] = (bf16)(cvt_pk_bf16(qs, 0.f) & 0xffffu); Kt[(16 * tseg + j) * HG_QS + k] = (bf16)(cvt_pk_bf16(ks, 0.f) & 0xffffu);
                    if (j & 1) kh[j >> 1] = (kh[j >> 1] & 0xffffu) | (cvt_pk_bf16(0.f, khv) & 0xffff0000u); else kh[j >> 1] = cvt_pk_bf16(khv, 0.f) & 0xffffu; }
                *(LAS u32x4*)(Kh + k * HG_HS + 16 * tseg) = (u32x4){kh[0], kh[1], kh[2], kh[3]}; *(LAS u32x4*)(Kh + k * HG_HS + 16 * tseg + 8) = (u32x4){kh[4], kh[5], kh[6], kh[7]}; }
            LDS_BARRIER();
            const LAS bf16* Sbc = Sb + (c & 1) * 32 * HG_SS; LAS bf16* Sbn = Sb + ((c + 1) & 1) * 32 * HG_SS;
            bf16x8 bq[4];
#pragma unroll
            for (int ks = 0; ks < 4; ++ks) bq[ks] = *(const LAS bf16x8*)(Qt + (16 * tt + fr) * HG_QS + 32 * ks + 8 * fq);
            f32x4 sc[4];
#pragma unroll
            for (int st = 0; st < 4; ++st) { sc[st] = (f32x4){0.f, 0.f, 0.f, 0.f};
                if (st <= tt) {
#pragma unroll
                    for (int ks = 0; ks < 4; ++ks) { const bf16x8 ka = *(const LAS bf16x8*)(Kt + (16 * st + fr) * HG_QS + 32 * ks + 8 * fq); sc[st] = __builtin_amdgcn_mfma_f32_16x16x32_bf16(ka, bq[ks], sc[st], 0, 0, 0); }
                    if (st == tt) {
#pragma unroll
                        for (int i = 0; i < 4; ++i) if (4 * fq + i > fr) sc[st][i] = 0.f; } } }
            f32x4 oacc = (f32x4){0.f, 0.f, 0.f, 0.f};
#pragma unroll
            for (int m = 0; m < 2; ++m) {
                u32x4 pw; pw.x = cvt_pk_bf16(sc[2 * m][0], sc[2 * m][1]); pw.y = cvt_pk_bf16(sc[2 * m][2], sc[2 * m][3]); pw.z = cvt_pk_bf16(sc[2 * m + 1][0], sc[2 * m + 1][1]); pw.w = cvt_pk_bf16(sc[2 * m + 1][2], sc[2 * m + 1][3]);
                const LAS bf16* vp = Vt + (16 * vt + fr) * HG_VS + 32 * m + 4 * fq;
                const u32x2 va = *(const LAS u32x2*)vp, vb = *(const LAS u32x2*)(vp + 16);
                const bf16x8 vf = __builtin_bit_cast(bf16x8, (u32x4){va.x, va.y, vb.x, vb.y});
                oacc = __builtin_amdgcn_mfma_f32_16x16x32_bf16(vf, __builtin_bit_cast(bf16x8, pw), oacc, 0, 0, 0);
            }
#pragma unroll
            for (int ks = 0; ks < 4; ++ks) { const bf16x8 sa = *(const LAS bf16x8*)(Sbc + (16 * vt + fr) * HG_SS + 32 * ks + 8 * fq); oacc = __builtin_amdgcn_mfma_f32_16x16x32_bf16(sa, bq[ks], oacc, 0, 0, 0); }
            *(f32x4*)(opre + (r0 + 16 * tt + fr) * D + 128 * h + 32 * vq + 16 * vt + 4 * fq) = oacc;
#pragma unroll
            for (int x = 0; x < 2; ++x) { const int kt = tt + 4 * x;
                const f32x4 dec = *(const LAS f32x4*)(GL + 16 * kt + 4 * fq);
                f32x4 a = sacc[x]; a.x *= __expf(dec.x); a.y *= __expf(dec.y); a.z *= __expf(dec.z); a.w *= __expf(dec.w);
#pragma unroll
                for (int m = 0; m < 2; ++m) { const bf16x8 ka = *(const LAS bf16x8*)(Kh + (16 * kt + fr) * HG_HS + 32 * m + 8 * fq), vbf = *(const LAS bf16x8*)(Vt + (16 * vt + fr) * HG_VS + 32 * m + 8 * fq);
                    a = __builtin_amdgcn_mfma_f32_16x16x32_bf16(ka, vbf, a, 0, 0, 0); }
                sacc[x] = a;
                u32x2 o; o.x = cvt_pk_bf16(a.x, a.y); o.y = cvt_pk_bf16(a.z, a.w);
                *(LAS u32x2*)(Sbn + (16 * vt + fr) * HG_SS + 16 * kt + 4 * fq) = o; }
            LDS_BARRIER();
        }
#undef HG_FETCH
    }
}
__device__ __forceinline__ void hgrn2_norm_phase(const Frame& F, const float* opre, const bf16* proj, const float* ng, bf16* ob) {
    const int gw = F.bid * NWAVES + F.wave, NGW = F.G * NWAVES, lane = F.lane;
    for (int r = gw; r < M; r += NGW) {
#pragma unroll
        for (int j = 0; j < 4; ++j) { const int col = 4 * lane + 256 * j; const f32x4 v = *(const f32x4*)(opre + (size_t)r * D + col);
            float ss = (v.x * v.x + v.y * v.y) + (v.z * v.z + v.w * v.w);
            ss = half_sum32(ss, lane);
            const float rs = __builtin_amdgcn_rsqf(ss * (1.f / 128.f) + RMS_EPS);
            const f32x4 g4 = *(const f32x4*)(ng + (col & 127)); const u32x2 gt = *(const u32x2*)(proj + (size_t)r * 4096 + 3072 + col);
            u32x2 o; o.x = cvt_pk_bf16(v.x * rs * g4.x * siluf_(bflo(gt.x)), v.y * rs * g4.y * siluf_(bfhi(gt.x))); o.y = cvt_pk_bf16(v.z * rs * g4.z * siluf_(bflo(gt.y)), v.w * rs * g4.w * siluf_(bfhi(gt.y)));
            *(u32x2*)(ob + (size_t)r * D + col) = o; }
    }
}
__device__ __forceinline__ void mla_norm_phase(const Frame& F, const float* projd, const int* positions, const float* qg, const float* kvg, bf16* cq, bf16* ckv, bf16* kr, float* ang) {
    const int gw = F.bid * NWAVES + F.wave, NGW = F.G * NWAVES, lane = F.lane;
    for (int r = gw; r < M; r += NGW) {
        const f32x4 a = *(const f32x4*)(projd + (size_t)r * 512 + 8 * lane), c = *(const f32x4*)(projd + (size_t)r * 512 + 8 * lane + 4);
        float x[8] = {a.x, a.y, a.z, a.w, c.x, c.y, c.z, c.w};
        float ss = 0.f;
#pragma unroll
        for (int i = 0; i < 8; ++i) ss += x[i] * x[i];
        const float s16 = row_sum16(ss);
        const float s32 = rdlane(s16, 0) + rdlane(s16, 16);
        float px[8];
#pragma unroll
        for (int i = 0; i < 8; ++i) px[i] = dppmov<0x4E>(x[i]);
        if (lane < 32) {
            const float rs = __builtin_amdgcn_rsqf(s32 * (1.f / 256.f) + RMS_EPS);
            const f32x4 g0 = *(const f32x4*)(qg + 8 * lane), g1 = *(const f32x4*)(qg + 8 * lane + 4);
            u32x4 o; o.x = cvt_pk_bf16(x[0] * rs * g0.x, x[1] * rs * g0.y); o.y = cvt_pk_bf16(x[2] * rs * g0.z, x[3] * rs * g0.w); o.z = cvt_pk_bf16(x[4] * rs * g1.x, x[5] * rs * g1.y); o.w = cvt_pk_bf16(x[6] * rs * g1.z, x[7] * rs * g1.w);
            *(u32x4*)(cq + (size_t)r * 256 + 8 * lane) = o;
        } else if (lane < 48) {
            const int l2 = lane - 32; const float rs = __builtin_amdgcn_rsqf(s16 * (1.f / 128.f) + RMS_EPS);
            const f32x4 g0 = *(const f32x4*)(kvg + 8 * l2), g1 = *(const f32x4*)(kvg + 8 * l2 + 4);
            u32x4 o; o.x = cvt_pk_bf16(x[0] * rs * g0.x, x[1] * rs * g0.y); o.y = cvt_pk_bf16(x[2] * rs * g0.z, x[3] * rs * g0.w); o.z = cvt_pk_bf16(x[4] * rs * g1.x, x[5] * rs * g1.y); o.w = cvt_pk_bf16(x[6] * rs * g1.z, x[7] * rs * g1.w);
            *(u32x4*)(ckv + (size_t)r * 256 + 8 * l2) = o;
        } else {
            *(u32x4*)(ckv + (size_t)r * 256 + 128 + 8 * (lane - 48)) = (u32x4){0u, 0u, 0u, 0u};
            if (lane < 52) {
                const int l3 = lane - 48, i0 = 8 * (l3 & 1); const bool second = l3 >= 2; const float pos = (float)positions[r];
                float outv[8];
#pragma unroll
                for (int i = 0; i < 8; ++i) { const float invf = fast_exp2(-(float)(i0 + i) * (13.287712379549449f / 16.f)); const float an = pos * invf; float rev = an * 0.15915494309189535f; rev = rev - floorf(rev); const float cs = __builtin_amdgcn_cosf(rev), sn = __builtin_amdgcn_sinf(rev);
                    outv[i] = second ? (x[i] * cs + px[i] * sn) : (x[i] * cs - px[i] * sn);
                    if (!second) { ang[(size_t)r * 32 + 2 * (i0 + i)] = cs; ang[(size_t)r * 32 + 2 * (i0 + i) + 1] = sn; } }
                u32x4 o; o.x = cvt_pk_bf16(outv[0], outv[1]); o.y = cvt_pk_bf16(outv[2], outv[3]); o.z = cvt_pk_bf16(outv[4], outv[5]); o.w = cvt_pk_bf16(outv[6], outv[7]);
                *(u32x4*)(kr + (size_t)r * 32 + 8 * l3) = o;
            }
        }
    }
}
__device__ __forceinline__ void mla_qrope_phase(const Frame& F, bf16* q, const float* ang) {
    const int gw = F.bid * NWAVES + F.wave, NGW = F.G * NWAVES, lane = F.lane;
    const int hh = lane >> 2, part = lane & 3, i0 = 8 * (part & 1); const bool second = part >= 2;
    for (int r = gw; r < M; r += NGW) {
        bf16* p = q + (size_t)r * 1536 + 96 * hh + 64 + 8 * part;
        const u32x4 wv = *(const u32x4*)p;
        float x[8] = {bflo(wv.x), bfhi(wv.x), bflo(wv.y), bfhi(wv.y), bflo(wv.z), bfhi(wv.z), bflo(wv.w), bfhi(wv.w)};
        float outv[8];
#pragma unroll
        for (int i = 0; i < 8; ++i) { const float px = __shfl_xor(x[i], 2); const f32x2 cssn = *(const f32x2*)(ang + (size_t)r * 32 + 2 * (i0 + i));
            outv[i] = second ? (x[i] * cssn.x + px * cssn.y) : (x[i] * cssn.x - px * cssn.y); }
        u32x4 o; o.x = cvt_pk_bf16(outv[0], outv[1]); o.y = cvt_pk_bf16(outv[2], outv[3]); o.z = cvt_pk_bf16(outv[4], outv[5]); o.w = cvt_pk_bf16(outv[6], outv[7]);
        *(u32x4*)p = o;
    }
}
constexpr int NPHASE = 36;
#ifndef MK_ONE_LAUNCH
#define MK_ONE_LAUNCH 1
#endif
#ifndef MK_DUP
#define MK_DUP 0ull
#endif
#ifndef MK_NRUN
#define MK_NRUN NPHASE
#endif
__device__ __forceinline__ void prologue_phase(const Frame& F, const Args& args, unsigned char* ws, bf16* XB) {
#define INP(i) ((const float*)args.in[i])

        convert_matrix(F, INP(I_A_WIN), 1024, 4096, (bf16*)(ws + W_A_IN), 1024, 4096, 0, 1);
        convert_matrix(F, INP(I_A_WOUT), 2048, 1024, (bf16*)(ws + W_A_OUT), 2048, 1024, 0, 1);
        convert_matrix(F, INP(I_B_WIN), 1024, 3396, (bf16*)(ws + W_B_IN), 1024, 3584, 0, 1);
        convert_matrix(F, INP(I_B_WOUT), 1024, 1024, (bf16*)(ws + W_B_OUT), 1024, 1024, 0, 1);
        convert_matrix(F, INP(I_C_WIN), 1024, 4096, (bf16*)(ws + W_C_IN), 1024, 4096, 0, 1);
        convert_matrix(F, INP(I_C_WOUT), 1024, 1024, (bf16*)(ws + W_C_OUT), 1024, 1024, 0, 1);
        convert_matrix(F, INP(I_D_WIN), 1024, 416, (bf16*)(ws + W_D_IN), 1024, 512, 0, 1);
        convert_matrix(F, INP(I_D_WUQ), 256, 1536, (bf16*)(ws + W_D_UQ), 256, 1536, 0, 1);
        convert_matrix(F, INP(I_D_WUKV), 128, 2048, (bf16*)(ws + W_D_UKV), 256, 2048, 0, 1);
        convert_matrix(F, INP(I_D_WOUT), 1024, 1024, (bf16*)(ws + W_D_OUT), 1024, 1024, 0, 1);
        convert_matrix(F, INP(I_F0_GU), 1024, 2 * FF, (bf16*)(ws + W_F0_GU), 1024, 2 * FF, 1, 1);
        convert_matrix(F, INP(I_F0_DN), FF, 1024, (bf16*)(ws + W_F0_DN), FF, 1024, 0, 1);
        convert_matrix(F, INP(I_F2_GU), 1024, 2 * FF, (bf16*)(ws + W_F2_GU), 1024, 2 * FF, 1, 1);
        convert_matrix(F, INP(I_F2_DN), FF, 1024, (bf16*)(ws + W_F2_DN), FF, 1024, 0, 1);
        convert_matrix(F, INP(I_M1_GU), 1024, 2 * FF, (bf16*)(ws + W_M1_GU), 1024, 2 * FF, 1, NE);
        convert_matrix(F, INP(I_M1_DN), FF, 1024, (bf16*)(ws + W_M1_DN), FF, 1024, 0, NE);
        cvt_rows_phase(F, INP(I_X), XB);
    #undef INP
}
__global__ void __launch_bounds__(NTHREADS, 2) fwd_kernel(Args args) {
    extern __shared__ __attribute__((aligned(16))) unsigned char lds_raw[];
    Frame F;
    F.lds = (LAS unsigned char*)lds_raw;
    F.tid = threadIdx.x; F.lane = F.tid & 63; F.wave = __builtin_amdgcn_readfirstlane(F.tid >> 6);
    F.G = gridDim.x; F.bid = blockIdx.x;
    F.ws = args.ws; F.ctl = (unsigned*)(args.ws + WS_CTL);
    unsigned char* ws = args.ws;
    const int lo = args.ph_lo, hi = args.ph_hi;
    for (int u = F.tid; u < (LDS_BYTES - LDSCTL_OFF) / 4; u += NTHREADS) ((LAS unsigned*)(F.lds + LDSCTL_OFF))[u] = 0u;
    __syncthreads();
    XcdBarrier bar; bar.bar = F.ctl + CW_BAR; bar.x = 0; bar.st = nullptr;
    const bool multi = (hi - lo) > 1;
    if (multi) bar = xcd_barrier_post(F.ctl + CW_BAR, (volatile LAS unsigned*)(F.lds + LDSCTL_OFF + 64));
#define IN(k) (lo <= (k) && (k) < hi)
#define SEAM(k) do { if (IN(k) && IN((k) + 1)) xcd_barrier(bar); } while (0)
#define DUPP(k) (((unsigned long long)(MK_DUP) >> (k)) & 1ull)
#define PHASE(k, ...) do { if (IN(k)) { __VA_ARGS__; if (DUPP(k)) { xcd_barrier(bar); __VA_ARGS__; } } SEAM(k); } while (0)
#define INP(i) ((const float*)args.in[i])
    float* XF = args.out;
    bf16* XB = (bf16*)(ws + WS_XB);
    bf16* H = (bf16*)(ws + B_H);
    bf16* OB = (bf16*)(ws + B_OB);
    bf16* XR = (bf16*)(ws + WS_R2); bf16* YK = (bf16*)(ws + WS_R2);
    LAS unsigned char* ring = F.lds;

#define GEMM(EpiT, Aptr, lda_, Bptr, Nn, Kk, epi) do { pg8::Gemm g_{(Aptr), (Bptr), M, (Nn), (Kk), (lda_), 0}; pg8::StaticOrder S_; S_.init(M, (Nn), F.G, F.bid); \
        pg8::gemm_phase<EpiT, pg8::StaticOrder>(ring, g_, S_, (epi)); } while (0)
#define FFN_DENSE(p0, WGU, WDN, lg, lb) do { \
        PHASE(p0, GEMM(pg8::EpiSwiGLU, XB, D, (const bf16*)(ws + (WGU)), 2 * FF, D, (pg8::EpiSwiGLU{H, FF}));); \
        PHASE((p0) + 1, GEMM(pg8::EpiResid, H, FF, (const bf16*)(ws + (WDN)), D, FF, (pg8::EpiResid{XB, XF, ALPHA}));); \
        PHASE((p0) + 2, ln_phase(F, XF, XB, (lg), (lb));); } while (0)
#define FFN_MOE(p0, slot_, WR, WGU, WDN, lmg, lmb, lfg, lfb, OUTF) do { \
        unsigned* cnt_ = F.ctl + CW_CNT + (slot_) * 512; \
        PHASE(p0, ln_route_phase(F, XF, XB, (lmg), (lmb), (WR), cnt_);); \
        PHASE((p0) + 1, moe_gather_phase(F, XB, XR, cnt_);); \
        PHASE((p0) + 2, int cv_[NE], ps_[NE]; pg8::MoeOrder S_; const int rows_ = moe_segments(cnt_, cv_, ps_, S_.pend); S_.so.init(rows_, 2 * FF, F.G, F.bid); \
            pg8::Gemm g_{XR, (const bf16*)(ws + (WGU)), rows_, 2 * FF, D, D, (size_t)2 * FF * D}; pg8::gemm_phase<pg8::EpiSwiGLU, pg8::MoeOrder>(ring, g_, S_, pg8::EpiSwiGLU{H, FF});); \
        PHASE((p0) + 3, int cv_[NE], ps_[NE]; pg8::MoeOrder S_; const int rows_ = moe_segments(cnt_, cv_, ps_, S_.pend); S_.so.init(rows_, D, F.G, F.bid); \
            pg8::Gemm g_{H, (const bf16*)(ws + (WDN)), rows_, D, FF, FF, (size_t)D * FF}; \
            pg8::gemm_phase<pg8::EpiMoeDown, pg8::MoeOrder>(ring, g_, S_, pg8::EpiMoeDown{YK, (const int*)(ws + S_ROWTOK), (const float*)(ws + S_ROWGATE)}); \
            if ((slot_) == 0) {   \
                const int nwg_ = S_.so.nwg; int n3_ = ((nwg_ - 1) % F.G) + 1; if (n3_ >= F.G) n3_ = 0; \
                if (F.bid >= n3_) { const int gw_ = (F.bid - n3_) * NWAVES + F.wave, ngw_ = (F.G - n3_) * NWAVES; \
                    convert_matrix_g(F, gw_, ngw_, INP(I_M3_GU), 1024, 2 * FF, (bf16*)(ws + W_M3_GU), 1024, 2 * FF, 1, NE); \
                    convert_matrix_g(F, gw_, ngw_, INP(I_M3_DN), FF, 1024, (bf16*)(ws + W_M3_DN), FF, 1024, 0, NE); } }); \
        PHASE((p0) + 4, ln_moe_phase(F, YK, (OUTF), XB, (lfg), (lfb));); } while (0)

    PHASE(0, prologue_phase(F, args, ws, XB););
    { bf16* UV = (bf16*)(ws + B_UV); bf16* GATED = (bf16*)(ws + B_GATED); float* STATS = (float*)(ws + S_STATS);
      PHASE(1, GEMM(pg8::EpiBf16<1>, XB, D, (const bf16*)(ws + W_A_IN), 4096, D, (pg8::EpiBf16<1>{UV, 4096, 1.f, 0})););
      PHASE(2, gmlp_stats_phase(F, UV, STATS););
      PHASE(3, gmlp_spatial_phase(F, UV, STATS, INP(I_A_WS), INP(I_A_BS), INP(I_A_LNG), INP(I_A_LNB), GATED););
      PHASE(4, GEMM(pg8::EpiResid, GATED, 2048, (const bf16*)(ws + W_A_OUT), D, 2048, (pg8::EpiResid{XB, XF, ALPHA})););
      PHASE(5, ln_phase(F, XF, XB, INP(I_LNM_G), INP(I_LNM_B));); }
    FFN_DENSE(6, W_F0_GU, W_F0_DN, INP(I_LNF_G), INP(I_LNF_B));
    { bf16* PROJ = (bf16*)(ws + B_PROJB); u64* MASK = (u64*)(ws + S_MASK);
      PHASE(9, GEMM(pg8::EpiBf16<0>, XB, D, (const bf16*)(ws + W_B_IN), 3584, D, (pg8::EpiBf16<0>{PROJ, 3584, 0.125f * 1.4426950408889634f, 4})););
      PHASE(10, dsa_topk_phase(F, PROJ, MASK););
      PHASE(11, AttnArgs A; A.Q = PROJ; A.ldq = PB_LD; A.qoff = 0; A.K1 = PROJ; A.ldk1 = PB_LD; A.k1off = 1024; A.k1hs = 64; A.K2 = nullptr; A.ldk2 = 0; A.V = PROJ; A.ldv = PB_LD; A.voff = 2048; A.vhs = 64;
          A.O = OB; A.mask = MASK; A.ang = nullptr; attn_phase<64, true>(F, A););
      PHASE(12, GEMM(pg8::EpiResid, OB, D, (const bf16*)(ws + W_B_OUT), D, D, (pg8::EpiResid{XB, XF, ALPHA}));); }
    FFN_MOE(13, 0, INP(I_M1_R), W_M1_GU, W_M1_DN, INP(I_LNM_G) + D, INP(I_LNM_B) + D, INP(I_LNF_G) + D, INP(I_LNF_B) + D, (float*)nullptr);
    { bf16* PROJ = (bf16*)(ws + B_PROJC); float* OPRE = (float*)(ws + B_OPRE);
      PHASE(18, GEMM(pg8::EpiBf16<0>, XB, D, (const bf16*)(ws + W_C_IN), 4096, D, (pg8::EpiBf16<0>{PROJ, 4096, 1.f, 0})););
      PHASE(19, hgrn2_scan_phase(F, PROJ, INP(I_C_LB), OPRE););
      PHASE(20, hgrn2_norm_phase(F, OPRE, PROJ, INP(I_C_NG), OB););
      PHASE(21, GEMM(pg8::EpiResid, OB, D, (const bf16*)(ws + W_C_OUT), D, D, (pg8::EpiResid{XB, XF, ALPHA})););
      PHASE(22, ln_phase(F, XF, XB, INP(I_LNM_G) + 2 * D, INP(I_LNM_B) + 2 * D);); }
    FFN_DENSE(23, W_F2_GU, W_F2_DN, INP(I_LNF_G) + 2 * D, INP(I_LNF_B) + 2 * D);
    { float* PROJD = (float*)(ws + B_PROJD); bf16* CQ = (bf16*)(ws + B_CQ); bf16* CKV = (bf16*)(ws + B_CKV); bf16* Q = (bf16*)(ws + B_Q); bf16* KV = (bf16*)(ws + B_KV);
      bf16* KR = (bf16*)(ws + S_KR); float* ANG = (float*)(ws + S_ANG);
      PHASE(26, GEMM(pg8::EpiF32, XB, D, (const bf16*)(ws + W_D_IN), 512, D, (pg8::EpiF32{PROJD, 512})););
      PHASE(27, mla_norm_phase(F, PROJD, (const int*)args.in[I_POS], INP(I_D_QNG), INP(I_D_KVNG), CQ, CKV, KR, ANG););
      PHASE(28, GEMM(pg8::EpiBf16<0>, CQ, 256, (const bf16*)(ws + W_D_UQ), 1536, 256, (pg8::EpiBf16<0>{Q, 1536, 0.10206207261596577f * 1.4426950408889634f, 6}));
                    GEMM(pg8::EpiBf16<0>, CKV, 256, (const bf16*)(ws + W_D_UKV), 2048, 256, (pg8::EpiBf16<0>{KV, 2048, 1.f, 0})););
      PHASE(29, AttnArgs A; A.Q = Q; A.ldq = 1536; A.qoff = 0; A.K1 = KV; A.ldk1 = 2048; A.k1off = 0; A.k1hs = 128; A.K2 = KR; A.ldk2 = 32; A.V = KV; A.ldv = 2048; A.voff = 64; A.vhs = 128;
          A.O = OB; A.mask = nullptr; A.ang = ANG; attn_phase<96, false>(F, A););
      PHASE(30, GEMM(pg8::EpiResid, OB, D, (const bf16*)(ws + W_D_OUT), D, D, (pg8::EpiResid{XB, XF, ALPHA}));); }
    FFN_MOE(31, 1, INP(I_M3_R), W_M3_GU, W_M3_DN, INP(I_LNM_G) + 3 * D, INP(I_LNM_B) + 3 * D, INP(I_LNF_G) + 3 * D, INP(I_LNF_B) + 3 * D, args.out);
#undef IN
#undef SEAM
}

extern "C" void kernel_launch(void* const* d_in, const int* in_sizes, int n_in, void* d_out, int out_size, void* d_ws, size_t ws_size, hipStream_t stream) {
    static int grid = 0;
    if (grid == 0) {
        if (n_in != 34 || out_size != M * D || ws_size < WS_END) { fprintf(stderr, "kernel_launch: unexpected problem (n_in %d, out %d, ws %zu < %zu)\n", n_in, out_size, ws_size, (size_t)WS_END); grid = -1; return; }
        int dev = 0, cus = 0;
        if (hipGetDevice(&dev) != hipSuccess || hipDeviceGetAttribute(&cus, hipDeviceAttributeMultiprocessorCount, dev) != hipSuccess) { grid = -1; return; }
        if (hipFuncSetAttribute((const void*)fwd_kernel, hipFuncAttributeMaxDynamicSharedMemorySize, LDS_BYTES) != hipSuccess) { fprintf(stderr, "kernel_launch: hipFuncSetAttribute failed\n"); grid = -1; return; }
        int per_cu = 0;
        if (hipOccupancyMaxActiveBlocksPerMultiprocessor(&per_cu, (const void*)fwd_kernel, NTHREADS, LDS_BYTES) != hipSuccess || per_cu < 1) fprintf(stderr, "kernel_launch: occupancy query reports %d\n", per_cu);
        (void)hipGetLastError();
        grid = cus;
    }
    if (grid < 0) return;
    if (hipMemsetAsync((char*)d_ws + WS_CTL, 0, CTL_ZERO_BYTES, stream) != hipSuccess) return;
    Args a{};
    for (int i = 0; i < 34; ++i) a.in[i] = d_in[i];
    a.out = (float*)d_out; a.ws = (unsigned char*)d_ws;
#if MK_ONE_LAUNCH
    a.ph_lo = 0; a.ph_hi = MK_NRUN;
    hipLaunchKernelGGL(fwd_kernel, dim3(grid), dim3(NTHREADS), LDS_BYTES, stream, a);
#else
    for (int p = 0; p < MK_NRUN; ++p) { a.ph_lo = p; a.ph_hi = p + 1; hipLaunchKernelGGL(fwd_kernel, dim3(grid), dim3(NTHREADS), LDS_BYTES, stream, a); }
#endif
}
```
